# Optimizing an MI355X kernel written in HIP

```python
import jax, jax.numpy as jnp
from jax import lax
import numpy as np

D_MODEL = 1024
BATCH = 16
SEQ = 4096
DEPTH = 2

N_MIXERS = 2
N_GLA_LAYERS = (DEPTH + N_MIXERS - 1) // N_MIXERS
N_ATT_LAYERS = DEPTH // N_MIXERS
N_META = 16
GRID_W = 64
D_FF = 2816
NORM_EPS = 1e-6
MACARON_WEIGHT = 0.5

GLA_HEADS = 4
GLA_DK = D_MODEL // 2 // GLA_HEADS
GLA_DV = D_MODEL // GLA_HEADS
GLA_QK_W = GLA_HEADS * GLA_DK
GLA_V_W = GLA_HEADS * GLA_DV
GLA_GATE_RANK = 16
GLA_GATE_TAU = 16.0
GLA_CHUNK = 64
GLA_PAD = GLA_CHUNK - N_META

ATT_Q_HEADS = 8
ATT_KV_HEADS = 2
ATT_HEAD_DIM = D_MODEL // ATT_Q_HEADS
ATT_GROUP = ATT_Q_HEADS // ATT_KV_HEADS
ATT_Q_W = ATT_Q_HEADS * ATT_HEAD_DIM
ATT_KV_W = ATT_KV_HEADS * ATT_HEAD_DIM
ATT_BLOCK = 128
ROPE_THETA = 10000.0
ROPE_AXIS_DIM = ATT_HEAD_DIM // 2

kernel_name = "hybrid_gla_axial_gqa_macaron_encoder"


def rms_norm(x, gain):
    xf = x.astype(jnp.float32)
    y = xf * lax.rsqrt(jnp.mean(xf * xf, axis=-1, keepdims=True) + NORM_EPS)
    return (y * gain.astype(jnp.float32)).astype(x.dtype)


def swiglu(h, w_gate, w_up, w_down):
    return (jax.nn.silu(h @ w_gate) * (h @ w_up)) @ w_down


def gla_chunk_scan(q, k, v, logg):
    b = jnp.cumsum(logg, axis=3)
    b_last = b[:, :, :, -1:, :]
    q_dec = q * jnp.exp(b)
    k_inv = k * jnp.exp(-b)
    k_end = k * jnp.exp(b_last - b)
    t_len = q.shape[3]
    causal = jnp.tril(jnp.ones((t_len, t_len), dtype=bool))
    a = jnp.where(causal, jnp.einsum('bhctd,bhcsd->bhcts', q_dec, k_inv), 0.0)
    o_intra = jnp.einsum('bhcts,bhcsv->bhctv', a, v)
    decay = jnp.exp(b_last[:, :, :, 0, :])

    def step(state, xs):
        q_c, k_c, v_c, dec_c = xs
        out = jnp.einsum('bhtd,bhdv->bhtv', q_c, state)
        state = dec_c[..., None] * state + jnp.einsum('bhsd,bhsv->bhdv', k_c, v_c)
        return state, out

    xs = (jnp.moveaxis(q_dec, 2, 0), jnp.moveaxis(k_end, 2, 0),
          jnp.moveaxis(v, 2, 0), jnp.moveaxis(decay, 2, 0))
    state0 = jnp.zeros((q.shape[0], q.shape[1], q.shape[4], v.shape[4]), q.dtype)
    _, o_inter = lax.scan(step, state0, xs)
    return o_intra + jnp.moveaxis(o_inter, 0, 2)


def gla_mixer(h, w_in, gate_w1, gate_w2, gate_b, head_norm, w_out):
    bsz, seq_len, _ = h.shape
    q, k, v, r = jnp.split(h @ w_in, [GLA_QK_W, 2 * GLA_QK_W, 2 * GLA_QK_W + GLA_V_W], axis=-1)
    q = q * GLA_DK ** -0.5
    z = jnp.einsum('nblr,nrk->nblk', jnp.einsum('bld,ndr->nblr', h, gate_w1), gate_w2) + gate_b[:, None, None, :]
    logg = jax.nn.log_sigmoid(z.astype(jnp.float32)) / GLA_GATE_TAU

    def to_chunks(t, d):
        t = jnp.pad(t.astype(jnp.float32), ((0, 0), (GLA_PAD, 0), (0, 0)))
        n_chunks = t.shape[1] // GLA_CHUNK
        return t.reshape(bsz, n_chunks, GLA_CHUNK, GLA_HEADS, d).transpose(0, 3, 1, 2, 4)

    qc, kc, vc = to_chunks(q, GLA_DK), to_chunks(k, GLA_DK), to_chunks(v, GLA_DV)
    g_fwd, g_bwd = to_chunks(logg[0], GLA_DK), to_chunks(logg[1], GLA_DK)
    flip = lambda t: jnp.flip(t, axis=(2, 3))
    o_fwd = gla_chunk_scan(qc, kc, vc, g_fwd)
    o_bwd = flip(gla_chunk_scan(flip(qc), flip(kc), flip(vc), flip(g_bwd)))
    o = (o_fwd + o_bwd).transpose(0, 2, 3, 1, 4)
    o = o.reshape(bsz, -1, GLA_HEADS, GLA_DV)[:, GLA_PAD:]
    o = rms_norm(o, head_norm) * jax.nn.silu(r.astype(jnp.float32)).reshape(bsz, seq_len, GLA_HEADS, GLA_DV)
    return o.reshape(bsz, seq_len, GLA_V_W).astype(h.dtype) @ w_out


def axial_rope_tables(n_real):
    rows = n_real // GRID_W
    t_row = jnp.broadcast_to(jnp.arange(rows)[:, None], (rows, GRID_W)).reshape(-1)
    t_col = jnp.broadcast_to(jnp.arange(GRID_W)[None, :], (rows, GRID_W)).reshape(-1)
    meta = jnp.zeros((N_META,), t_row.dtype)
    t_row = jnp.concatenate([meta, t_row]).astype(jnp.float32)
    t_col = jnp.concatenate([meta, t_col]).astype(jnp.float32)
    inv_freq = ROPE_THETA ** (-jnp.arange(0, ROPE_AXIS_DIM, 2, dtype=jnp.float32) / ROPE_AXIS_DIM)
    ang_row = t_row[:, None] * inv_freq[None, :]
    ang_col = t_col[:, None] * inv_freq[None, :]
    return jnp.cos(ang_row), jnp.sin(ang_row), jnp.cos(ang_col), jnp.sin(ang_col)


def rotate_half_pairs(x, cos, sin):
    x1, x2 = jnp.split(x, 2, axis=-1)
    c, s = cos[None, :, None, :], sin[None, :, None, :]
    return jnp.concatenate([x1 * c - x2 * s, x2 * c + x1 * s], axis=-1)


def apply_axial_rope(x, tables):
    cos_r, sin_r, cos_c, sin_c = tables
    xf = x.astype(jnp.float32)
    out = jnp.concatenate([rotate_half_pairs(xf[..., :ROPE_AXIS_DIM], cos_r, sin_r),
                           rotate_half_pairs(xf[..., ROPE_AXIS_DIM:], cos_c, sin_c)], axis=-1)
    return out.astype(x.dtype)


def attn_mixer(h, w_in, q_norm, k_norm, w_out):
    bsz, seq_len, _ = h.shape
    n_real = seq_len - N_META
    q, k, v = jnp.split(h @ w_in, [ATT_Q_W, ATT_Q_W + ATT_KV_W], axis=-1)
    q = rms_norm(q.reshape(bsz, seq_len, ATT_Q_HEADS, ATT_HEAD_DIM), q_norm)
    k = rms_norm(k.reshape(bsz, seq_len, ATT_KV_HEADS, ATT_HEAD_DIM), k_norm)
    v = v.reshape(bsz, seq_len, ATT_KV_HEADS, ATT_HEAD_DIM)
    tables = axial_rope_tables(n_real)
    q = apply_axial_rope(q, tables) * ATT_HEAD_DIM ** -0.5
    k = apply_axial_rope(k, tables)
    q = q.reshape(bsz, seq_len, ATT_KV_HEADS, ATT_GROUP, ATT_HEAD_DIM)

    def attend(q_blk):
        s = jnp.einsum('bqkgd,bskd->bkgqs', q_blk, k).astype(jnp.float32)
        p = jax.nn.softmax(s, axis=-1).astype(v.dtype)
        return jnp.einsum('bkgqs,bskd->bqkgd', p, v)

    o_meta = attend(q[:, :N_META])
    n_blk = n_real // ATT_BLOCK
    q_blocks = jnp.moveaxis(q[:, N_META:].reshape(bsz, n_blk, ATT_BLOCK, ATT_KV_HEADS, ATT_GROUP, ATT_HEAD_DIM), 1, 0)
    o_real = jnp.moveaxis(lax.map(attend, q_blocks), 0, 1).reshape(bsz, n_real, ATT_KV_HEADS, ATT_GROUP, ATT_HEAD_DIM)
    o = jnp.concatenate([o_meta, o_real], axis=1).reshape(bsz, seq_len, ATT_Q_W)
    return o @ w_out


def setup_inputs(seed: int = 0) -> dict:
    key = jax.random.key(seed)
    ks = iter(jax.random.split(key, 32))
    nrm = lambda shape, fan_in: jax.random.normal(next(ks), shape, jnp.float32) * fan_in ** -0.5
    gain = lambda shape: 1.0 + 0.02 * jax.random.normal(next(ks), shape, jnp.float32)
    return {
        "x": jax.random.normal(next(ks), (BATCH, SEQ, D_MODEL), jnp.float32),
        "meta_tokens": jax.random.normal(next(ks), (N_META, D_MODEL), jnp.float32),
        "norm_ffn1": gain((DEPTH, D_MODEL)),
        "ffn1_w_gate": nrm((DEPTH, D_MODEL, D_FF), D_MODEL),
        "ffn1_w_up": nrm((DEPTH, D_MODEL, D_FF), D_MODEL),
        "ffn1_w_down": nrm((DEPTH, D_FF, D_MODEL), D_FF),
        "norm_mix": gain((DEPTH, D_MODEL)),
        "gla_w_in": nrm((N_GLA_LAYERS, D_MODEL, 2 * GLA_QK_W + 2 * GLA_V_W), D_MODEL),
        "gla_gate_w1": nrm((N_GLA_LAYERS, 2, D_MODEL, GLA_GATE_RANK), D_MODEL),
        "gla_gate_w2": nrm((N_GLA_LAYERS, 2, GLA_GATE_RANK, GLA_QK_W), GLA_GATE_RANK),
        "gla_gate_b": 0.1 * jax.random.normal(next(ks), (N_GLA_LAYERS, 2, GLA_QK_W), jnp.float32),
        "gla_head_norm": gain((N_GLA_LAYERS, GLA_DV)),
        "gla_w_out": nrm((N_GLA_LAYERS, GLA_V_W, D_MODEL), GLA_V_W),
        "attn_w_in": nrm((N_ATT_LAYERS, D_MODEL, ATT_Q_W + 2 * ATT_KV_W), D_MODEL),
        "attn_q_norm": gain((N_ATT_LAYERS, ATT_HEAD_DIM)),
        "attn_k_norm": gain((N_ATT_LAYERS, ATT_HEAD_DIM)),
        "attn_w_out": nrm((N_ATT_LAYERS, ATT_Q_W, D_MODEL), ATT_Q_W),
        "norm_ffn2": gain((DEPTH, D_MODEL)),
        "ffn2_w_gate": nrm((DEPTH, D_MODEL, D_FF), D_MODEL),
        "ffn2_w_up": nrm((DEPTH, D_MODEL, D_FF), D_MODEL),
        "ffn2_w_down": nrm((DEPTH, D_FF, D_MODEL), D_FF),
        "norm_final": gain((D_MODEL,)),
    }


def reference(x, meta_tokens, norm_ffn1, ffn1_w_gate, ffn1_w_up, ffn1_w_down, norm_mix,
              gla_w_in, gla_gate_w1, gla_gate_w2, gla_gate_b, gla_head_norm, gla_w_out,
              attn_w_in, attn_q_norm, attn_k_norm, attn_w_out,
              norm_ffn2, ffn2_w_gate, ffn2_w_up, ffn2_w_down, norm_final):
    bsz = x.shape[0]
    meta = jnp.broadcast_to(meta_tokens.astype(x.dtype)[None], (bsz, N_META, x.shape[-1]))
    h = jnp.concatenate([meta, x], axis=1)
    for i in range(DEPTH):
        h = h + MACARON_WEIGHT * swiglu(rms_norm(h, norm_ffn1[i]), ffn1_w_gate[i], ffn1_w_up[i], ffn1_w_down[i])
        hn = rms_norm(h, norm_mix[i])
        j = i // N_MIXERS
        if i % N_MIXERS == 0:
            h = h + gla_mixer(hn, gla_w_in[j], gla_gate_w1[j], gla_gate_w2[j], gla_gate_b[j], gla_head_norm[j], gla_w_out[j])
        else:
            h = h + attn_mixer(hn, attn_w_in[j], attn_q_norm[j], attn_k_norm[j], attn_w_out[j])
        h = h + MACARON_WEIGHT * swiglu(rms_norm(h, norm_ffn2[i]), ffn2_w_gate[i], ffn2_w_up[i], ffn2_w_down[i])
    return rms_norm(h[:, N_META:], norm_final)
```

```cpp
#include <hip/hip_runtime.h>
#include <hip/hip_cooperative_groups.h>
#include <cstdio>
namespace cg = cooperative_groups;

#ifndef NOADD
#define NOADD 0
#endif
#ifndef FWDONLY
#define FWDONLY 0
#endif
#ifndef DIAG
#define DIAG 0
#endif
#ifndef PHMASK
#define PHMASK 0x3ffff
#endif
#ifndef KMASK
#define KMASK 1023
#endif
#ifndef ONE_LAUNCH
#define ONE_LAUNCH 1
#endif

#define LAS __attribute__((address_space(3)))
typedef unsigned short bf16_t;
typedef short bf16x8 __attribute__((ext_vector_type(8)));
typedef short s16x4 __attribute__((ext_vector_type(4)));
typedef float f32x4 __attribute__((ext_vector_type(4)));
typedef float f32x8 __attribute__((ext_vector_type(8)));
typedef float f32x16 __attribute__((ext_vector_type(16)));
typedef unsigned u32x4 __attribute__((ext_vector_type(4)));
typedef unsigned u32x2 __attribute__((ext_vector_type(2)));
typedef LAS unsigned char* ldsp;

constexpr int DM = 1024, FF = 2816, NB = 16, SEQ = 4096, NMETA = 16;
constexpr int MROWS = NB * NMETA + NB * SEQ;
constexpr int R0 = NB * NMETA;
constexpr float EPS = 1e-6f;
constexpr int LDS_BYTES = 143360;
constexpr int NPHASE = 18;

constexpr size_t SZ_H = (size_t)MROWS * DM * 4, SZ_HB = (size_t)MROWS * DM * 2, SZ_SSQ1 = (size_t)MROWS * 16 * 4;
constexpr size_t WS_H = 0, WS_HB = WS_H + SZ_H, WS_SSQ = WS_HB + SZ_HB, WS_W = WS_SSQ + 7 * SZ_SSQ1;
constexpr size_t SZ_WGU = (size_t)2 * FF * DM * 2, SZ_WD = (size_t)DM * FF * 2;
constexpr size_t WS_WGU = WS_W, WS_WD = WS_WGU + 4 * SZ_WGU, WS_WGIN = WS_WD + 4 * SZ_WD, WS_WGOUT = WS_WGIN + (size_t)4096 * DM * 2,
                 WS_WAIN = WS_WGOUT + (size_t)DM * DM * 2, WS_WAOUT = WS_WAIN + (size_t)1536 * DM * 2, WS_U = WS_WAOUT + (size_t)DM * DM * 2;
constexpr size_t U_ACT = WS_U;
constexpr size_t U_GB = WS_U, U_GK = U_GB + (size_t)MROWS * 512 * 4, U_GV = U_GK + (size_t)MROWS * 512 * 2, U_GR = U_GV + SZ_HB, U_GEND = U_GR + SZ_HB;
constexpr size_t U_AQ = WS_U, U_AK = U_AQ + SZ_HB, U_AV = U_AK + (size_t)MROWS * 256 * 2, U_AO = U_AV + (size_t)MROWS * 256 * 2, U_AEND = U_AO + SZ_HB;
constexpr size_t WS_NEED = (U_GEND > U_AEND ? U_GEND : U_AEND);
constexpr size_t O_GF = 0, O_GQ = (size_t)MROWS * 512 * 4;

struct Params { const float* in[22]; float* out; unsigned char* ws; int lo, hi; };

typedef __bf16 bf16x2_t __attribute__((ext_vector_type(2)));
typedef float f32x2_t __attribute__((ext_vector_type(2)));
__device__ __forceinline__ unsigned cvt_pk_bf16(float lo, float hi) { const f32x2_t f = {lo, hi}; const bf16x2_t b = __builtin_convertvector(f, bf16x2_t); return __builtin_bit_cast(unsigned, b); }
__device__ __forceinline__ int get_tid() { int t = threadIdx.x; asm volatile("" : "+v"(t)); return t; }
__device__ __forceinline__ float bf2f(bf16_t v) { return __uint_as_float(((unsigned)v) << 16); }
__device__ __forceinline__ float bflo(unsigned w) { return __uint_as_float(w << 16); }
__device__ __forceinline__ float bfhi(unsigned w) { return __uint_as_float(w & 0xffff0000u); }
__device__ __forceinline__ float row_rstd(const float* ssq, int row) { const f32x4* p4 = (const f32x4*)(ssq + (size_t)row * 16); const f32x4 a = p4[0], b = p4[1], c = p4[2], d = p4[3];
    const f32x4 t = (a + b) + (c + d); return rsqrtf(((t[0] + t[1]) + (t[2] + t[3])) * (1.f / 1024.f) + EPS); }
__device__ __forceinline__ float fast_exp(float x) { return __builtin_amdgcn_exp2f(x * 1.4426950408889634f); }
__device__ __forceinline__ float silu_f(float x) { return x * __builtin_amdgcn_rcpf(1.f + __builtin_amdgcn_exp2f(-1.4426950408889634f * x)); }

namespace pg8 {
constexpr int BM = 256, BK = 64, HALF = 128, HTB = HALF * BK * 2, STAGE_BYTES = 8 * HTB, NXCD = 8, WGM = 8;
__host__ __device__ __forceinline__ int lds_byte(int r, int c) { const int st = (r >> 4) * 2 + (c >> 5), rr = r & 15, cc = c & 31, ob = rr * 64 + cc * 2; return st * 1024 + (ob ^ (((ob >> 9) & 1) << 5)); }
__host__ __device__ __forceinline__ void stage_rc(int b, int& R, int& C) { const int st = b / 1024, sb = b % 1024, swz = sb ^ (((sb >> 9) & 1) << 5); R = (st >> 1) * 16 + swz / 64; C = (st & 1) * 32 + (swz % 64) / 2; }
__host__ __device__ __forceinline__ int perm32(int rho) { const int n = rho >> 4, i = rho & 15; return 8 * (i >> 2) + 4 * n + (i & 3); }
struct Unit { int pm, pn; };
struct Gemm { const bf16_t* A; const bf16_t* Bt; int M, N, K; };
struct StaticOrder {
    int nM, nN, nwg, G, c;
    __device__ void init(int M, int N, int G_, int c_) { nM = M / BM; nN = N / BM; nwg = nM * nN; G = G_; c = c_; }
    __device__ bool next(int i, Unit& u) const {
        const long L = (long)i * G + c; if (L >= nwg) return false;
        int wgid = (int)L; { const int q = nwg / NXCD, r = nwg % NXCD, xcd = wgid % NXCD, off = wgid / NXCD; wgid = (xcd < r ? xcd * (q + 1) : r * (q + 1) + (xcd - r) * q) + off; }
        const int nig = WGM * nN, gid = wgid / nig, fm = gid * WGM, gsz = (nM - fm) < WGM ? (nM - fm) : WGM;
        u.pm = fm + ((wgid % nig) % gsz); u.pn = (wgid % nig) / gsz; return true;
    }
};
template <class Epi>
__device__ __forceinline__ void gemm_phase(ldsp lds, const Gemm g, const StaticOrder& S, const Epi& E) {
    const int tid = get_tid(), wid = __builtin_amdgcn_readfirstlane(tid >> 6), lane = tid & 63, wr = wid >> 2, wc = wid & 3, fr = lane & 15, fq = lane >> 4;
    const int K = g.K, nt = K / BK;
    unsigned voffA[2], voffB[2];
#pragma unroll
    for (int i = 0; i < 2; ++i) { int R, C; stage_rc(tid * 16 + i * 8192, R, C); const int Rb = Epi::PERM ? ((R & ~31) + perm32(R & 31)) : R;
        voffA[i] = (unsigned)(R * K + C) * 2u; voffB[i] = (unsigned)(Rb * K + C) * 2u; }
    const size_t kstep = (size_t)(BK * 2);
    const size_t hstep = (size_t)HALF * K * 2;
    const size_t tstep = 2 * hstep;
    const unsigned ldsw = (unsigned)wid * 1024u;
    const int aoff = lds_byte(wr * 64 + fr, fq * 8), boff = lds_byte(wc * 32 + fr, fq * 8);
#define PG8_SA(b, h) (((b) * 2 + (h)) * HTB)
#define PG8_SB(b, h) ((4 + (b) * 2 + (h)) * HTB)
#define PG8_STAGE(bufoff, gbase, voff) do { _Pragma("unroll") for (int _i = 0; _i < 2; ++_i) \
        __builtin_amdgcn_global_load_lds((const unsigned*)((const char*)(gbase) + (voff)[_i]), (LAS unsigned*)(lds + (bufoff) + ldsw + _i * 8192), 16, 0, 0); } while (0)
#define PG8_LDA(dst, b, h) do { _Pragma("unroll") for (int m = 0; m < 4; ++m) _Pragma("unroll") for (int k = 0; k < 2; ++k) dst[m][k] = *(const LAS bf16x8*)(lds + PG8_SA(b, h) + aoff + m * 2048 + k * 1024); } while (0)
#define PG8_LDB(dst, b, h) do { _Pragma("unroll") for (int n = 0; n < 2; ++n) _Pragma("unroll") for (int k = 0; k < 2; ++k) dst[n][k] = *(const LAS bf16x8*)(lds + PG8_SB(b, h) + boff + n * 2048 + k * 1024); } while (0)
#define PG8_MMA(ai, bj, At, Bt) do { __builtin_amdgcn_s_setprio(1); _Pragma("unroll") for (int m = 0; m < 4; ++m) _Pragma("unroll") for (int n = 0; n < 2; ++n) _Pragma("unroll") for (int k = 0; k < 2; ++k) \
        acc[ai][bj][m][n] = __builtin_amdgcn_mfma_f32_16x16x32_bf16(Bt[n][k], At[m][k], acc[ai][bj][m][n], 0, 0, 0); __builtin_amdgcn_s_setprio(0); } while (0)
#define PG8_WAIT_V(n) asm volatile("s_waitcnt vmcnt(" #n ")" ::: "memory")
#define PG8_WAIT_L(n) asm volatile("s_waitcnt lgkmcnt(" #n ")" ::: "memory")
#define PG8_BAR __builtin_amdgcn_s_barrier()
#define PG8_SCHED __builtin_amdgcn_sched_barrier(0)
    Unit cur, nxt; int ui = 0;
    if (!S.next(0, cur)) return;
    f32x4 acc[2][2][4][2];
#pragma unroll
    for (int a = 0; a < 2; ++a)
#pragma unroll
        for (int b = 0; b < 2; ++b)
#pragma unroll
            for (int m = 0; m < 4; ++m)
#pragma unroll
                for (int n = 0; n < 2; ++n) acc[a][b][m][n] = (f32x4){0.f, 0.f, 0.f, 0.f};
    bf16x8 At[4][2], B0[2][2], B1[2][2];
    const char* cA = (const char*)g.A + (size_t)cur.pm * tstep; const char* cB = (const char*)g.Bt + (size_t)cur.pn * tstep;
    PG8_STAGE(PG8_SB(0, 0), cB, voffB); PG8_STAGE(PG8_SA(0, 0), cA, voffA); PG8_STAGE(PG8_SB(0, 1), cB + hstep, voffB); PG8_STAGE(PG8_SA(0, 1), cA + hstep, voffA);
    if (wr == 1) PG8_BAR;
    PG8_WAIT_V(4); PG8_BAR;
    PG8_STAGE(PG8_SB(1, 0), cB + kstep, voffB); PG8_STAGE(PG8_SA(1, 0), cA + kstep, voffA); PG8_STAGE(PG8_SB(1, 1), cB + hstep + kstep, voffB);
    PG8_WAIT_V(6); PG8_BAR;
    for (;;) {
        const bool has_next = S.next(ui + 1, nxt);
        const char* nA = has_next ? (const char*)g.A + (size_t)nxt.pm * tstep : cA; const char* nB = has_next ? (const char*)g.Bt + (size_t)nxt.pn * tstep : cB;
        for (int t = 0; t < nt; t += 2) {
            const bool last = (t == nt - 2);
            const char* a1 = cA + (size_t)(t + 1) * kstep;
            const char* a2 = last ? nA : cA + (size_t)(t + 2) * kstep; const char* b2 = last ? nB : cB + (size_t)(t + 2) * kstep;
            const char* a3 = a2 + kstep; const char* b3 = b2 + kstep;
            PG8_LDB(B0, 0, 0); PG8_SCHED; PG8_LDA(At, 0, 0); PG8_STAGE(PG8_SA(1, 1), a1 + hstep, voffA);
            PG8_WAIT_L(8); PG8_BAR; PG8_WAIT_L(0); PG8_MMA(0, 0, At, B0); PG8_BAR; PG8_SCHED;
            PG8_LDB(B1, 0, 1); PG8_STAGE(PG8_SB(0, 0), b2, voffB);
            PG8_BAR; PG8_WAIT_L(0); PG8_MMA(0, 1, At, B1); PG8_BAR;
            PG8_LDA(At, 0, 1); PG8_STAGE(PG8_SA(0, 0), a2, voffA);
            PG8_BAR; PG8_WAIT_L(0); PG8_MMA(1, 0, At, B0); PG8_BAR; PG8_SCHED;
            PG8_STAGE(PG8_SB(0, 1), b2 + hstep, voffB);
            PG8_WAIT_V(6); PG8_BAR; PG8_MMA(1, 1, At, B1); PG8_BAR;
            PG8_LDB(B0, 1, 0); PG8_SCHED; PG8_LDA(At, 1, 0); PG8_STAGE(PG8_SA(0, 1), a2 + hstep, voffA);
            PG8_WAIT_L(8); PG8_BAR; PG8_WAIT_L(0); PG8_MMA(0, 0, At, B0); PG8_BAR; PG8_SCHED;
            PG8_LDB(B1, 1, 1); PG8_STAGE(PG8_SB(1, 0), b3, voffB);
            PG8_BAR; PG8_WAIT_L(0); PG8_MMA(0, 1, At, B1); PG8_BAR;
            PG8_LDA(At, 1, 1); PG8_STAGE(PG8_SA(1, 0), a3, voffA);
            PG8_BAR; PG8_WAIT_L(0); PG8_MMA(1, 0, At, B0); PG8_BAR; PG8_SCHED;
            PG8_STAGE(PG8_SB(1, 1), b3 + hstep, voffB);
            PG8_WAIT_V(6); PG8_BAR; PG8_MMA(1, 1, At, B1); PG8_BAR;
        }
        E(acc, cur, wr, wc, fr, fq);
        if (!has_next) break;
#pragma unroll
        for (int a = 0; a < 2; ++a)
#pragma unroll
            for (int b = 0; b < 2; ++b)
#pragma unroll
                for (int m = 0; m < 4; ++m)
#pragma unroll
                    for (int n = 0; n < 2; ++n) acc[a][b][m][n] = (f32x4){0.f, 0.f, 0.f, 0.f};
        cur = nxt; cA = nA; cB = nB; ++ui;
    }
    PG8_WAIT_V(0);
    if (wr == 0) PG8_BAR;
    PG8_BAR;
#undef PG8_SA
#undef PG8_SB
#undef PG8_STAGE
#undef PG8_LDA
#undef PG8_LDB
#undef PG8_MMA
#undef PG8_WAIT_V
#undef PG8_WAIT_L
#undef PG8_BAR
#undef PG8_SCHED
}
}

typedef f32x4 AccT[2][2][4][2];

struct EpiSwiGLU { static constexpr bool PERM = true;
    bf16_t* act; const float* ssq;
    __device__ __forceinline__ void operator()(const AccT& acc, const pg8::Unit& u, int wr, int wc, int fr, int fq) const {
        const int row0 = u.pm * 256 + wr * 64 + fr, col0 = u.pn * 128 + wc * 32 + 8 * fq;
#pragma unroll
        for (int ai = 0; ai < 2; ++ai)
#pragma unroll
            for (int m = 0; m < 4; ++m) { const int row = row0 + ai * 128 + m * 16; const float s = row_rstd(ssq, row);
                float a[8];
#pragma unroll
                for (int n = 0; n < 2; ++n)
#pragma unroll
                    for (int j = 0; j < 4; ++j) a[n * 4 + j] = silu_f(acc[ai][0][m][n][j] * s) * (acc[ai][1][m][n][j] * s);
                u32x4 w; w.x = cvt_pk_bf16(a[0], a[1]); w.y = cvt_pk_bf16(a[2], a[3]); w.z = cvt_pk_bf16(a[4], a[5]); w.w = cvt_pk_bf16(a[6], a[7]);
                *(u32x4*)(act + (size_t)row * FF + col0) = w; }
    }
};
struct EpiResid { static constexpr bool PERM = false;
    const float* resid; const float* resid0; float* h; bf16_t* hb; float* ssq; float alpha;
    __device__ __forceinline__ void operator()(const AccT& acc, const pg8::Unit& u, int wr, int wc, int fr, int fq) const {
        const int row0 = u.pm * 256 + wr * 64 + fr, col0 = u.pn * 256 + wc * 32 + 4 * fq;
        const float* rbase = (u.pm == 0) ? resid0 : resid;
#pragma unroll
        for (int ai = 0; ai < 2; ++ai)
#pragma unroll
            for (int m = 0; m < 4; ++m) { const int row = row0 + ai * 128 + m * 16; const size_t off = (size_t)row * DM + col0; float ss = 0.f;
#pragma unroll
                for (int bj = 0; bj < 2; ++bj)
#pragma unroll
                    for (int n = 0; n < 2; ++n) { const int o2 = bj * 128 + n * 16; const f32x4 r = *(const f32x4*)(rbase + off + o2); const f32x4 v = r + alpha * acc[ai][bj][m][n];
                        *(f32x4*)(h + off + o2) = v; u32x2 w; w.x = cvt_pk_bf16(v[0], v[1]); w.y = cvt_pk_bf16(v[2], v[3]); *(u32x2*)(hb + off + o2) = w;
                        ss += (v[0] * v[0] + v[1] * v[1]) + (v[2] * v[2] + v[3] * v[3]); }
                ss += __shfl_xor(ss, 16); ss += __shfl_xor(ss, 32);
                if (fq == 0) ssq[(size_t)row * 16 + u.pn * 4 + wc] = ss; }
    }
};
struct EpiGlaIn { static constexpr bool PERM = true;
    bf16_t *q, *k, *v, *r; float *gf, *gb; const float* ssq; const float* gbias;
    __device__ __forceinline__ void operator()(const AccT& acc, const pg8::Unit& u, int wr, int wc, int fr, int fq) const {
        const int row0 = u.pm * 256 + wr * 64 + fr, cin0 = wc * 32 + 8 * fq, pn = u.pn;
#pragma unroll
        for (int ai = 0; ai < 2; ++ai)
#pragma unroll
            for (int m = 0; m < 4; ++m) { const int row = row0 + ai * 128 + m * 16; float s = row_rstd(ssq, row);
                if (pn < 2) s *= 0.08838834764831845f;
#pragma unroll
                for (int bj = 0; bj < 2; ++bj) { const int c = cin0 + 128 * bj; const f32x4 v0 = acc[ai][bj][m][0] * s, v1 = acc[ai][bj][m][1] * s;
                    if (pn < 12) {
                        bf16_t* dst;
                        if (pn < 2) dst = q + (size_t)row * 512 + pn * 256 + c; else if (pn < 4) dst = k + (size_t)row * 512 + (pn - 2) * 256 + c;
                        else if (pn < 8) dst = v + (size_t)row * 1024 + (pn - 4) * 256 + c; else dst = r + (size_t)row * 1024 + (pn - 8) * 256 + c;
                        u32x4 w; w.x = cvt_pk_bf16(v0[0], v0[1]); w.y = cvt_pk_bf16(v0[2], v0[3]); w.z = cvt_pk_bf16(v1[0], v1[1]); w.w = cvt_pk_bf16(v1[2], v1[3]);
                        *(u32x4*)dst = w;
                    } else {
                        const int dir = (pn - 12) >> 1, gc = ((pn - 12) & 1) * 256 + c; const float* bp = gbias + dir * 512 + gc;
                        const f32x4 b0 = *(const f32x4*)bp, b1 = *(const f32x4*)(bp + 4); f32x4 o0, o1;
#pragma unroll
                        for (int j = 0; j < 4; ++j) { const float z0 = v0[j] + b0[j], z1 = v1[j] + b1[j];
                            o0[j] = (fminf(z0, 0.f) - __logf(1.f + __expf(-fabsf(z0)))) * 0.0625f; o1[j] = (fminf(z1, 0.f) - __logf(1.f + __expf(-fabsf(z1)))) * 0.0625f; }
                        float* dst = (dir ? gb : gf) + (size_t)row * 512 + gc; *(f32x4*)dst = o0; *(f32x4*)(dst + 4) = o1;
                    } } }
    }
};
struct EpiAttnIn { static constexpr bool PERM = true;
    bf16_t *q, *k, *v; const float* ssq;
    __device__ __forceinline__ void operator()(const AccT& acc, const pg8::Unit& u, int wr, int wc, int fr, int fq) const {
        const int row0 = u.pm * 256 + wr * 64 + fr, cin0 = wc * 32 + 8 * fq, pn = u.pn;
#pragma unroll
        for (int ai = 0; ai < 2; ++ai)
#pragma unroll
            for (int m = 0; m < 4; ++m) { const int row = row0 + ai * 128 + m * 16; const float s = row_rstd(ssq, row);
#pragma unroll
                for (int bj = 0; bj < 2; ++bj) { const int c = cin0 + 128 * bj; const f32x4 v0 = acc[ai][bj][m][0] * s, v1 = acc[ai][bj][m][1] * s;
                    bf16_t* dst = (pn < 4) ? q + (size_t)row * 1024 + pn * 256 + c : (pn == 4 ? k + (size_t)row * 256 + c : v + (size_t)row * 256 + c);
                    u32x4 w; w.x = cvt_pk_bf16(v0[0], v0[1]); w.y = cvt_pk_bf16(v0[2], v0[3]); w.z = cvt_pk_bf16(v1[0], v1[1]); w.w = cvt_pk_bf16(v1[2], v1[3]);
                    *(u32x4*)dst = w; } }
    }
};

template <class F>
__device__ __forceinline__ void xpose_tiles(ldsp lds, int K, int N, F val, bf16_t* dst, int rmode, int rbase) {
    LAS float* T = (LAS float*)lds; const int tid = get_tid(), nkt = K / 64, nnt = N / 64;
    for (int t = blockIdx.x; t < nkt * nnt; t += gridDim.x) {
        const int kt = t % nkt, ntl = t / nkt, k0 = kt * 64, n0 = ntl * 64;
#pragma unroll
        for (int ps = 0; ps < 2; ++ps) { const int kr = (tid >> 4) + ps * 32, nc = (tid & 15) * 4; const f32x4 v = val(k0 + kr, n0 + nc);
            T[kr * 65 + nc] = v[0]; T[kr * 65 + nc + 1] = v[1]; T[kr * 65 + nc + 2] = v[2]; T[kr * 65 + nc + 3] = v[3]; }
        __syncthreads();
        { const int n = tid >> 3, k8 = (tid & 7) * 8; float x[8];
#pragma unroll
            for (int j = 0; j < 8; ++j) x[j] = T[(k8 + j) * 65 + n];
            const int gn = n0 + n, dr = (rmode ? ((gn >> 7) * 256 + (gn & 127)) : gn) + rbase;
            u32x4 w; w.x = cvt_pk_bf16(x[0], x[1]); w.y = cvt_pk_bf16(x[2], x[3]); w.z = cvt_pk_bf16(x[4], x[5]); w.w = cvt_pk_bf16(x[6], x[7]);
            *(u32x4*)(dst + (size_t)dr * K + k0 + k8) = w; }
        __syncthreads();
    }
}
struct ValPlain { const float* src; int ld; const float* gain;
    __device__ __forceinline__ f32x4 operator()(int k, int n) const { f32x4 v = *(const f32x4*)(src + (size_t)k * ld + n); if (gain) v = v * gain[k]; return v; } };
struct ValGate { const float* w1; const float* w2; const float* gain;
    __device__ __forceinline__ f32x4 operator()(int k, int n) const { f32x4 a = {0.f, 0.f, 0.f, 0.f};
#pragma unroll
        for (int r = 0; r < 16; ++r) a += w1[k * 16 + r] * *(const f32x4*)(w2 + r * 512 + n);
        return a * gain[k]; } };

__device__ __forceinline__ void phase_prep(const Params& p, ldsp lds) {
    unsigned char* ws = p.ws; const int tid = get_tid(), lane = tid & 63, wid = tid >> 6;
    float* ssq = (float*)(ws + WS_SSQ); float* h = (float*)(ws + WS_H); bf16_t* hb = (bf16_t*)(ws + WS_HB);
    for (int r = blockIdx.x * 8 + wid; r < MROWS; r += gridDim.x * 8) {
        const float* src = (r < R0) ? p.in[1] + (size_t)(r & 15) * DM : p.in[0] + (size_t)(r - R0) * DM; float ss = 0.f;
#pragma unroll
        for (int i = 0; i < 4; ++i) { const int c = i * 256 + lane * 4; const f32x4 v = *(const f32x4*)(src + c);
            u32x2 w; w.x = cvt_pk_bf16(v[0], v[1]); w.y = cvt_pk_bf16(v[2], v[3]); *(u32x2*)(hb + (size_t)r * DM + c) = w;
            if (r < R0 || DIAG) *(f32x4*)(h + (size_t)r * DM + c) = v;
            ss += (v[0] * v[0] + v[1] * v[1]) + (v[2] * v[2] + v[3] * v[3]); }
#pragma unroll
        for (int o = 32; o >= 1; o >>= 1) ss += __shfl_xor(ss, o);
        if (lane < 16) ssq[(size_t)r * 16 + lane] = lane == 0 ? ss : 0.f;
        if (DIAG == 1 && lane < 16) ssq[(size_t)6 * MROWS * 16 + (size_t)r * 16 + lane] = lane == 0 ? ss : 0.f;
    }
    for (int f = 0; f < 4; ++f) { const int li = f >> 1; const bool second = f & 1;
        const float* wg = p.in[second ? 18 : 3] + (size_t)li * DM * FF; const float* wu = p.in[second ? 19 : 4] + (size_t)li * DM * FF;
        const float* wd = p.in[second ? 20 : 5] + (size_t)li * FF * DM; const float* gn = p.in[second ? 17 : 2] + li * DM;
        bf16_t* dgu = (bf16_t*)(ws + WS_WGU + f * SZ_WGU); bf16_t* dd = (bf16_t*)(ws + WS_WD + f * SZ_WD);
        xpose_tiles(lds, DM, FF, ValPlain{wg, FF, gn}, dgu, 1, 0);
        xpose_tiles(lds, DM, FF, ValPlain{wu, FF, gn}, dgu, 1, 128);
        xpose_tiles(lds, FF, DM, ValPlain{wd, DM, nullptr}, dd, 0, 0);
    }
    xpose_tiles(lds, DM, 3072, ValPlain{p.in[7], 3072, p.in[6]}, (bf16_t*)(ws + WS_WGIN), 0, 0);
    xpose_tiles(lds, DM, 512, ValGate{p.in[8], p.in[9], p.in[6]}, (bf16_t*)(ws + WS_WGIN), 0, 3072);
    xpose_tiles(lds, DM, 512, ValGate{p.in[8] + DM * 16, p.in[9] + 16 * 512, p.in[6]}, (bf16_t*)(ws + WS_WGIN), 0, 3584);
    xpose_tiles(lds, DM, DM, ValPlain{p.in[12], DM, nullptr}, (bf16_t*)(ws + WS_WGOUT), 0, 0);
    xpose_tiles(lds, DM, 1536, ValPlain{p.in[13], 1536, p.in[6] + DM}, (bf16_t*)(ws + WS_WAIN), 0, 0);
    xpose_tiles(lds, DM, DM, ValPlain{p.in[16], DM, nullptr}, (bf16_t*)(ws + WS_WAOUT), 0, 0);
}

__device__ __forceinline__ int gla_row(int b, int c, int to) { return c == 0 ? (to >= 48 ? b * 16 + (to - 48) : -1) : R0 + b * SEQ + (c - 1) * 64 + to; }
__device__ __forceinline__ bf16x8 ld8(ldsp base, int off) { return *(const LAS bf16x8*)(base + off); }

__device__ __forceinline__ void phase_gla_seq(const Params& p, ldsp lds) {
    constexpr int PBF = 528, PQ = 272, PT = 144;
    constexpr int OFF_BF = 0, OFF_QD = 33792, OFF_KI = OFF_QD + 17408, OFF_KET = OFF_KI + 17408, OFF_VT = OFF_KET + 18432, OFF_AM = OFF_VT + 9216,
                  OFF_ST = OFF_AM + 9216, OFF_PART = OFF_ST + 2 * 17408, OFF_DEC = OFF_PART + 2048;
    static_assert(OFF_DEC + 512 <= LDS_BYTES, "gla lds");
    unsigned char* ws = p.ws;
    const bf16_t* qb = (const bf16_t*)((unsigned char*)p.out + O_GQ); const bf16_t* kb = (const bf16_t*)(ws + U_GK); const bf16_t* vb = (const bf16_t*)(ws + U_GV);
    const float* gfp = (const float*)((unsigned char*)p.out + O_GF); const float* gbp = (const float*)(ws + U_GB);
    bf16_t* obuf = (bf16_t*)(ws + WS_HB);
    const int tid = get_tid(), lane = tid & 63, wid = __builtin_amdgcn_readfirstlane(tid >> 6), fr = lane & 15, fq = lane >> 4;
    const int dcol = tid & 127, qtr = tid >> 7;
    const int trow = tid >> 3, seg = tid & 7;
    for (int item = blockIdx.x; item < 256; item += gridDim.x) {
        const int b = item >> 4, hd = (item >> 2) & 3, vs = item & 3;
        float gcol[16]; bf16_t kcol[16]; u32x4 rq0, rq1, rk0, rk1, rv;
        f32x4 accS[4];
#define GLA_LOAD(dir_, c_) do { const float* G_ = (dir_) ? gbp : gfp; \
        _Pragma("unroll") for (int i = 0; i < 16; ++i) { const int to_ = qtr * 16 + i; const int r_ = gla_row(b, (c_), to_); \
            gcol[i] = r_ >= 0 ? G_[(size_t)r_ * 512 + hd * 128 + dcol] : 0.f; kcol[i] = r_ >= 0 ? kb[(size_t)r_ * 512 + hd * 128 + dcol] : (bf16_t)0; } \
        { const int to_ = trow; const int r_ = gla_row(b, (c_), to_); const u32x4 z_ = {0u, 0u, 0u, 0u}; \
          if (r_ >= 0) { const bf16_t* qp_ = qb + (size_t)r_ * 512 + hd * 128 + seg * 16; const bf16_t* kp_ = kb + (size_t)r_ * 512 + hd * 128 + seg * 16; \
              rq0 = *(const u32x4*)qp_; rq1 = *(const u32x4*)(qp_ + 8); rk0 = *(const u32x4*)kp_; rk1 = *(const u32x4*)(kp_ + 8); \
              rv = *(const u32x4*)(vb + (size_t)r_ * 1024 + hd * 256 + vs * 64 + seg * 8); } \
          else { rq0 = z_; rq1 = z_; rk0 = z_; rk1 = z_; rv = z_; } } } while (0)
        GLA_LOAD(0, 0);
        for (int step = 0; step < (FWDONLY ? 65 : 130); ++step) {
            const int dir = step >= 65, ci = dir ? step - 65 : step, c = dir ? 64 - ci : ci, cur = step & 1;
            if (ci == 0) {
#pragma unroll
                for (int i = 0; i < 4; ++i) accS[i] = (f32x4){0.f, 0.f, 0.f, 0.f};
                for (int i = tid; i < 17408 / 4; i += 512) *(LAS unsigned*)(lds + OFF_ST + cur * 17408 + i * 4) = 0u;
            }
            float bl[16]; float run = 0.f;
            if (dir == 0) {
#pragma unroll
                for (int i = 0; i < 16; ++i) { run += gcol[i]; bl[i] = run; }
            } else {
#pragma unroll
                for (int i = 15; i >= 0; --i) { run += gcol[i]; bl[i] = run; }
            }
            *(LAS float*)(lds + OFF_PART + (qtr * 128 + dcol) * 4) = run;
            { const unsigned vw[4] = {rv.x, rv.y, rv.z, rv.w};
#pragma unroll
              for (int i = 0; i < 4; ++i) { *(LAS bf16_t*)(lds + OFF_VT + (seg * 8 + 2 * i) * PT + trow * 2) = (bf16_t)(vw[i] & 0xffffu);
                  *(LAS bf16_t*)(lds + OFF_VT + (seg * 8 + 2 * i + 1) * PT + trow * 2) = (bf16_t)(vw[i] >> 16); } }
            __syncthreads();
            float offp = 0.f, tot = 0.f;
#pragma unroll
            for (int q2 = 0; q2 < 4; ++q2) { const float pv = *(LAS float*)(lds + OFF_PART + (q2 * 128 + dcol) * 4); tot += pv; if (dir ? (q2 > qtr) : (q2 < qtr)) offp += pv; }
            { float ke[16];
#pragma unroll
              for (int i = 0; i < 16; ++i) { const float bv = bl[i] + offp; *(LAS float*)(lds + OFF_BF + (qtr * 16 + i) * PBF + dcol * 4) = bv; ke[i] = bf2f(kcol[i]) * fast_exp(tot - bv); }
              u32x4 w0, w1; w0.x = cvt_pk_bf16(ke[0], ke[1]); w0.y = cvt_pk_bf16(ke[2], ke[3]); w0.z = cvt_pk_bf16(ke[4], ke[5]); w0.w = cvt_pk_bf16(ke[6], ke[7]);
              w1.x = cvt_pk_bf16(ke[8], ke[9]); w1.y = cvt_pk_bf16(ke[10], ke[11]); w1.z = cvt_pk_bf16(ke[12], ke[13]); w1.w = cvt_pk_bf16(ke[14], ke[15]);
              *(LAS u32x4*)(lds + OFF_KET + dcol * PT + qtr * 32) = w0; *(LAS u32x4*)(lds + OFF_KET + dcol * PT + qtr * 32 + 16) = w1;
              if (qtr == 0) *(LAS float*)(lds + OFF_DEC + dcol * 4) = fast_exp(tot); }
            __syncthreads();
            { const unsigned qw[8] = {rq0.x, rq0.y, rq0.z, rq0.w, rq1.x, rq1.y, rq1.z, rq1.w}, kw[8] = {rk0.x, rk0.y, rk0.z, rk0.w, rk1.x, rk1.y, rk1.z, rk1.w};
              unsigned qo[8], ko[8];
#pragma unroll
              for (int i = 0; i < 4; ++i) { const f32x4 bv = *(const LAS f32x4*)(lds + OFF_BF + trow * PBF + (seg * 16 + i * 4) * 4);
#pragma unroll
                  for (int j = 0; j < 2; ++j) { const float e0 = fast_exp(bv[2 * j]), e1 = fast_exp(bv[2 * j + 1]); const unsigned qq = qw[i * 2 + j], kk = kw[i * 2 + j];
                      qo[i * 2 + j] = cvt_pk_bf16(bflo(qq) * e0, bfhi(qq) * e1); ko[i * 2 + j] = cvt_pk_bf16(bflo(kk) * __builtin_amdgcn_rcpf(e0), bfhi(kk) * __builtin_amdgcn_rcpf(e1)); } }
              *(LAS u32x4*)(lds + OFF_QD + trow * PQ + seg * 32) = (u32x4){qo[0], qo[1], qo[2], qo[3]}; *(LAS u32x4*)(lds + OFF_QD + trow * PQ + seg * 32 + 16) = (u32x4){qo[4], qo[5], qo[6], qo[7]};
              *(LAS u32x4*)(lds + OFF_KI + trow * PQ + seg * 32) = (u32x4){ko[0], ko[1], ko[2], ko[3]}; *(LAS u32x4*)(lds + OFF_KI + trow * PQ + seg * 32 + 16) = (u32x4){ko[4], ko[5], ko[6], ko[7]}; }
            if (step + 1 < 130) { const int s2 = step + 1, dir2 = s2 >= 65, ci2 = dir2 ? s2 - 65 : s2, c2 = dir2 ? 64 - ci2 : ci2; GLA_LOAD(dir2, c2); }
            __syncthreads();
#pragma unroll
            for (int xx = 0; xx < 2; ++xx) { const int x = 2 * wid + xx, si = x >> 2, ti = x & 3; f32x4 a4 = {0.f, 0.f, 0.f, 0.f};
                if (dir ? (si >= ti) : (si <= ti)) {
#pragma unroll
                    for (int kk = 0; kk < 4; ++kk) a4 = __builtin_amdgcn_mfma_f32_16x16x32_bf16(ld8(lds, OFF_KI + (si * 16 + fr) * PQ + kk * 64 + fq * 16), ld8(lds, OFF_QD + (ti * 16 + fr) * PQ + kk * 64 + fq * 16), a4, 0, 0, 0);
#pragma unroll
                    for (int i = 0; i < 4; ++i) { const int sd = si * 16 + 4 * fq + i - (ti * 16 + fr); if (dir ? (sd < 0) : (sd > 0)) a4[i] = 0.f; }
                }
                u32x2 w; w.x = cvt_pk_bf16(a4[0], a4[1]); w.y = cvt_pk_bf16(a4[2], a4[3]);
                *(LAS u32x2*)(lds + OFF_AM + (ti * 16 + fr) * PT + (si * 16 + 4 * fq) * 2) = w; }
            __syncthreads();
#pragma unroll
            for (int xx = 0; xx < 2; ++xx) { const int x = 2 * wid + xx, vi = x >> 2, ti = x & 3; f32x4 a4 = {0.f, 0.f, 0.f, 0.f};
#pragma unroll
                for (int kk = 0; kk < 2; ++kk) a4 = __builtin_amdgcn_mfma_f32_16x16x32_bf16(ld8(lds, OFF_VT + (vi * 16 + fr) * PT + kk * 64 + fq * 16), ld8(lds, OFF_AM + (ti * 16 + fr) * PT + kk * 64 + fq * 16), a4, 0, 0, 0);
#pragma unroll
                for (int kk = 0; kk < 4; ++kk) a4 = __builtin_amdgcn_mfma_f32_16x16x32_bf16(ld8(lds, OFF_ST + cur * 17408 + (vi * 16 + fr) * PQ + kk * 64 + fq * 16), ld8(lds, OFF_QD + (ti * 16 + fr) * PQ + kk * 64 + fq * 16), a4, 0, 0, 0);
                const int to = ti * 16 + fr; const int r = gla_row(b, c, to);
                if (r >= 0) { bf16_t* op = obuf + (size_t)r * 1024 + hd * 256 + vs * 64 + vi * 16 + 4 * fq;
                    if (dir && !NOADD) { const u32x2 pr = *(const u32x2*)op; a4[0] += bflo(pr.x); a4[1] += bfhi(pr.x); a4[2] += bflo(pr.y); a4[3] += bfhi(pr.y); }
                    u32x2 w; w.x = cvt_pk_bf16(a4[0], a4[1]); w.y = cvt_pk_bf16(a4[2], a4[3]); *(u32x2*)op = w; } }
            { const f32x4 dc = *(const LAS f32x4*)(lds + OFF_DEC + (16 * wid + 4 * fq) * 4);
#pragma unroll
              for (int vbk = 0; vbk < 4; ++vbk) { accS[vbk] = accS[vbk] * dc;
#pragma unroll
                  for (int kk = 0; kk < 2; ++kk) accS[vbk] = __builtin_amdgcn_mfma_f32_16x16x32_bf16(ld8(lds, OFF_KET + (16 * wid + fr) * PT + kk * 64 + fq * 16), ld8(lds, OFF_VT + (vbk * 16 + fr) * PT + kk * 64 + fq * 16), accS[vbk], 0, 0, 0);
                  u32x2 w; w.x = cvt_pk_bf16(accS[vbk][0], accS[vbk][1]); w.y = cvt_pk_bf16(accS[vbk][2], accS[vbk][3]);
                  *(LAS u32x2*)(lds + OFF_ST + (cur ^ 1) * 17408 + (vbk * 16 + fr) * PQ + (16 * wid + 4 * fq) * 2) = w; } }
            __syncthreads();
        }
#undef GLA_LOAD
    }
}

__device__ __forceinline__ void phase_gla_post(const Params& p) {
    unsigned char* ws = p.ws; const bf16_t* o = (const bf16_t*)(ws + WS_HB); const bf16_t* r = (const bf16_t*)(ws + U_GR); bf16_t* og = (bf16_t*)(ws + U_GV);
    const float* hn = p.in[11]; const int tid = get_tid(), lane = tid & 63, wid = tid >> 6;
    float g[16];
#pragma unroll
    for (int i = 0; i < 16; ++i) g[i] = hn[(lane & 15) * 16 + i];
    for (int row = blockIdx.x * 8 + wid; row < MROWS; row += gridDim.x * 8) {
        const size_t off = (size_t)row * 1024 + lane * 16;
        const u32x4 o0 = *(const u32x4*)(o + off), o1 = *(const u32x4*)(o + off + 8), r0 = *(const u32x4*)(r + off), r1 = *(const u32x4*)(r + off + 8);
        const unsigned ow[8] = {o0.x, o0.y, o0.z, o0.w, o1.x, o1.y, o1.z, o1.w}, rw[8] = {r0.x, r0.y, r0.z, r0.w, r1.x, r1.y, r1.z, r1.w};
        float x[16]; float ss = 0.f;
#pragma unroll
        for (int i = 0; i < 8; ++i) { x[2 * i] = bflo(ow[i]); x[2 * i + 1] = bfhi(ow[i]); ss += x[2 * i] * x[2 * i] + x[2 * i + 1] * x[2 * i + 1]; }
        ss += __shfl_xor(ss, 1); ss += __shfl_xor(ss, 2); ss += __shfl_xor(ss, 4); ss += __shfl_xor(ss, 8);
        const float rs = rsqrtf(ss * (1.f / 256.f) + EPS); unsigned w[8];
#pragma unroll
        for (int i = 0; i < 8; ++i) w[i] = cvt_pk_bf16(x[2 * i] * rs * g[2 * i] * silu_f(bflo(rw[i])), x[2 * i + 1] * rs * g[2 * i + 1] * silu_f(bfhi(rw[i])));
        *(u32x4*)(og + off) = (u32x4){w[0], w[1], w[2], w[3]}; *(u32x4*)(og + off + 8) = (u32x4){w[4], w[5], w[6], w[7]};
    }
}

__device__ __forceinline__ void phase_attn_prep(const Params& p) {
    unsigned char* ws = p.ws; bf16_t* q = (bf16_t*)(ws + U_AQ); bf16_t* k = (bf16_t*)(ws + U_AK); bf16_t* ao = (bf16_t*)(ws + U_AO);
    const float* qn = p.in[14]; const float* kn = p.in[15]; const int tid = get_tid(), lane = tid & 63, wid = tid >> 6;
    for (size_t i = (size_t)blockIdx.x * 512 + tid; i < (size_t)R0 * 1024 / 2; i += (size_t)gridDim.x * 512) ((unsigned*)ao)[i] = 0u;
    const int ax = lane >> 5, fi = lane & 31, da = ax * 64 + fi, db = da + 32;
    const float invf = __builtin_amdgcn_exp2f(-(float)fi * (2.0f / 64.0f) * 13.287712379549449f);
    const float qga = qn[da], qgb = qn[db], kga = kn[da], kgb = kn[db];
    for (int row = blockIdx.x * 8 + wid; row < MROWS; row += gridDim.x * 8) {
        float cs = 1.f, sn = 0.f;
        if (row >= R0) { const int pp = (row - R0) & 4095; const float t = (float)(ax ? (pp & 63) : (pp >> 6)); float rev = t * invf * 0.15915494309189535f; rev -= floorf(rev);
            sn = __builtin_amdgcn_sinf(rev); cs = __builtin_amdgcn_cosf(rev); }
#pragma unroll
        for (int hh = 0; hh < 10; ++hh) { bf16_t* base = hh < 8 ? q + (size_t)row * 1024 + hh * 128 : k + (size_t)row * 256 + (hh - 8) * 128;
            const float xa = bf2f(base[da]), xb = bf2f(base[db]); float ss = xa * xa + xb * xb;
#pragma unroll
            for (int o = 32; o >= 1; o >>= 1) ss += __shfl_xor(ss, o);
            const float rs = rsqrtf(ss * (1.f / 128.f) + EPS); const float ya = xa * rs * (hh < 8 ? qga : kga), yb = xb * rs * (hh < 8 ? qgb : kgb);
            const unsigned w = cvt_pk_bf16(ya * cs - yb * sn, yb * cs + ya * sn);
            base[da] = (bf16_t)(w & 0xffffu); base[db] = (bf16_t)(w >> 16); }
    }
}

__device__ __forceinline__ void phase_final(const Params& p) {
    unsigned char* ws = p.ws; const float* h = (const float*)(ws + WS_H); const float* ssq = (const float*)(ws + WS_SSQ) + 6 * (size_t)MROWS * 16; const float* gn = p.in[21];
    const int tid = get_tid(), lane = tid & 63, wid = tid >> 6;
    f32x4 g[4];
#pragma unroll
    for (int i = 0; i < 4; ++i) g[i] = *(const f32x4*)(gn + i * 256 + lane * 4);
    for (int row = R0 + blockIdx.x * 8 + wid; row < MROWS; row += gridDim.x * 8) { const float s = row_rstd(ssq, row);
#pragma unroll
        for (int i = 0; i < 4; ++i) { const int c = i * 256 + lane * 4; *(f32x4*)(p.out + (size_t)(row - R0) * DM + c) = *(const f32x4*)(h + (size_t)row * DM + c) * s * g[i]; } }
}

namespace att {
constexpr int D = 128, KVBLK = 64, LDQ = 1024, LDK = 256, LDO = 1024;
constexpr float SCALE = 0.088388347648318440f, THR = 8.f;
constexpr size_t SHM_V = KVBLK * D * 2, SHM_K = KVBLK * D * 2, SHM_ATTN = 2 * SHM_V + 2 * SHM_K + 8 * 64 * 4;
#define KSWZ(row, colB) ((row) * 256 + ((colB) ^ (((row) & 7) << 4)))
#define SBAR() __builtin_amdgcn_sched_barrier(0)
__device__ __forceinline__ int crow(int r, int hi) { return (r & 3) + 8 * (r >> 2) + 4 * hi; }
__device__ __forceinline__ void partialSM(f32x16& p0, f32x16& p1, float& m_reg, float& mn, float& alpha) {
  constexpr float C = SCALE * 1.4426950408889634f;
  float pmax = p0[0]; for (int r = 1; r < 16; ++r) pmax = fmaxf(pmax, p0[r]); for (int r = 0; r < 16; ++r) pmax = fmaxf(pmax, p1[r]);
  { auto rr = __builtin_amdgcn_permlane32_swap(__float_as_uint(pmax), __float_as_uint(pmax), false, false);
    pmax = fmaxf(__uint_as_float(rr[0]), __uint_as_float(rr[1])); }
  if (__builtin_expect(__all(pmax - m_reg <= THR / SCALE), 1)) { mn = m_reg; alpha = 1.f; }
  else { mn = fmaxf(m_reg, pmax); alpha = __builtin_amdgcn_exp2f((m_reg - mn) * C); m_reg = mn; }
  float mnC = -mn * C;
  for (int r = 0; r < 16; ++r) p0[r] = fmaf(p0[r], C, mnC); for (int r = 0; r < 16; ++r) p1[r] = fmaf(p1[r], C, mnC);
  for (int r = 0; r < 16; ++r) p0[r] = __builtin_amdgcn_exp2f(p0[r]);
}
__device__ __forceinline__ void finishSM(f32x16& p0, f32x16& p1, float alpha, float& l_reg, bf16x8& pa0, bf16x8& pa1, bf16x8& pa2, bf16x8& pa3) {
  for (int r = 0; r < 16; ++r) p1[r] = __builtin_amdgcn_exp2f(p1[r]);
  float ps = 0; for (int r = 0; r < 16; ++r) ps += p0[r]; for (int r = 0; r < 16; ++r) ps += p1[r];
  { auto rr = __builtin_amdgcn_permlane32_swap(__float_as_uint(ps), __float_as_uint(ps), false, false);
    ps = __uint_as_float(rr[0]) + __uint_as_float(rr[1]); }
  l_reg = l_reg * alpha + ps;
#define PK4(P, BASE, OUT) do { unsigned a0 = cvt_pk_bf16(P[BASE + 0], P[BASE + 1]), a1 = cvt_pk_bf16(P[BASE + 2], P[BASE + 3]);   \
    unsigned b0 = cvt_pk_bf16(P[BASE + 4], P[BASE + 5]), b1 = cvt_pk_bf16(P[BASE + 6], P[BASE + 7]);                              \
    auto r0 = __builtin_amdgcn_permlane32_swap(a0, b0, false, false); auto r1 = __builtin_amdgcn_permlane32_swap(a1, b1, false, false); \
    u32x4 w = {r0[0], r1[0], r0[1], r1[1]}; OUT = *reinterpret_cast<bf16x8*>(&w); } while (0)
  PK4(p0, 0, pa0); PK4(p0, 8, pa1); PK4(p1, 0, pa2); PK4(p1, 8, pa3);
#undef PK4
}
__device__ __forceinline__ void qkt(f32x16& p0, f32x16& p1, const char* Ks, const bf16x8* qr, int r32, int hi) {
  p0 = f32x16{}; p1 = f32x16{};
  for (int d0 = 0; d0 < 8; ++d0) { int cb = (d0 * 16 + hi * 8) * 2;
    bf16x8 b0 = *reinterpret_cast<const bf16x8*>(Ks + KSWZ(r32, cb));
    bf16x8 b1 = *reinterpret_cast<const bf16x8*>(Ks + KSWZ(32 + r32, cb));
    p0 = __builtin_amdgcn_mfma_f32_32x32x16_bf16(b0, qr[d0], p0, 0, 0, 0);
    p1 = __builtin_amdgcn_mfma_f32_32x32x16_bf16(b1, qr[d0], p1, 0, 0, 0); }
}
__device__ __forceinline__ int v_st(int k, int c) { const int kk = (k & ~0xC) | ((k & 4) << 1) | ((k & 8) >> 1); return ((kk >> 3) * 4 + (c >> 5)) * 512 + ((kk & 7) * 32 + (c & 31)) * 2; }
__device__ __forceinline__ int v_rd_base(int lane) { return ((lane & 3) << 3) | (((lane >> 2) & 3) << 6) | (((lane >> 4) & 1) << 5) | (((lane >> 5) & 1) << 8); }
constexpr int v_rd_off(int d0, int ks, int half) { return d0 * 512 + ks * 4096 + half * 2048; }
template <int OFF> __device__ __forceinline__ s16x4 tr_read(int vb) {
  s16x4 r; asm volatile("ds_read_b64_tr_b16 %0, %1 offset:%2" : "=&v"(r) : "v"(vb), "i"(OFF) : "memory"); return r;
}
template <int D0> __device__ __forceinline__ void pv_one(f32x16& od, int vb, bf16x8 pa0, bf16x8 pa1, bf16x8 pa2, bf16x8 pa3) {
  const s16x4 l0 = tr_read<v_rd_off(D0, 0, 0)>(vb), h0 = tr_read<v_rd_off(D0, 0, 1)>(vb), l1 = tr_read<v_rd_off(D0, 1, 0)>(vb), h1 = tr_read<v_rd_off(D0, 1, 1)>(vb);
  const s16x4 l2 = tr_read<v_rd_off(D0, 2, 0)>(vb), h2 = tr_read<v_rd_off(D0, 2, 1)>(vb), l3 = tr_read<v_rd_off(D0, 3, 0)>(vb), h3 = tr_read<v_rd_off(D0, 3, 1)>(vb);
  asm volatile("s_waitcnt lgkmcnt(0)" ::: "memory"); SBAR();
#define PK(L, H) (bf16x8){L[0], L[1], L[2], L[3], H[0], H[1], H[2], H[3]}
  od = __builtin_amdgcn_mfma_f32_32x32x16_bf16(pa0, PK(l0, h0), od, 0, 0, 0);
  od = __builtin_amdgcn_mfma_f32_32x32x16_bf16(pa1, PK(l1, h1), od, 0, 0, 0);
  od = __builtin_amdgcn_mfma_f32_32x32x16_bf16(pa2, PK(l2, h2), od, 0, 0, 0);
  od = __builtin_amdgcn_mfma_f32_32x32x16_bf16(pa3, PK(l3, h3), od, 0, 0, 0);
#undef PK
}
__device__ __forceinline__ void pv_d0(f32x16* o, int vb, bf16x8 pa0, bf16x8 pa1, bf16x8 pa2, bf16x8 pa3) {
  pv_one<0>(o[0], vb, pa0, pa1, pa2, pa3); pv_one<1>(o[1], vb, pa0, pa1, pa2, pa3); pv_one<2>(o[2], vb, pa0, pa1, pa2, pa3); pv_one<3>(o[3], vb, pa0, pa1, pa2, pa3);
}
__device__ __forceinline__ void attn_body(const bf16_t* Qb, const bf16_t* K0, const bf16_t* V0, const bf16_t* K1, const bf16_t* V1, bf16_t* Ob, char* lds) {
  constexpr int NT = 65;
  const int tid = get_tid(), wid = tid >> 6, lane = tid & 63, r32 = lane & 31, hi = lane >> 5;
  char* V_lds = lds; char* K_lds = lds + 2 * SHM_V;
  float* wsf = (float*)(lds + 2 * SHM_V + 2 * SHM_K) + wid * 64; float* li_l = wsf; float* al_l = wsf + 32;
  float m_reg = -1e30f, l_reg = 0; f32x16 o[4] = {}; bf16x8 qr[8];
  const bf16_t* Qw = Qb + (long)(wid * 32 + r32) * LDQ + hi * 8;
#pragma unroll
  for (int d0 = 0; d0 < 8; ++d0) qr[d0] = *reinterpret_cast<const bf16x8*>(Qw + d0 * 16);
  const int sr = tid >> 4, sc = (tid & 15) * 8, vst0 = v_st(sr, sc), vst1 = v_st(32 + sr, sc);
  const int vb0 = (int)(uintptr_t)V_lds + v_rd_base(lane);
  struct { bf16x8 vs0, vs1, ks0, ks1; } sr_[2];
#define TKP(T) ((T) == 0 ? K0 : K1 + (long)((T) - 1) * 64 * LDK)
#define TVP(T) ((T) == 0 ? V0 : V1 + (long)((T) - 1) * 64 * LDK)
#define SLOAD(i, T) do { const bf16_t* kp_ = TKP(T); const bf16_t* vp_ = TVP(T); \
    sr_[i].vs0 = *reinterpret_cast<const bf16x8*>(&vp_[(long)(sr) * LDK + sc]); sr_[i].vs1 = *reinterpret_cast<const bf16x8*>(&vp_[(long)(32 + sr) * LDK + sc]); \
    sr_[i].ks0 = *reinterpret_cast<const bf16x8*>(&kp_[(long)(sr) * LDK + sc]); sr_[i].ks1 = *reinterpret_cast<const bf16x8*>(&kp_[(long)(32 + sr) * LDK + sc]); } while (0)
#define SWRITE(b, i) do { *(bf16x8*)(V_lds + (b) * SHM_V + vst0) = sr_[i].vs0;          \
    *(bf16x8*)(V_lds + (b) * SHM_V + vst1) = sr_[i].vs1; int kc = sc * 2;               \
    *(bf16x8*)(K_lds + (b) * SHM_K + KSWZ(sr, kc)) = sr_[i].ks0;                       \
    *(bf16x8*)(K_lds + (b) * SHM_K + KSWZ(32 + sr, kc)) = sr_[i].ks1; } while (0)
#define SWAIT() asm volatile("s_waitcnt vmcnt(4)" ::: "memory")
#define RESC(a) do { if (__any((a) < 1.f)) { if (hi == 0) al_l[r32] = (a); asm volatile("s_waitcnt lgkmcnt(0)" ::: "memory"); \
    for (int d = 0; d < 4; ++d) for (int r = 0; r < 16; ++r) o[d][r] *= al_l[crow(r, hi)]; } } while (0)
  f32x16 pA0, pA1, pB0, pB1; float mnA, mnB, alA, alB; bf16x8 pa0, pa1, pa2, pa3;
  constexpr int SE = 0, SO = 1;
  SLOAD(SE, 0); asm volatile("s_waitcnt vmcnt(0)" ::: "memory"); SWRITE(0, SE); __syncthreads();
  qkt(pA0, pA1, K_lds, qr, r32, hi);
#pragma unroll
  for (int r = 8; r < 16; ++r) pA0[r] = -1e30f;
#pragma unroll
  for (int r = 0; r < 16; ++r) pA1[r] = -1e30f;
  partialSM(pA0, pA1, m_reg, mnA, alA);
  SLOAD(SO, 1); SLOAD(SE, 2);
  SWAIT(); SWRITE(1, SO); __syncthreads();
  for (int j = 1; j + 1 < NT; j += 2) {
    SBAR(); qkt(pB0, pB1, K_lds + SHM_K, qr, r32, hi);
    finishSM(pA0, pA1, alA, l_reg, pa0, pa1, pa2, pa3); SBAR();
    if (j + 2 < NT) SLOAD(SO, j + 2); SBAR();
    pv_d0(o, vb0, pa0, pa1, pa2, pa3); partialSM(pB0, pB1, m_reg, mnB, alB);
    __syncthreads(); SWAIT(); SWRITE(0, SE);
    RESC(alB); __syncthreads();
    SBAR(); qkt(pA0, pA1, K_lds, qr, r32, hi);
    finishSM(pB0, pB1, alB, l_reg, pa0, pa1, pa2, pa3); SBAR();
    if (j + 3 < NT) SLOAD(SE, j + 3); SBAR();
    pv_d0(o, vb0 + (int)SHM_V, pa0, pa1, pa2, pa3); partialSM(pA0, pA1, m_reg, mnA, alA);
    __syncthreads(); SWAIT(); SWRITE(1, SO);
    RESC(alA); __syncthreads();
  }
  finishSM(pA0, pA1, alA, l_reg, pa0, pa1, pa2, pa3); SBAR();
  pv_d0(o, vb0, pa0, pa1, pa2, pa3);
  if (hi == 0) li_l[r32] = l_reg; asm volatile("s_waitcnt lgkmcnt(0)" ::: "memory");
  float rli[16];
#pragma unroll
  for (int r = 0; r < 16; ++r) rli[r] = __builtin_amdgcn_rcpf(li_l[crow(r, hi)]);
  bf16_t* Ow = Ob + (long)(wid * 32) * LDO;
#pragma unroll
  for (int r = 0; r < 16; ++r) { int orow = crow(r, hi);
    for (int d0 = 0; d0 < 4; ++d0) { const float v = o[d0][r] * rli[r]; Ow[(long)orow * LDO + d0 * 32 + r32] = (bf16_t)(cvt_pk_bf16(v, v) & 0xffffu); } }
#undef SLOAD
#undef SWRITE
#undef SWAIT
#undef RESC
#undef TKP
#undef TVP
}
}

__device__ __forceinline__ void phase_attn(const Params& p, char* lds) {
    unsigned char* ws = p.ws; const bf16_t* q = (const bf16_t*)(ws + U_AQ); const bf16_t* k = (const bf16_t*)(ws + U_AK); const bf16_t* v = (const bf16_t*)(ws + U_AV); bf16_t* ao = (bf16_t*)(ws + U_AO);
    for (int item = blockIdx.x; item < 2048; item += gridDim.x) {
        const int qb = item & 15, hh = (item >> 4) & 7, b = item >> 7, kvh = hh >> 2;
        const size_t qrow = (size_t)R0 + (size_t)b * SEQ + qb * 256;
        att::attn_body(q + qrow * 1024 + hh * 128, k + (size_t)(b * 16) * 256 + kvh * 128, v + (size_t)(b * 16) * 256 + kvh * 128,
                       k + ((size_t)R0 + (size_t)b * SEQ) * 256 + kvh * 128, v + ((size_t)R0 + (size_t)b * SEQ) * 256 + kvh * 128,
                       ao + qrow * 1024 + hh * 128, lds);
        __syncthreads();
    }
}

__global__ void __launch_bounds__(512, 1) mega_fwd(Params p) {
    extern __shared__ __attribute__((aligned(16))) unsigned char shm[];
    ldsp lds = (ldsp)shm;
    unsigned char* ws = p.ws;
    float* h = (float*)(ws + WS_H); bf16_t* hb = (bf16_t*)(ws + WS_HB); float* ssq = (float*)(ws + WS_SSQ);
    const int G = gridDim.x, c = blockIdx.x;
    for (int ph = p.lo; ph < p.hi; ++ph) {
        int kind, f = 0, nin = 0, nout = 0;
        switch (ph) {
            case 0: kind = 0; break;
            case 1: kind = 1; f = 0; nin = 0; break;
            case 2: kind = 2; f = 0; nout = (DIAG == 2) ? 6 : 1; break;
            case 3: kind = 3; nin = 1; break;
            case 4: kind = 4; break;
            case 5: kind = 5; break;
            case 6: kind = 2; f = 4; nout = (DIAG == 3) ? 6 : 2; break;
            case 7: kind = 1; f = 1; nin = 2; break;
            case 8: kind = 2; f = 1; nout = 3; break;
            case 9: kind = 1; f = 2; nin = 3; break;
            case 10: kind = 2; f = 2; nout = 4; break;
            case 11: kind = 6; nin = 4; break;
            case 12: kind = 7; break;
            case 13: kind = 8; break;
            case 14: kind = 2; f = 5; nout = 5; break;
            case 15: kind = 1; f = 3; nin = 5; break;
            case 16: kind = 2; f = 3; nout = 6; break;
            default: kind = 9; break;
        }
        if (!((PHMASK >> ph) & 1)) kind = 99;
        if (kind == 0) { if (KMASK & 1) phase_prep(p, lds); }
        else if (kind == 1 && (KMASK & 2)) {
            pg8::Gemm g{hb, (const bf16_t*)(ws + WS_WGU + f * SZ_WGU), MROWS, 2 * FF, DM}; pg8::StaticOrder S; S.init(MROWS, 2 * FF, G, c);
            EpiSwiGLU E{(bf16_t*)(ws + U_ACT), ssq + (size_t)nin * MROWS * 16};
            pg8::gemm_phase(lds, g, S, E);
        } else if (kind == 2 && (KMASK & 4)) {
            pg8::Gemm g; float alpha; const float* resid = h;
            if (f < 4) { g = pg8::Gemm{(const bf16_t*)(ws + U_ACT), (const bf16_t*)(ws + WS_WD + f * SZ_WD), MROWS, DM, FF}; alpha = 0.5f; if (ph == 2) resid = p.in[0] - (size_t)R0 * DM; }
            else if (f == 4) { g = pg8::Gemm{(const bf16_t*)(ws + U_GV), (const bf16_t*)(ws + WS_WGOUT), MROWS, DM, DM}; alpha = 1.f; }
            else { g = pg8::Gemm{(const bf16_t*)(ws + U_AO), (const bf16_t*)(ws + WS_WAOUT), MROWS, DM, DM}; alpha = 1.f; }
            pg8::StaticOrder S; S.init(MROWS, DM, G, c);
            EpiResid E{resid, h, h, hb, ssq + (size_t)nout * MROWS * 16, alpha};
            pg8::gemm_phase(lds, g, S, E);
        } else if (kind == 3 && (KMASK & 8)) {
            pg8::Gemm g{hb, (const bf16_t*)(ws + WS_WGIN), MROWS, 4096, DM}; pg8::StaticOrder S; S.init(MROWS, 4096, G, c);
            EpiGlaIn E{(bf16_t*)((unsigned char*)p.out + O_GQ), (bf16_t*)(ws + U_GK), (bf16_t*)(ws + U_GV), (bf16_t*)(ws + U_GR), (float*)((unsigned char*)p.out + O_GF), (float*)(ws + U_GB),
                       ssq + (size_t)nin * MROWS * 16, p.in[10]};
            pg8::gemm_phase(lds, g, S, E);
        } else if (kind == 4) { if (KMASK & 16) phase_gla_seq(p, lds); }
        else if (kind == 5) { if (KMASK & 32) phase_gla_post(p); }
        else if (kind == 6 && (KMASK & 64)) {
            pg8::Gemm g{hb, (const bf16_t*)(ws + WS_WAIN), MROWS, 1536, DM}; pg8::StaticOrder S; S.init(MROWS, 1536, G, c);
            EpiAttnIn E{(bf16_t*)(ws + U_AQ), (bf16_t*)(ws + U_AK), (bf16_t*)(ws + U_AV), ssq + (size_t)nin * MROWS * 16};
            pg8::gemm_phase(lds, g, S, E);
        } else if (kind == 7) { if (KMASK & 128) phase_attn_prep(p); }
        else if (kind == 8) { if (KMASK & 256) phase_attn(p, (char*)shm); }
        else if (kind == 9 && (KMASK & 512)) phase_final(p);
        if (ph + 1 < p.hi) cg::this_grid().sync();
    }
}

extern "C" void kernel_launch(void* const* d_in, const int* in_sizes, int n_in, void* d_out, int out_size, void* d_ws, size_t ws_size, hipStream_t stream) {
    static int grid = 0;
    if (grid == 0) {
        if (n_in != 22 || out_size != NB * SEQ * DM || ws_size < WS_NEED) { fprintf(stderr, "kernel_launch: unexpected shapes n_in %d out %d ws %zu (need %zu)\n", n_in, out_size, ws_size, (size_t)WS_NEED); grid = -1; return; }
        if (hipFuncSetAttribute((const void*)mega_fwd, hipFuncAttributeMaxDynamicSharedMemorySize, LDS_BYTES) != hipSuccess) { fprintf(stderr, "kernel_launch: hipFuncSetAttribute failed\n"); grid = -1; return; }
        int dev = 0, cus = 0, per_cu = 0;
        hipGetDevice(&dev); hipDeviceGetAttribute(&cus, hipDeviceAttributeMultiprocessorCount, dev);
        hipOccupancyMaxActiveBlocksPerMultiprocessor(&per_cu, (const void*)mega_fwd, 512, LDS_BYTES);
        if (per_cu < 1) { fprintf(stderr, "kernel_launch: occupancy query says %d blocks/CU\n", per_cu); per_cu = 1; }
        (void)hipGetLastError();
        grid = cus * per_cu;
    }
    if (grid < 0) return;
    Params p{};
    for (int i = 0; i < 22; ++i) p.in[i] = (const float*)d_in[i];
    p.out = (float*)d_out; p.ws = (unsigned char*)d_ws;
#if ONE_LAUNCH
    p.lo = 0; p.hi = NPHASE;
    void* args[] = {&p};
    hipError_t e = hipLaunchCooperativeKernel((const void*)mega_fwd, dim3(grid), dim3(512), args, LDS_BYTES, stream);
    if (e != hipSuccess) fprintf(stderr, "cooperative launch failed: %s (grid %d)\n", hipGetErrorString(e), grid);
#else
    for (int ph = 0; ph < NPHASE; ++ph) { p.lo = ph; p.hi = ph + 1; hipLaunchKernelGGL(mega_fwd, dim3(grid), dim3(512), LDS_BYTES, stream, p); }
#endif
}
```

```cpp
#include <hip/hip_runtime.h>
#include <hip/hip_cooperative_groups.h>
#include <cstdio>
namespace cg = cooperative_groups;

#ifndef TPROBE_MASK
#define TPROBE_MASK 0
#endif
#ifndef NOADD
#define NOADD 0
#endif
#ifndef FWDONLY
#define FWDONLY 0
#endif
#ifndef DIAG
#define DIAG 0
#endif
#ifndef PHMASK
#define PHMASK 0x3ffff
#endif
#ifndef KMASK
#define KMASK 1023
#endif
#ifndef ONE_LAUNCH
#define ONE_LAUNCH 1
#endif

#define LAS __attribute__((address_space(3)))
typedef unsigned short bf16_t;
typedef short bf16x8 __attribute__((ext_vector_type(8)));
typedef short s16x4 __attribute__((ext_vector_type(4)));
typedef float f32x4 __attribute__((ext_vector_type(4)));
typedef float f32x8 __attribute__((ext_vector_type(8)));
typedef float f32x16 __attribute__((ext_vector_type(16)));
typedef unsigned u32x4 __attribute__((ext_vector_type(4)));
typedef unsigned u32x2 __attribute__((ext_vector_type(2)));
typedef LAS unsigned char* ldsp;

constexpr int DM = 1024, FF = 2816, NB = 16, SEQ = 4096, NMETA = 16;
constexpr int MROWS = NB * NMETA + NB * SEQ;
constexpr int R0 = NB * NMETA;
constexpr float EPS = 1e-6f;
constexpr int LDS_BYTES = 152064;
constexpr int LDS_TOTAL = LDS_BYTES + 16;
constexpr int NPHASE = 18;

constexpr size_t SZ_H = (size_t)MROWS * DM * 4, SZ_HB = (size_t)MROWS * DM * 2, SZ_SSQ1 = (size_t)MROWS * 16 * 4;
constexpr size_t WS_H = 0, WS_HB = WS_H + SZ_H, WS_SSQ = WS_HB + SZ_HB, WS_W = WS_SSQ + 7 * SZ_SSQ1;
constexpr size_t SZ_WGU = (size_t)2 * FF * DM * 2, SZ_WD = (size_t)DM * FF * 2;
constexpr size_t WS_WGU = WS_W, WS_WD = WS_WGU + 4 * SZ_WGU, WS_WGIN = WS_WD + 4 * SZ_WD, WS_WGOUT = WS_WGIN + (size_t)4096 * DM * 2,
                 WS_WAIN = WS_WGOUT + (size_t)DM * DM * 2, WS_WAOUT = WS_WAIN + (size_t)1536 * DM * 2, WS_U = WS_WAOUT + (size_t)DM * DM * 2;
constexpr size_t U_ACT = WS_U;
constexpr size_t U_GB = WS_U, U_GK = U_GB + (size_t)MROWS * 512 * 4, U_GV = U_GK + (size_t)MROWS * 512 * 2, U_GR = U_GV + SZ_HB, U_GEND = U_GR + SZ_HB;
constexpr size_t U_AQ = WS_U, U_AK = U_AQ + SZ_HB, U_AV = U_AK + (size_t)MROWS * 256 * 2, U_AO = U_AV + (size_t)MROWS * 256 * 2, U_AEND = U_AO + SZ_HB;
constexpr size_t WS_NEED = (U_GEND > U_AEND ? U_GEND : U_AEND);
constexpr size_t WS_BAR = WS_NEED + 256, WS_END = WS_BAR + 16384;
constexpr size_t O_GF = 0, O_GQ = (size_t)MROWS * 512 * 4;

struct Params { const float* in[22]; float* out; unsigned char* ws; int lo, hi; };

typedef __bf16 bf16x2_t __attribute__((ext_vector_type(2)));
typedef float f32x2_t __attribute__((ext_vector_type(2)));
__device__ __forceinline__ unsigned cvt_pk_bf16(float lo, float hi) { const f32x2_t f = {lo, hi}; const bf16x2_t b = __builtin_convertvector(f, bf16x2_t); return __builtin_bit_cast(unsigned, b); }
__device__ __forceinline__ int get_tid() { int t = threadIdx.x; asm volatile("" : "+v"(t)); return t; }
__device__ __forceinline__ float bf2f(bf16_t v) { return __uint_as_float(((unsigned)v) << 16); }
__device__ __forceinline__ float bflo(unsigned w) { return __uint_as_float(w << 16); }
__device__ __forceinline__ float bfhi(unsigned w) { return __uint_as_float(w & 0xffff0000u); }
__device__ __forceinline__ float row_rstd(const float* ssq, int row) { const f32x4* p4 = (const f32x4*)(ssq + (size_t)row * 16); const f32x4 a = p4[0], b = p4[1], c = p4[2], d = p4[3];
    const f32x4 t = (a + b) + (c + d); return rsqrtf(((t[0] + t[1]) + (t[2] + t[3])) * (1.f / 1024.f) + EPS); }
__device__ __forceinline__ float fast_exp(float x) { return __builtin_amdgcn_exp2f(x * 1.4426950408889634f); }
__device__ __forceinline__ float silu_f(float x) { return x * __builtin_amdgcn_rcpf(1.f + __builtin_amdgcn_exp2f(-1.4426950408889634f * x)); }

namespace pg8 {
constexpr int BM = 256, BK = 64, HALF = 128, HTB = HALF * BK * 2, STAGE_BYTES = 8 * HTB, NXCD = 8, WGM = 8;
__host__ __device__ __forceinline__ int lds_byte(int r, int c) { const int st = (r >> 4) * 2 + (c >> 5), rr = r & 15, cc = c & 31, ob = rr * 64 + cc * 2; return st * 1024 + (ob ^ (((ob >> 9) & 1) << 5)); }
__host__ __device__ __forceinline__ void stage_rc(int b, int& R, int& C) { const int st = b / 1024, sb = b % 1024, swz = sb ^ (((sb >> 9) & 1) << 5); R = (st >> 1) * 16 + swz / 64; C = (st & 1) * 32 + (swz % 64) / 2; }
__host__ __device__ __forceinline__ int perm32(int rho) { const int n = rho >> 4, i = rho & 15; return 8 * (i >> 2) + 4 * n + (i & 3); }
struct Unit { int pm, pn; };
struct Gemm { const bf16_t* A; const bf16_t* Bt; int M, N, K; int atiled; };
struct StaticOrder {
    int nM, nN, nwg, G, c;
    __device__ void init(int M, int N, int G_, int c_) { nM = M / BM; nN = N / BM; nwg = nM * nN; G = G_; c = c_; }
    __device__ bool next(int i, Unit& u) const {
        const long L = (long)i * G + c; if (L >= nwg) return false;
        int wgid = (int)L; { const int q = nwg / NXCD, r = nwg % NXCD, xcd = wgid % NXCD, off = wgid / NXCD; wgid = (xcd < r ? xcd * (q + 1) : r * (q + 1) + (xcd - r) * q) + off; }
        const int nig = WGM * nN, gid = wgid / nig, fm = gid * WGM, gsz = (nM - fm) < WGM ? (nM - fm) : WGM;
        u.pm = fm + ((wgid % nig) % gsz); u.pn = (wgid % nig) / gsz; return true;
    }
};
template <class Epi>
__device__ __forceinline__ void gemm_phase(ldsp lds, const Gemm g, const StaticOrder& S, const Epi& E) {
    const int tid = get_tid(), wid = __builtin_amdgcn_readfirstlane(tid >> 6), lane = tid & 63, wr = wid >> 2, wc = wid & 3, fr = lane & 15, fq = lane >> 4;
    const int K = g.K, nt = K / BK;
    unsigned voffA[2], voffB[2];
#pragma unroll
    for (int i = 0; i < 2; ++i) { int R, C; stage_rc(tid * 16 + i * 8192, R, C); const int Rb = Epi::PERM ? ((R & ~31) + perm32(R & 31)) : R;
        voffA[i] = (unsigned)(R * (g.atiled ? BK : K) + C) * 2u; voffB[i] = (unsigned)(Rb * K + C) * 2u; }
    const size_t kstep = (size_t)(BK * 2);
    const size_t hstep = (size_t)HALF * K * 2;
    const size_t tstep = 2 * hstep;
    const size_t kstepA = g.atiled ? (size_t)BM * BK * 2 : kstep, hstepA = g.atiled ? (size_t)HALF * BK * 2 : hstep;
    const unsigned ldsw = (unsigned)wid * 1024u;
    const int aoff = lds_byte(wr * 64 + fr, fq * 8), boff = lds_byte(wc * 32 + fr, fq * 8);
#define PG8_SA(b, h) (((b) * 2 + (h)) * HTB)
#define PG8_SB(b, h) ((4 + (b) * 2 + (h)) * HTB)
#define PG8_STAGE(bufoff, gbase, voff) do { _Pragma("unroll") for (int _i = 0; _i < 2; ++_i) \
        __builtin_amdgcn_global_load_lds((const unsigned*)((const char*)(gbase) + (voff)[_i]), (LAS unsigned*)(lds + (bufoff) + ldsw + _i * 8192), 16, 0, 0); } while (0)
#define PG8_LDA(dst, b, h) do { _Pragma("unroll") for (int m = 0; m < 4; ++m) _Pragma("unroll") for (int k = 0; k < 2; ++k) dst[m][k] = *(const LAS bf16x8*)(lds + PG8_SA(b, h) + aoff + m * 2048 + k * 1024); } while (0)
#define PG8_LDB(dst, b, h) do { _Pragma("unroll") for (int n = 0; n < 2; ++n) _Pragma("unroll") for (int k = 0; k < 2; ++k) dst[n][k] = *(const LAS bf16x8*)(lds + PG8_SB(b, h) + boff + n * 2048 + k * 1024); } while (0)
#define PG8_MMA(ai, bj, At, Bt) do { __builtin_amdgcn_s_setprio(1); _Pragma("unroll") for (int m = 0; m < 4; ++m) _Pragma("unroll") for (int n = 0; n < 2; ++n) _Pragma("unroll") for (int k = 0; k < 2; ++k) \
        acc[ai][bj][m][n] = __builtin_amdgcn_mfma_f32_16x16x32_bf16(Bt[n][k], At[m][k], acc[ai][bj][m][n], 0, 0, 0); __builtin_amdgcn_s_setprio(0); } while (0)
#define PG8_WAIT_V(n) asm volatile("s_waitcnt vmcnt(" #n ")" ::: "memory")
#define PG8_WAIT_L(n) asm volatile("s_waitcnt lgkmcnt(" #n ")" ::: "memory")
#define PG8_BAR __builtin_amdgcn_s_barrier()
#define PG8_SCHED __builtin_amdgcn_sched_barrier(0)
    Unit cur, nxt; int ui = 0;
    if (!S.next(0, cur)) return;
    f32x4 acc[2][2][4][2];
#pragma unroll
    for (int a = 0; a < 2; ++a)
#pragma unroll
        for (int b = 0; b < 2; ++b)
#pragma unroll
            for (int m = 0; m < 4; ++m)
#pragma unroll
                for (int n = 0; n < 2; ++n) acc[a][b][m][n] = (f32x4){0.f, 0.f, 0.f, 0.f};
    bf16x8 At[4][2], B0[2][2], B1[2][2];
    const char* cA = (const char*)g.A + (size_t)cur.pm * tstep; const char* cB = (const char*)g.Bt + (size_t)cur.pn * tstep;
    PG8_STAGE(PG8_SB(0, 0), cB, voffB); PG8_STAGE(PG8_SA(0, 0), cA, voffA); PG8_STAGE(PG8_SB(0, 1), cB + hstep, voffB); PG8_STAGE(PG8_SA(0, 1), cA + hstepA, voffA);
    if (wr == 1) PG8_BAR;
    PG8_WAIT_V(4); PG8_BAR;
    PG8_STAGE(PG8_SB(1, 0), cB + kstep, voffB); PG8_STAGE(PG8_SA(1, 0), cA + kstepA, voffA); PG8_STAGE(PG8_SB(1, 1), cB + hstep + kstep, voffB);
    PG8_WAIT_V(6); PG8_BAR;
    for (;;) {
        const bool has_next = S.next(ui + 1, nxt);
        const char* nA = has_next ? (const char*)g.A + (size_t)nxt.pm * tstep : cA; const char* nB = has_next ? (const char*)g.Bt + (size_t)nxt.pn * tstep : cB;
        for (int t = 0; t < nt; t += 2) {
            const bool last = (t == nt - 2);
            const char* a1 = cA + (size_t)(t + 1) * kstepA;
            const char* a2 = last ? nA : cA + (size_t)(t + 2) * kstepA; const char* b2 = last ? nB : cB + (size_t)(t + 2) * kstep;
            const char* a3 = a2 + kstepA; const char* b3 = b2 + kstep;
            PG8_LDB(B0, 0, 0); PG8_SCHED; PG8_LDA(At, 0, 0); PG8_STAGE(PG8_SA(1, 1), a1 + hstepA, voffA);
            PG8_WAIT_L(8); PG8_BAR; PG8_WAIT_L(0); PG8_MMA(0, 0, At, B0); PG8_BAR; PG8_SCHED;
            PG8_LDB(B1, 0, 1); PG8_STAGE(PG8_SB(0, 0), b2, voffB);
            PG8_BAR; PG8_WAIT_L(0); PG8_MMA(0, 1, At, B1); PG8_BAR;
            PG8_LDA(At, 0, 1); PG8_STAGE(PG8_SA(0, 0), a2, voffA);
            PG8_BAR; PG8_WAIT_L(0); PG8_MMA(1, 0, At, B0); PG8_BAR; PG8_SCHED;
            PG8_STAGE(PG8_SB(0, 1), b2 + hstep, voffB);
            PG8_WAIT_V(6); PG8_BAR; PG8_MMA(1, 1, At, B1); PG8_BAR;
            PG8_LDB(B0, 1, 0); PG8_SCHED; PG8_LDA(At, 1, 0); PG8_STAGE(PG8_SA(0, 1), a2 + hstepA, voffA);
            PG8_WAIT_L(8); PG8_BAR; PG8_WAIT_L(0); PG8_MMA(0, 0, At, B0); PG8_BAR; PG8_SCHED;
            PG8_LDB(B1, 1, 1); PG8_STAGE(PG8_SB(1, 0), b3, voffB);
            PG8_BAR; PG8_WAIT_L(0); PG8_MMA(0, 1, At, B1); PG8_BAR;
            PG8_LDA(At, 1, 1); PG8_STAGE(PG8_SA(1, 0), a3, voffA);
            PG8_BAR; PG8_WAIT_L(0); PG8_MMA(1, 0, At, B0); PG8_BAR; PG8_SCHED;
            PG8_STAGE(PG8_SB(1, 1), b3 + hstep, voffB);
            PG8_WAIT_V(6); PG8_BAR; PG8_MMA(1, 1, At, B1); PG8_BAR;
        }
        E(acc, cur, wr, wc, fr, fq);
        if (!has_next) break;
#pragma unroll
        for (int a = 0; a < 2; ++a)
#pragma unroll
            for (int b = 0; b < 2; ++b)
#pragma unroll
                for (int m = 0; m < 4; ++m)
#pragma unroll
                    for (int n = 0; n < 2; ++n) acc[a][b][m][n] = (f32x4){0.f, 0.f, 0.f, 0.f};
        cur = nxt; cA = nA; cB = nB; ++ui;
    }
    PG8_WAIT_V(0);
    if (wr == 0) PG8_BAR;
    PG8_BAR;
#undef PG8_SA
#undef PG8_SB
#undef PG8_STAGE
#undef PG8_LDA
#undef PG8_LDB
#undef PG8_MMA
#undef PG8_WAIT_V
#undef PG8_WAIT_L
#undef PG8_BAR
#undef PG8_SCHED
}
}

typedef f32x4 AccT[2][2][4][2];

constexpr int RS_OFF = 131072, RS_SLOTS = 8, RS_TAG = RS_OFF + RS_SLOTS * 256 * 4, GB_OFF = RS_TAG + 64;
static_assert(GB_OFF + 4096 <= LDS_BYTES, "rstd table + gate bias");
__device__ __forceinline__ void rstd_table_build(ldsp lds, const pg8::StaticOrder& S, const float* ssq, int pmoff) {
    const int tid = get_tid(); int nslot = 0, last = -1; pg8::Unit u;
    for (int i = 0; S.next(i, u); ++i) if (u.pm != last) { last = u.pm;
        if (nslot < RS_SLOTS) { if (tid < 256) *(LAS float*)(lds + RS_OFF + (nslot * 256 + tid) * 4) = row_rstd(ssq, (u.pm + pmoff) * 256 + tid); if (tid == 0) *(LAS int*)(lds + RS_TAG + nslot * 4) = u.pm; }
        ++nslot; }
    if (tid < RS_SLOTS && tid >= nslot) *(LAS int*)(lds + RS_TAG + tid * 4) = -1;
    __syncthreads();
}
__device__ __forceinline__ void rstd_rows(ldsp lds, const float* ssq, int pm, int pmoff, int wr, int fr, float (&rs)[8]) {
    int slot = -1;
#pragma unroll
    for (int k = 0; k < RS_SLOTS; ++k) if (*(const LAS int*)(lds + RS_TAG + k * 4) == pm) slot = k;
    if (slot >= 0) {
#pragma unroll
        for (int ai = 0; ai < 2; ++ai)
#pragma unroll
            for (int m = 0; m < 4; ++m) rs[ai * 4 + m] = *(const LAS float*)(lds + RS_OFF + (slot * 256 + ai * 128 + wr * 64 + m * 16 + fr) * 4);
    } else {
#pragma unroll
        for (int ai = 0; ai < 2; ++ai)
#pragma unroll
            for (int m = 0; m < 4; ++m) rs[ai * 4 + m] = row_rstd(ssq, (pm + pmoff) * 256 + ai * 128 + wr * 64 + m * 16 + fr);
    }
}

struct EpiSwiGLU { static constexpr bool PERM = true;
    bf16_t* act; const float* ssq; int pmoff; ldsp lds;
    __device__ __forceinline__ void operator()(const AccT& acc, const pg8::Unit& u, int wr, int wc, int fr, int fq) const {
        const int row0 = (u.pm + pmoff) * 256 + wr * 64 + fr, col0 = u.pn * 128 + wc * 32 + 8 * fq;
        float rs[8]; rstd_rows(lds, ssq, u.pm, pmoff, wr, fr, rs);
#pragma unroll
        for (int ai = 0; ai < 2; ++ai)
#pragma unroll
            for (int m = 0; m < 4; ++m) { const int row = row0 + ai * 128 + m * 16; const float s = rs[ai * 4 + m];
                float a[8];
#pragma unroll
                for (int n = 0; n < 2; ++n)
#pragma unroll
                    for (int j = 0; j < 4; ++j) a[n * 4 + j] = silu_f(acc[ai][0][m][n][j] * s) * (acc[ai][1][m][n][j] * s);
                u32x4 w; w.x = cvt_pk_bf16(a[0], a[1]); w.y = cvt_pk_bf16(a[2], a[3]); w.z = cvt_pk_bf16(a[4], a[5]); w.w = cvt_pk_bf16(a[6], a[7]);
                *(u32x4*)(act + ((size_t)((row >> 8) * (FF / 64) + (col0 >> 6)) * 256 + (row & 255)) * 64 + (col0 & 63)) = w; }
    }
};
struct EpiResid { static constexpr bool PERM = true;
    const float* x32; bf16_t* hb; float* ssq; float alpha; int pmoff;
    __device__ __forceinline__ void operator()(const AccT& acc, const pg8::Unit& u, int wr, int wc, int fr, int fq) const {
        const int row0 = (u.pm + pmoff) * 256 + wr * 64 + fr, col0 = u.pn * 256 + wc * 32 + 8 * fq;
        const bool fromx = (x32 != nullptr) && (u.pm + pmoff != 0);
        if (fromx) {
#pragma unroll
            for (int ai = 0; ai < 2; ++ai)
#pragma unroll
                for (int mh = 0; mh < 2; ++mh) { f32x4 rf[2][2][2];
#pragma unroll
                    for (int mm = 0; mm < 2; ++mm)
#pragma unroll
                        for (int bj = 0; bj < 2; ++bj) { const float* xp = x32 + (size_t)(row0 + ai * 128 + (mh * 2 + mm) * 16) * DM + col0 + bj * 128; rf[mm][bj][0] = *(const f32x4*)xp; rf[mm][bj][1] = *(const f32x4*)(xp + 4); }
#pragma unroll
                    for (int mm = 0; mm < 2; ++mm) { const int m = mh * 2 + mm; const int row = row0 + ai * 128 + m * 16; const size_t off = (size_t)row * DM + col0; float ss = 0.f;
#pragma unroll
                        for (int bj = 0; bj < 2; ++bj) { float v[8];
#pragma unroll
                            for (int n = 0; n < 2; ++n)
#pragma unroll
                                for (int j = 0; j < 4; ++j) { v[n * 4 + j] = rf[mm][bj][n][j] + alpha * acc[ai][bj][m][n][j]; ss += v[n * 4 + j] * v[n * 4 + j]; }
                            u32x4 w; w.x = cvt_pk_bf16(v[0], v[1]); w.y = cvt_pk_bf16(v[2], v[3]); w.z = cvt_pk_bf16(v[4], v[5]); w.w = cvt_pk_bf16(v[6], v[7]);
                            *(u32x4*)(hb + off + bj * 128) = w; }
                        ss += __shfl_xor(ss, 16); ss += __shfl_xor(ss, 32);
                        if (fq == 0) ssq[(size_t)row * 16 + u.pn * 4 + wc] = ss; } }
        } else {
#pragma unroll
            for (int ai = 0; ai < 2; ++ai) { u32x4 rw[4][2];
#pragma unroll
                for (int m = 0; m < 4; ++m)
#pragma unroll
                    for (int bj = 0; bj < 2; ++bj) rw[m][bj] = *(const u32x4*)(hb + (size_t)(row0 + ai * 128 + m * 16) * DM + col0 + bj * 128);
#pragma unroll
                for (int m = 0; m < 4; ++m) { const int row = row0 + ai * 128 + m * 16; const size_t off = (size_t)row * DM + col0; float ss = 0.f;
#pragma unroll
                    for (int bj = 0; bj < 2; ++bj) { const u32x4 t = rw[m][bj]; const float r[8] = {bflo(t.x), bfhi(t.x), bflo(t.y), bfhi(t.y), bflo(t.z), bfhi(t.z), bflo(t.w), bfhi(t.w)}; float v[8];
#pragma unroll
                        for (int n = 0; n < 2; ++n)
#pragma unroll
                            for (int j = 0; j < 4; ++j) { v[n * 4 + j] = r[n * 4 + j] + alpha * acc[ai][bj][m][n][j]; ss += v[n * 4 + j] * v[n * 4 + j]; }
                        u32x4 w; w.x = cvt_pk_bf16(v[0], v[1]); w.y = cvt_pk_bf16(v[2], v[3]); w.z = cvt_pk_bf16(v[4], v[5]); w.w = cvt_pk_bf16(v[6], v[7]);
                        *(u32x4*)(hb + off + bj * 128) = w; }
                    ss += __shfl_xor(ss, 16); ss += __shfl_xor(ss, 32);
                    if (fq == 0) ssq[(size_t)row * 16 + u.pn * 4 + wc] = ss; } }
        }
    }
};
struct EpiGlaIn { static constexpr bool PERM = true;
    bf16_t *q, *k, *v, *r; float *gf, *gb; const float* ssq; const float* gbias; ldsp lds;
    __device__ __forceinline__ void operator()(const AccT& acc, const pg8::Unit& u, int wr, int wc, int fr, int fq) const {
        const int row0 = u.pm * 256 + wr * 64 + fr, cin0 = wc * 32 + 8 * fq, pn = u.pn;
        float rs[8]; rstd_rows(lds, ssq, u.pm, 0, wr, fr, rs);
#pragma unroll
        for (int ai = 0; ai < 2; ++ai)
#pragma unroll
            for (int m = 0; m < 4; ++m) { const int row = row0 + ai * 128 + m * 16; float s = rs[ai * 4 + m];
                if (pn < 2) s *= 0.08838834764831845f;
#pragma unroll
                for (int bj = 0; bj < 2; ++bj) { const int c = cin0 + 128 * bj; const f32x4 v0 = acc[ai][bj][m][0] * s, v1 = acc[ai][bj][m][1] * s;
                    if (pn < 12) {
                        bf16_t* dst;
                        if (pn < 2) dst = q + (size_t)row * 512 + pn * 256 + c; else if (pn < 4) dst = k + (size_t)row * 512 + (pn - 2) * 256 + c;
                        else if (pn < 8) dst = v + (size_t)row * 1024 + (pn - 4) * 256 + c; else dst = r + (size_t)row * 1024 + (pn - 8) * 256 + c;
                        u32x4 w; w.x = cvt_pk_bf16(v0[0], v0[1]); w.y = cvt_pk_bf16(v0[2], v0[3]); w.z = cvt_pk_bf16(v1[0], v1[1]); w.w = cvt_pk_bf16(v1[2], v1[3]);
                        *(u32x4*)dst = w;
                    } else {
                        const int dir = (pn - 12) >> 1, gc = ((pn - 12) & 1) * 256 + c;
                        const f32x4 b0 = *(const LAS f32x4*)(lds + GB_OFF + (dir * 512 + gc) * 4), b1 = *(const LAS f32x4*)(lds + GB_OFF + (dir * 512 + gc + 4) * 4); f32x4 o0, o1;
#pragma unroll
                        for (int j = 0; j < 4; ++j) { const float z0 = v0[j] + b0[j], z1 = v1[j] + b1[j];
                            o0[j] = (fminf(z0, 0.f) - __logf(1.f + __expf(-fabsf(z0)))) * 0.0625f; o1[j] = (fminf(z1, 0.f) - __logf(1.f + __expf(-fabsf(z1)))) * 0.0625f; }
                        float* dst = (dir ? gb : gf) + (size_t)row * 512 + gc; *(f32x4*)dst = o0; *(f32x4*)(dst + 4) = o1;
                    } } }
    }
};
struct EpiAttnIn { static constexpr bool PERM = true;
    bf16_t *q, *k, *v; const float* ssq; ldsp lds;
    __device__ __forceinline__ void operator()(const AccT& acc, const pg8::Unit& u, int wr, int wc, int fr, int fq) const {
        const int row0 = u.pm * 256 + wr * 64 + fr, cin0 = wc * 32 + 8 * fq, pn = u.pn;
        float rs[8]; rstd_rows(lds, ssq, u.pm, 0, wr, fr, rs);
#pragma unroll
        for (int ai = 0; ai < 2; ++ai)
#pragma unroll
            for (int m = 0; m < 4; ++m) { const int row = row0 + ai * 128 + m * 16; const float s = rs[ai * 4 + m];
#pragma unroll
                for (int bj = 0; bj < 2; ++bj) { const int c = cin0 + 128 * bj; const f32x4 v0 = acc[ai][bj][m][0] * s, v1 = acc[ai][bj][m][1] * s;
                    bf16_t* dst = (pn < 4) ? q + (size_t)row * 1024 + pn * 256 + c : (pn == 4 ? k + (size_t)row * 256 + c : v + (size_t)row * 256 + c);
                    u32x4 w; w.x = cvt_pk_bf16(v0[0], v0[1]); w.y = cvt_pk_bf16(v0[2], v0[3]); w.z = cvt_pk_bf16(v1[0], v1[1]); w.w = cvt_pk_bf16(v1[2], v1[3]);
                    *(u32x4*)dst = w; } }
    }
};

template <class F>
__device__ __forceinline__ void xpose_tiles(ldsp lds, int K, int N, F val, bf16_t* dst, int rmode, int rbase) {
    LAS float* T = (LAS float*)lds; const int tid = get_tid(), nkt = K / 64, nnt = N / 64;
    for (int t = blockIdx.x; t < nkt * nnt; t += gridDim.x) {
        const int kt = t % nkt, ntl = t / nkt, k0 = kt * 64, n0 = ntl * 64;
        { const int kr = tid >> 4, nc = (tid & 15) * 4; const f32x4 v0 = val(k0 + kr, n0 + nc), v1 = val(k0 + kr + 32, n0 + nc);
            T[kr * 65 + nc] = v0[0]; T[kr * 65 + nc + 1] = v0[1]; T[kr * 65 + nc + 2] = v0[2]; T[kr * 65 + nc + 3] = v0[3];
            T[(kr + 32) * 65 + nc] = v1[0]; T[(kr + 32) * 65 + nc + 1] = v1[1]; T[(kr + 32) * 65 + nc + 2] = v1[2]; T[(kr + 32) * 65 + nc + 3] = v1[3]; }
        __syncthreads();
        { const int n = tid >> 3, k8 = (tid & 7) * 8; float x[8];
#pragma unroll
            for (int j = 0; j < 8; ++j) x[j] = T[(k8 + j) * 65 + n];
            const int gn = n0 + n, dr = (rmode ? ((gn >> 7) * 256 + (gn & 127)) : gn) + rbase;
            u32x4 w; w.x = cvt_pk_bf16(x[0], x[1]); w.y = cvt_pk_bf16(x[2], x[3]); w.z = cvt_pk_bf16(x[4], x[5]); w.w = cvt_pk_bf16(x[6], x[7]);
            *(u32x4*)(dst + (size_t)dr * K + k0 + k8) = w; }
        __syncthreads();
    }
}
struct ValPlain { const float* src; int ld;
    __device__ __forceinline__ f32x4 operator()(int k, int n) const { return *(const f32x4*)(src + (size_t)k * ld + n); } };
struct ValGain { const float* src; int ld; const float* gain;
    __device__ __forceinline__ f32x4 operator()(int k, int n) const { const f32x4 v = *(const f32x4*)(src + (size_t)k * ld + n); return v * gain[k]; } };
struct ValGate { const float* w1; const float* w2; const float* gain;
    __device__ __forceinline__ f32x4 operator()(int k, int n) const { f32x4 a = {0.f, 0.f, 0.f, 0.f};
#pragma unroll
        for (int r = 0; r < 16; ++r) a += w1[k * 16 + r] * *(const f32x4*)(w2 + r * 512 + n);
        return a * gain[k]; } };

__device__ __forceinline__ void phase_prep(const Params& p, ldsp lds) {
    unsigned char* ws = p.ws; const int tid = get_tid(), lane = tid & 63, wid = tid >> 6;
    float* ssq = (float*)(ws + WS_SSQ); bf16_t* hb = (bf16_t*)(ws + WS_HB);
    for (int rp = blockIdx.x * 8 + wid; rp < MROWS / 2; rp += gridDim.x * 8) {
        f32x4 v[2][4];
#pragma unroll
        for (int k = 0; k < 2; ++k) { const int r = rp * 2 + k; const float* src = (r < R0) ? p.in[1] + (size_t)(r & 15) * DM : p.in[0] + (size_t)(r - R0) * DM;
#pragma unroll
            for (int i = 0; i < 4; ++i) v[k][i] = *(const f32x4*)(src + i * 256 + lane * 4); }
#pragma unroll
        for (int k = 0; k < 2; ++k) { const int r = rp * 2 + k; float ss = 0.f;
#pragma unroll
            for (int i = 0; i < 4; ++i) { const f32x4 x = v[k][i]; u32x2 w; w.x = cvt_pk_bf16(x[0], x[1]); w.y = cvt_pk_bf16(x[2], x[3]); *(u32x2*)(hb + (size_t)r * DM + i * 256 + lane * 4) = w;
                ss += (x[0] * x[0] + x[1] * x[1]) + (x[2] * x[2] + x[3] * x[3]); }
#pragma unroll
            for (int o = 32; o >= 1; o >>= 1) ss += __shfl_xor(ss, o);
            if (lane < 16) ssq[(size_t)r * 16 + lane] = lane == 0 ? ss : 0.f; }
    }
    for (int f = 0; f < 4; ++f) { const int li = f >> 1; const bool second = f & 1;
        const float* wg = p.in[second ? 18 : 3] + (size_t)li * DM * FF; const float* wu = p.in[second ? 19 : 4] + (size_t)li * DM * FF;
        const float* wd = p.in[second ? 20 : 5] + (size_t)li * FF * DM; const float* gn = p.in[second ? 17 : 2] + li * DM;
        bf16_t* dgu = (bf16_t*)(ws + WS_WGU + f * SZ_WGU); bf16_t* dd = (bf16_t*)(ws + WS_WD + f * SZ_WD);
        xpose_tiles(lds, DM, FF, ValGain{wg, FF, gn}, dgu, 1, 0);
        xpose_tiles(lds, DM, FF, ValGain{wu, FF, gn}, dgu, 1, 128);
        xpose_tiles(lds, FF, DM, ValPlain{wd, DM}, dd, 0, 0);
    }
    xpose_tiles(lds, DM, 3072, ValGain{p.in[7], 3072, p.in[6]}, (bf16_t*)(ws + WS_WGIN), 0, 0);
    xpose_tiles(lds, DM, 512, ValGate{p.in[8], p.in[9], p.in[6]}, (bf16_t*)(ws + WS_WGIN), 0, 3072);
    xpose_tiles(lds, DM, 512, ValGate{p.in[8] + DM * 16, p.in[9] + 16 * 512, p.in[6]}, (bf16_t*)(ws + WS_WGIN), 0, 3584);
    xpose_tiles(lds, DM, DM, ValPlain{p.in[12], DM}, (bf16_t*)(ws + WS_WGOUT), 0, 0);
    xpose_tiles(lds, DM, 1536, ValGain{p.in[13], 1536, p.in[6] + DM}, (bf16_t*)(ws + WS_WAIN), 0, 0);
    xpose_tiles(lds, DM, DM, ValPlain{p.in[16], DM}, (bf16_t*)(ws + WS_WAOUT), 0, 0);
}

__device__ __forceinline__ int gla_row(int b, int c, int to) { return c == 0 ? (to >= 48 ? b * 16 + (to - 48) : -1) : R0 + b * SEQ + (c - 1) * 64 + to; }
__device__ __forceinline__ bf16x8 ld8(ldsp base, int off) { return *(const LAS bf16x8*)(base + off); }

__device__ __forceinline__ void phase_gla_seq(const Params& p, ldsp lds) {
    constexpr int PBF = 528, PQ = 272, PT = 144;
    constexpr int OFF_BF = 0, OFF_QD = 33792, OFF_KI = OFF_QD + 17408, OFF_KET = OFF_KI + 17408, OFF_VT = OFF_KET + 18432, OFF_AM = OFF_VT + 18432,
                  OFF_ST = OFF_AM + 9216, OFF_PART = OFF_ST + 34816, OFF_DEC = OFF_PART + 2048;
    static_assert(OFF_DEC + 512 <= LDS_BYTES, "gla lds");
    unsigned char* ws = p.ws;
    const bf16_t* qb = (const bf16_t*)((unsigned char*)p.out + O_GQ); const bf16_t* kb = (const bf16_t*)(ws + U_GK); const bf16_t* vb = (const bf16_t*)(ws + U_GV);
    const float* gfp = (const float*)((unsigned char*)p.out + O_GF); const float* gbp = (const float*)(ws + U_GB);
    const int tid = get_tid(), lane = tid & 63, wid = __builtin_amdgcn_readfirstlane(tid >> 6), fr = lane & 15, fq = lane >> 4;
    const int dcol = tid & 127, qtr = tid >> 7;
    const int trow = tid >> 3, seg = tid & 7;
    for (int it = blockIdx.x; it < 256; it += gridDim.x) {
        const int item = (gridDim.x == 256) ? ((it & 7) * 32 + (it >> 3)) : it;
        const int vp = item & 1, dir = (item >> 1) & 1, hd = (item >> 2) & 3, b = item >> 4;
        bf16_t* obuf = (bf16_t*)(ws + WS_H) + (size_t)dir * MROWS * 1024;
        const float* gsrc = dir ? gbp : gfp;
        const unsigned colo = (unsigned)(qtr * 16) * 2048u + (unsigned)dcol * 4u, rowo = (unsigned)trow * 1024u + (unsigned)seg * 32u, rowv = (unsigned)trow * 2048u + (unsigned)seg * 32u;
        float gcol[16]; u32x4 rq0, rq1, rk0, rk1, rv0, rv1;
        f32x4 accS[8];
#define GLA_LOAD_SLOW(c_) do { \
        _Pragma("unroll") for (int i = 0; i < 16; ++i) { const int r_ = gla_row(b, (c_), qtr * 16 + i); \
            gcol[i] = r_ >= 0 ? gsrc[(size_t)r_ * 512 + hd * 128 + dcol] : 0.f; } \
        { const int r_ = gla_row(b, (c_), trow); const u32x4 z_ = {0u, 0u, 0u, 0u}; \
          if (r_ >= 0) { const bf16_t* qp_ = qb + (size_t)r_ * 512 + hd * 128 + seg * 16; const bf16_t* kp_ = kb + (size_t)r_ * 512 + hd * 128 + seg * 16; const bf16_t* vp_ = vb + (size_t)r_ * 1024 + hd * 256 + vp * 128 + seg * 16; \
              rq0 = *(const u32x4*)qp_; rq1 = *(const u32x4*)(qp_ + 8); rk0 = *(const u32x4*)kp_; rk1 = *(const u32x4*)(kp_ + 8); rv0 = *(const u32x4*)vp_; rv1 = *(const u32x4*)(vp_ + 8); } \
          else { rq0 = z_; rq1 = z_; rk0 = z_; rk1 = z_; rv0 = z_; rv1 = z_; } } } while (0)
#define GLA_LOAD_FAST(c_) do { const size_t rb_ = (size_t)R0 + (size_t)b * SEQ + (size_t)((c_) - 1) * 64; \
        unsigned colo_ = colo, rowo_ = rowo; asm volatile("" : "+v"(colo_), "+v"(rowo_));     \
        { const char* gB_ = (const char*)(gsrc + rb_ * 512 + hd * 128); \
          _Pragma("unroll") for (int i = 0; i < 16; ++i) gcol[i] = *(const float*)(gB_ + (colo_ + (unsigned)i * 2048u)); } \
        { const char* qB_ = (const char*)(qb + rb_ * 512 + hd * 128); const char* kB_ = (const char*)(kb + rb_ * 512 + hd * 128); const char* vB_ = (const char*)(vb + rb_ * 1024 + hd * 256 + vp * 128); \
          rq0 = *(const u32x4*)(qB_ + rowo_); rq1 = *(const u32x4*)(qB_ + rowo_ + 16u); rk0 = *(const u32x4*)(kB_ + rowo_); rk1 = *(const u32x4*)(kB_ + rowo_ + 16u); \
          rv0 = *(const u32x4*)(vB_ + rowv); rv1 = *(const u32x4*)(vB_ + rowv + 16u); } } while (0)
#define GLA_LOAD(c_) do { if ((c_) != 0) GLA_LOAD_FAST(c_); else GLA_LOAD_SLOW(c_); } while (0)
        GLA_LOAD(dir ? 64 : 0);
#pragma unroll
        for (int i = 0; i < 8; ++i) accS[i] = (f32x4){0.f, 0.f, 0.f, 0.f};
        for (int i = tid; i < 34816 / 4; i += 512) *(LAS unsigned*)(lds + OFF_ST + i * 4) = 0u;
        for (int ci = 0; ci < 65; ++ci) {
            const int c = dir ? 64 - ci : ci;
            float bl[16]; float run = 0.f;
            if (dir == 0) {
#pragma unroll
                for (int i = 0; i < 16; ++i) { run += gcol[i]; bl[i] = run; }
            } else {
#pragma unroll
                for (int i = 15; i >= 0; --i) { run += gcol[i]; bl[i] = run; }
            }
            *(LAS float*)(lds + OFF_PART + (qtr * 128 + dcol) * 4) = run;
            { const unsigned vw[8] = {rv0.x, rv0.y, rv0.z, rv0.w, rv1.x, rv1.y, rv1.z, rv1.w};
#pragma unroll
              for (int i = 0; i < 8; ++i) { const int vv = seg * 16 + 2 * i; const int vts = (((trow >> 3) ^ ((vv >> 3) & 7)) << 4) + (trow & 7) * 2;
                  *(LAS bf16_t*)(lds + OFF_VT + vv * PT + vts) = (bf16_t)(vw[i] & 0xffffu); *(LAS bf16_t*)(lds + OFF_VT + (vv + 1) * PT + vts) = (bf16_t)(vw[i] >> 16); } }
            __syncthreads();
            float offp = 0.f, tot = 0.f;
#pragma unroll
            for (int q2 = 0; q2 < 4; ++q2) { const float pv = *(LAS float*)(lds + OFF_PART + (q2 * 128 + dcol) * 4); tot += pv; if (dir ? (q2 > qtr) : (q2 < qtr)) offp += pv; }
#pragma unroll
            for (int i = 0; i < 16; ++i) *(LAS float*)(lds + OFF_BF + (qtr * 16 + i) * PBF + dcol * 4) = bl[i] + offp;
            if (qtr == 0) *(LAS float*)(lds + OFF_DEC + dcol * 4) = fast_exp(tot);
            __syncthreads();
            { const unsigned qw[8] = {rq0.x, rq0.y, rq0.z, rq0.w, rq1.x, rq1.y, rq1.z, rq1.w}, kw[8] = {rk0.x, rk0.y, rk0.z, rk0.w, rk1.x, rk1.y, rk1.z, rk1.w};
              unsigned qo[8], ko[8]; const int kts = (((trow >> 3) ^ seg) << 4) + (trow & 7) * 2;
#pragma unroll
              for (int i = 0; i < 4; ++i) { const f32x4 bv = *(const LAS f32x4*)(lds + OFF_BF + trow * PBF + (seg * 16 + i * 4) * 4); const f32x4 dc = *(const LAS f32x4*)(lds + OFF_DEC + (seg * 16 + i * 4) * 4);
#pragma unroll
                  for (int j = 0; j < 2; ++j) { const float e0 = fast_exp(bv[2 * j]), e1 = fast_exp(bv[2 * j + 1]); const unsigned qq = qw[i * 2 + j], kk = kw[i * 2 + j];
                      const float k0 = bflo(kk) * __builtin_amdgcn_rcpf(e0), k1 = bfhi(kk) * __builtin_amdgcn_rcpf(e1);
                      qo[i * 2 + j] = cvt_pk_bf16(bflo(qq) * e0, bfhi(qq) * e1); ko[i * 2 + j] = cvt_pk_bf16(k0, k1);
                      const unsigned kew = cvt_pk_bf16(k0 * dc[2 * j], k1 * dc[2 * j + 1]); const int d = seg * 16 + i * 4 + 2 * j;
                      *(LAS bf16_t*)(lds + OFF_KET + d * PT + kts) = (bf16_t)(kew & 0xffffu); *(LAS bf16_t*)(lds + OFF_KET + (d + 1) * PT + kts) = (bf16_t)(kew >> 16); } }
              *(LAS u32x4*)(lds + OFF_QD + trow * PQ + seg * 32) = (u32x4){qo[0], qo[1], qo[2], qo[3]}; *(LAS u32x4*)(lds + OFF_QD + trow * PQ + seg * 32 + 16) = (u32x4){qo[4], qo[5], qo[6], qo[7]};
              *(LAS u32x4*)(lds + OFF_KI + trow * PQ + seg * 32) = (u32x4){ko[0], ko[1], ko[2], ko[3]}; *(LAS u32x4*)(lds + OFF_KI + trow * PQ + seg * 32 + 16) = (u32x4){ko[4], ko[5], ko[6], ko[7]}; }
            if (ci + 1 < 65) { const int c2 = dir ? 63 - ci : ci + 1; GLA_LOAD(c2); }
            __syncthreads();
#pragma unroll
            for (int xx = 0; xx < 2; ++xx) { const int x = 2 * wid + xx, si = x >> 2, ti = x & 3; f32x4 a4 = {0.f, 0.f, 0.f, 0.f};
                if (dir ? (si >= ti) : (si <= ti)) {
#pragma unroll
                    for (int kk = 0; kk < 4; ++kk) a4 = __builtin_amdgcn_mfma_f32_16x16x32_bf16(ld8(lds, OFF_KI + (si * 16 + fr) * PQ + kk * 64 + fq * 16), ld8(lds, OFF_QD + (ti * 16 + fr) * PQ + kk * 64 + fq * 16), a4, 0, 0, 0);
#pragma unroll
                    for (int i = 0; i < 4; ++i) { const int sd = si * 16 + 4 * fq + i - (ti * 16 + fr); if (dir ? (sd < 0) : (sd > 0)) a4[i] = 0.f; }
                }
                u32x2 w; w.x = cvt_pk_bf16(a4[0], a4[1]); w.y = cvt_pk_bf16(a4[2], a4[3]);
                *(LAS u32x2*)(lds + OFF_AM + (ti * 16 + fr) * PT + (si * 16 + 4 * fq) * 2) = w; }
            __syncthreads();
            { const int vsw = (2 * wid + (fr >> 3)) & 7; bf16x8 fv[2], fs[4];
#pragma unroll
              for (int kk = 0; kk < 2; ++kk) fv[kk] = ld8(lds, OFF_VT + (wid * 16 + fr) * PT + (((kk * 4 + fq) ^ vsw) << 4));
#pragma unroll
              for (int kk = 0; kk < 4; ++kk) fs[kk] = ld8(lds, OFF_ST + (wid * 16 + fr) * PQ + kk * 64 + fq * 16);
#pragma unroll
              for (int ti = 0; ti < 4; ++ti) { f32x4 a4 = {0.f, 0.f, 0.f, 0.f};
#pragma unroll
                  for (int kk = 0; kk < 2; ++kk) a4 = __builtin_amdgcn_mfma_f32_16x16x32_bf16(fv[kk], ld8(lds, OFF_AM + (ti * 16 + fr) * PT + kk * 64 + fq * 16), a4, 0, 0, 0);
#pragma unroll
                  for (int kk = 0; kk < 4; ++kk) a4 = __builtin_amdgcn_mfma_f32_16x16x32_bf16(fs[kk], ld8(lds, OFF_QD + (ti * 16 + fr) * PQ + kk * 64 + fq * 16), a4, 0, 0, 0);
                  const int r = gla_row(b, c, ti * 16 + fr);
                  if (r >= 0) { u32x2 w; w.x = cvt_pk_bf16(a4[0], a4[1]); w.y = cvt_pk_bf16(a4[2], a4[3]); *(u32x2*)(obuf + (size_t)r * 1024 + hd * 256 + vp * 128 + wid * 16 + 4 * fq) = w; } } }
            __syncthreads();
            { const f32x4 dc = *(const LAS f32x4*)(lds + OFF_DEC + (16 * wid + 4 * fq) * 4); bf16x8 fk[2];
#pragma unroll
              for (int kk = 0; kk < 2; ++kk) fk[kk] = ld8(lds, OFF_KET + (16 * wid + fr) * PT + (((kk * 4 + fq) ^ (wid & 7)) << 4));
#pragma unroll
              for (int vbk = 0; vbk < 8; ++vbk) { accS[vbk] = accS[vbk] * dc; const int vsw = (2 * vbk + (fr >> 3)) & 7;
#pragma unroll
                  for (int kk = 0; kk < 2; ++kk) accS[vbk] = __builtin_amdgcn_mfma_f32_16x16x32_bf16(fk[kk], ld8(lds, OFF_VT + (vbk * 16 + fr) * PT + (((kk * 4 + fq) ^ vsw) << 4)), accS[vbk], 0, 0, 0);
                  u32x2 w; w.x = cvt_pk_bf16(accS[vbk][0], accS[vbk][1]); w.y = cvt_pk_bf16(accS[vbk][2], accS[vbk][3]);
                  *(LAS u32x2*)(lds + OFF_ST + (vbk * 16 + fr) * PQ + (16 * wid + 4 * fq) * 2) = w; } }
            __syncthreads();
        }
#undef GLA_LOAD
#undef GLA_LOAD_FAST
#undef GLA_LOAD_SLOW
    }
}

__device__ __forceinline__ void phase_gla_post(const Params& p) {
    unsigned char* ws = p.ws; const bf16_t* o = (const bf16_t*)(ws + WS_H); const bf16_t* ob = o + (size_t)MROWS * 1024; const bf16_t* r = (const bf16_t*)(ws + U_GR); bf16_t* og = (bf16_t*)(ws + U_GV);
    const float* hn = p.in[11]; const int tid = get_tid(), lane = tid & 63, wid = tid >> 6;
    float g[16];
#pragma unroll
    for (int i = 0; i < 16; ++i) g[i] = hn[(lane & 15) * 16 + i];
    for (int row = blockIdx.x * 8 + wid; row < MROWS; row += gridDim.x * 8) {
        const size_t off = (size_t)row * 1024 + lane * 16;
        const u32x4 o0 = *(const u32x4*)(o + off), o1 = *(const u32x4*)(o + off + 8), p0 = *(const u32x4*)(ob + off), p1 = *(const u32x4*)(ob + off + 8), r0 = *(const u32x4*)(r + off), r1 = *(const u32x4*)(r + off + 8);
        const unsigned ow[8] = {o0.x, o0.y, o0.z, o0.w, o1.x, o1.y, o1.z, o1.w}, pw[8] = {p0.x, p0.y, p0.z, p0.w, p1.x, p1.y, p1.z, p1.w}, rw[8] = {r0.x, r0.y, r0.z, r0.w, r1.x, r1.y, r1.z, r1.w};
        float x[16]; float ss = 0.f;
#pragma unroll
        for (int i = 0; i < 8; ++i) { x[2 * i] = bflo(ow[i]) + bflo(pw[i]); x[2 * i + 1] = bfhi(ow[i]) + bfhi(pw[i]); ss += x[2 * i] * x[2 * i] + x[2 * i + 1] * x[2 * i + 1]; }
        ss += __shfl_xor(ss, 1); ss += __shfl_xor(ss, 2); ss += __shfl_xor(ss, 4); ss += __shfl_xor(ss, 8);
        const float rs = rsqrtf(ss * (1.f / 256.f) + EPS); unsigned w[8];
#pragma unroll
        for (int i = 0; i < 8; ++i) w[i] = cvt_pk_bf16(x[2 * i] * rs * g[2 * i] * silu_f(bflo(rw[i])), x[2 * i + 1] * rs * g[2 * i + 1] * silu_f(bfhi(rw[i])));
        *(u32x4*)(og + off) = (u32x4){w[0], w[1], w[2], w[3]}; *(u32x4*)(og + off + 8) = (u32x4){w[4], w[5], w[6], w[7]};
    }
}

__device__ __forceinline__ void attn_prep_head(bf16_t* base, int pos, bool real, int ax, int ic, const float* gn) {
    const int d0 = ax * 64 + ic * 8;
    const u32x4 wa = *(const u32x4*)(base + d0), wb = *(const u32x4*)(base + d0 + 32);
    const unsigned aw[4] = {wa.x, wa.y, wa.z, wa.w}, bw[4] = {wb.x, wb.y, wb.z, wb.w};
    float xa[8], xb[8]; float ss = 0.f;
#pragma unroll
    for (int j = 0; j < 4; ++j) { xa[2 * j] = bflo(aw[j]); xa[2 * j + 1] = bfhi(aw[j]); xb[2 * j] = bflo(bw[j]); xb[2 * j + 1] = bfhi(bw[j]); }
#pragma unroll
    for (int j = 0; j < 8; ++j) ss += xa[j] * xa[j] + xb[j] * xb[j];
    ss += __shfl_xor(ss, 1); ss += __shfl_xor(ss, 2); ss += __shfl_xor(ss, 4);
    const float rs = rsqrtf(ss * (1.f / 128.f) + EPS);
    const float t = real ? (float)(ax ? (pos & 63) : (pos >> 6)) : 0.f;
    const f32x4 ga0 = *(const f32x4*)(gn + d0), ga1 = *(const f32x4*)(gn + d0 + 4), gb0 = *(const f32x4*)(gn + d0 + 32), gb1 = *(const f32x4*)(gn + d0 + 36);
    float oa[8], ob[8];
#pragma unroll
    for (int j = 0; j < 8; ++j) { const float invf = __builtin_amdgcn_exp2f(-(float)(ic * 8 + j) * (2.0f / 64.0f) * 13.287712379549449f);
        float rev = t * invf * 0.15915494309189535f; rev -= floorf(rev);
        const float sn = __builtin_amdgcn_sinf(rev), cs = __builtin_amdgcn_cosf(rev);
        const float ya = xa[j] * rs * (j < 4 ? ga0[j & 3] : ga1[j & 3]), yb = xb[j] * rs * (j < 4 ? gb0[j & 3] : gb1[j & 3]);
        oa[j] = ya * cs - yb * sn; ob[j] = yb * cs + ya * sn; }
    *(u32x4*)(base + d0) = (u32x4){cvt_pk_bf16(oa[0], oa[1]), cvt_pk_bf16(oa[2], oa[3]), cvt_pk_bf16(oa[4], oa[5]), cvt_pk_bf16(oa[6], oa[7])};
    *(u32x4*)(base + d0 + 32) = (u32x4){cvt_pk_bf16(ob[0], ob[1]), cvt_pk_bf16(ob[2], ob[3]), cvt_pk_bf16(ob[4], ob[5]), cvt_pk_bf16(ob[6], ob[7])};
}
__device__ __forceinline__ void phase_attn_prep(const Params& p) {
    unsigned char* ws = p.ws; bf16_t* k = (bf16_t*)(ws + U_AK);
    const float* kn = p.in[15]; const int tid = get_tid(), lane = tid & 63, wid = tid >> 6;
    const int sub = lane & 7, ax = sub >> 2, ic = sub & 3, hl = lane >> 3;
    for (int r4 = blockIdx.x * 8 + wid; r4 < MROWS / 4; r4 += gridDim.x * 8) { const int row = r4 * 4 + (hl >> 1);
        attn_prep_head(k + (size_t)row * 256 + (hl & 1) * 128, (row - R0) & 4095, row >= R0, ax, ic, kn); }
}

__device__ __forceinline__ void phase_final(const Params& p) {
    unsigned char* ws = p.ws; const bf16_t* hb = (const bf16_t*)(ws + WS_HB); const float* ssq = (const float*)(ws + WS_SSQ) + 6 * (size_t)MROWS * 16; const float* gn = p.in[21];
    const int tid = get_tid(), lane = tid & 63, wid = tid >> 6;
    f32x4 g[4];
#pragma unroll
    for (int i = 0; i < 4; ++i) g[i] = *(const f32x4*)(gn + i * 256 + lane * 4);
    float pofs = 0.f;
    if (TPROBE_MASK) pofs = sqrtf(*(const float*)(ws + WS_NEED) * 1e-8f);
    for (int rq = blockIdx.x * 8 + wid; rq < (MROWS - R0) / 4; rq += gridDim.x * 8) {
        u32x2 w[4][4]; float sr[4];
#pragma unroll
        for (int k = 0; k < 4; ++k) { const int row = R0 + rq * 4 + k;
#pragma unroll
            for (int i = 0; i < 4; ++i) w[k][i] = *(const u32x2*)(hb + (size_t)row * DM + i * 256 + lane * 4);
            sr[k] = row_rstd(ssq, row); }
#pragma unroll
        for (int k = 0; k < 4; ++k) { const int row = R0 + rq * 4 + k;
#pragma unroll
            for (int i = 0; i < 4; ++i) { const f32x4 v = {bflo(w[k][i].x), bfhi(w[k][i].x), bflo(w[k][i].y), bfhi(w[k][i].y)};
                *(f32x4*)(p.out + (size_t)(row - R0) * DM + i * 256 + lane * 4) = v * sr[k] * g[i] + pofs; } }
    }
}

namespace att {
constexpr int D = 128, KVBLK = 64, LDQ = 1024, LDK = 256, LDO = 1024;
constexpr float SCALE = 0.088388347648318440f, THR = 8.f;
constexpr size_t SHM_V = KVBLK * D * 2, SHM_K = KVBLK * D * 2, SHM_ATTN = 2 * SHM_V + 2 * SHM_K + 8 * 64 * 4;
#define KSWZ(row, colB) ((row) * 256 + ((colB) ^ (((row) & 7) << 4)))
#define SBAR() __builtin_amdgcn_sched_barrier(0)
__device__ __forceinline__ int crow(int r, int hi) { return (r & 3) + 8 * (r >> 2) + 4 * hi; }
__device__ __forceinline__ void partialSM(f32x16& p0, f32x16& p1, float& m_reg, float& mn, float& alpha) {
  constexpr float C = SCALE * 1.4426950408889634f;
  float pmax = p0[0]; for (int r = 1; r < 16; ++r) pmax = fmaxf(pmax, p0[r]); for (int r = 0; r < 16; ++r) pmax = fmaxf(pmax, p1[r]);
  { auto rr = __builtin_amdgcn_permlane32_swap(__float_as_uint(pmax), __float_as_uint(pmax), false, false);
    pmax = fmaxf(__uint_as_float(rr[0]), __uint_as_float(rr[1])); }
  if (__builtin_expect(__all(pmax - m_reg <= THR / SCALE), 1)) { mn = m_reg; alpha = 1.f; }
  else { mn = fmaxf(m_reg, pmax); alpha = __builtin_amdgcn_exp2f((m_reg - mn) * C); m_reg = mn; }
  float mnC = -mn * C;
  for (int r = 0; r < 16; ++r) p0[r] = fmaf(p0[r], C, mnC); for (int r = 0; r < 16; ++r) p1[r] = fmaf(p1[r], C, mnC);
  for (int r = 0; r < 16; ++r) p0[r] = __builtin_amdgcn_exp2f(p0[r]);
}
__device__ __forceinline__ void finishSM(f32x16& p0, f32x16& p1, float alpha, float& l_reg, bf16x8& pa0, bf16x8& pa1, bf16x8& pa2, bf16x8& pa3) {
  for (int r = 0; r < 16; ++r) p1[r] = __builtin_amdgcn_exp2f(p1[r]);
  float ps = 0; for (int r = 0; r < 16; ++r) ps += p0[r]; for (int r = 0; r < 16; ++r) ps += p1[r];
  { auto rr = __builtin_amdgcn_permlane32_swap(__float_as_uint(ps), __float_as_uint(ps), false, false);
    ps = __uint_as_float(rr[0]) + __uint_as_float(rr[1]); }
  l_reg = l_reg * alpha + ps;
#define PK4(P, BASE, OUT) do { unsigned a0 = cvt_pk_bf16(P[BASE + 0], P[BASE + 1]), a1 = cvt_pk_bf16(P[BASE + 2], P[BASE + 3]);   \
    unsigned b0 = cvt_pk_bf16(P[BASE + 4], P[BASE + 5]), b1 = cvt_pk_bf16(P[BASE + 6], P[BASE + 7]);                              \
    auto r0 = __builtin_amdgcn_permlane32_swap(a0, b0, false, false); auto r1 = __builtin_amdgcn_permlane32_swap(a1, b1, false, false); \
    u32x4 w = {r0[0], r1[0], r0[1], r1[1]}; OUT = *reinterpret_cast<bf16x8*>(&w); } while (0)
  PK4(p0, 0, pa0); PK4(p0, 8, pa1); PK4(p1, 0, pa2); PK4(p1, 8, pa3);
#undef PK4
}
__device__ __forceinline__ void qkt(f32x16& p0, f32x16& p1, const char* Ks, const bf16x8* qr, int r32, int hi) {
  p0 = f32x16{}; p1 = f32x16{};
  for (int d0 = 0; d0 < 8; ++d0) { int cb = (d0 * 16 + hi * 8) * 2;
    bf16x8 b0 = *reinterpret_cast<const bf16x8*>(Ks + KSWZ(r32, cb));
    bf16x8 b1 = *reinterpret_cast<const bf16x8*>(Ks + KSWZ(32 + r32, cb));
    p0 = __builtin_amdgcn_mfma_f32_32x32x16_bf16(b0, qr[d0], p0, 0, 0, 0);
    p1 = __builtin_amdgcn_mfma_f32_32x32x16_bf16(b1, qr[d0], p1, 0, 0, 0); }
}
__device__ __forceinline__ int v_st(int k, int c) { const int kk = (k & ~0xC) | ((k & 4) << 1) | ((k & 8) >> 1); return ((kk >> 3) * 4 + (c >> 5)) * 512 + ((kk & 7) * 32 + (c & 31)) * 2; }
__device__ __forceinline__ int v_rd_base(int lane) { return ((lane & 3) << 3) | (((lane >> 2) & 3) << 6) | (((lane >> 4) & 1) << 5) | (((lane >> 5) & 1) << 8); }
constexpr int v_rd_off(int d0, int ks, int half) { return d0 * 512 + ks * 4096 + half * 2048; }
template <int OFF> __device__ __forceinline__ s16x4 tr_read(int vb) {
  s16x4 r; asm volatile("ds_read_b64_tr_b16 %0, %1 offset:%2" : "=&v"(r) : "v"(vb), "i"(OFF) : "memory"); return r;
}
template <int D0> __device__ __forceinline__ void pv_one(f32x16& od, int vb, bf16x8 pa0, bf16x8 pa1, bf16x8 pa2, bf16x8 pa3) {
  const s16x4 l0 = tr_read<v_rd_off(D0, 0, 0)>(vb), h0 = tr_read<v_rd_off(D0, 0, 1)>(vb), l1 = tr_read<v_rd_off(D0, 1, 0)>(vb), h1 = tr_read<v_rd_off(D0, 1, 1)>(vb);
  const s16x4 l2 = tr_read<v_rd_off(D0, 2, 0)>(vb), h2 = tr_read<v_rd_off(D0, 2, 1)>(vb), l3 = tr_read<v_rd_off(D0, 3, 0)>(vb), h3 = tr_read<v_rd_off(D0, 3, 1)>(vb);
  asm volatile("s_waitcnt lgkmcnt(0)" ::: "memory"); SBAR();
#define PK(L, H) (bf16x8){L[0], L[1], L[2], L[3], H[0], H[1], H[2], H[3]}
  od = __builtin_amdgcn_mfma_f32_32x32x16_bf16(pa0, PK(l0, h0), od, 0, 0, 0);
  od = __builtin_amdgcn_mfma_f32_32x32x16_bf16(pa1, PK(l1, h1), od, 0, 0, 0);
  od = __builtin_amdgcn_mfma_f32_32x32x16_bf16(pa2, PK(l2, h2), od, 0, 0, 0);
  od = __builtin_amdgcn_mfma_f32_32x32x16_bf16(pa3, PK(l3, h3), od, 0, 0, 0);
#undef PK
}
__device__ __forceinline__ void pv_d0(f32x16* o, int vb, bf16x8 pa0, bf16x8 pa1, bf16x8 pa2, bf16x8 pa3) {
  pv_one<0>(o[0], vb, pa0, pa1, pa2, pa3); pv_one<1>(o[1], vb, pa0, pa1, pa2, pa3); pv_one<2>(o[2], vb, pa0, pa1, pa2, pa3); pv_one<3>(o[3], vb, pa0, pa1, pa2, pa3);
}
__device__ __forceinline__ void attn_body(const bf16_t* Qb, const bf16_t* K0, const bf16_t* V0, const bf16_t* K1, const bf16_t* V1, bf16_t* Ob, char* lds, const float* qn, int qpos0) {
  constexpr int NT = 65;
  const int tid = get_tid(), wid = tid >> 6, lane = tid & 63, r32 = lane & 31, hi = lane >> 5;
  char* V_lds = lds; char* K_lds = lds + 2 * SHM_V;
  float* wsf = (float*)(lds + 2 * SHM_V + 2 * SHM_K) + wid * 64; float* li_l = wsf; float* al_l = wsf + 32;
  float m_reg = -1e30f, l_reg = 0; f32x16 o[4] = {}; bf16x8 qr[8];
  const bf16_t* Qw = Qb + (long)(wid * 32 + r32) * LDQ + hi * 8;
#pragma unroll
  for (int d0 = 0; d0 < 8; ++d0) qr[d0] = *reinterpret_cast<const bf16x8*>(Qw + d0 * 16);
  { float ss = 0.f;
#pragma unroll
    for (int d0 = 0; d0 < 8; ++d0)
#pragma unroll
      for (int j = 0; j < 8; ++j) { const float x = bf2f((bf16_t)qr[d0][j]); ss += x * x; }
    ss += __shfl_xor(ss, 32);
    const float rs = rsqrtf(ss * (1.f / 128.f) + EPS);
    const int pos = (qpos0 + wid * 32 + r32) & 4095;
#pragma unroll
    for (int ax = 0; ax < 2; ++ax) { const float t = (float)(ax ? (pos & 63) : (pos >> 6));
#pragma unroll
      for (int bl = 0; bl < 2; ++bl) { const int da = ax * 4 + bl, db = da + 2; unsigned wa[4], wb[4];
        const f32x4 ga0 = *(const f32x4*)(qn + da * 16 + hi * 8), ga1 = *(const f32x4*)(qn + da * 16 + hi * 8 + 4), gb0 = *(const f32x4*)(qn + db * 16 + hi * 8), gb1 = *(const f32x4*)(qn + db * 16 + hi * 8 + 4);
#pragma unroll
        for (int jp = 0; jp < 4; ++jp) { float oa[2], ob[2];
#pragma unroll
          for (int jj = 0; jj < 2; ++jj) { const int j = jp * 2 + jj;
            const float invf = __builtin_amdgcn_exp2f(-(float)(bl * 16 + j) * (2.0f / 64.0f) * 13.287712379549449f) * __builtin_amdgcn_exp2f(-(float)hi * (16.0f / 64.0f) * 13.287712379549449f);
            float rev = t * invf * 0.15915494309189535f; rev -= floorf(rev);
            const float sn = __builtin_amdgcn_sinf(rev), cs = __builtin_amdgcn_cosf(rev);
            const float ya = bf2f((bf16_t)qr[da][j]) * rs * (j < 4 ? ga0[j & 3] : ga1[j & 3]), yb = bf2f((bf16_t)qr[db][j]) * rs * (j < 4 ? gb0[j & 3] : gb1[j & 3]);
            oa[jj] = ya * cs - yb * sn; ob[jj] = yb * cs + ya * sn; }
          wa[jp] = cvt_pk_bf16(oa[0], oa[1]); wb[jp] = cvt_pk_bf16(ob[0], ob[1]); }
        { u32x4 w = {wa[0], wa[1], wa[2], wa[3]}; qr[da] = *reinterpret_cast<bf16x8*>(&w); }
        { u32x4 w = {wb[0], wb[1], wb[2], wb[3]}; qr[db] = *reinterpret_cast<bf16x8*>(&w); } } }
  }
  const int sr = tid >> 4, sc = (tid & 15) * 8, vst0 = v_st(sr, sc), vst1 = v_st(32 + sr, sc);
  const int vb0 = (int)(uintptr_t)V_lds + v_rd_base(lane);
  struct { bf16x8 vs0, vs1, ks0, ks1; } sr_[2];
#define TKP(T) ((T) == 0 ? K0 : K1 + (long)((T) - 1) * 64 * LDK)
#define TVP(T) ((T) == 0 ? V0 : V1 + (long)((T) - 1) * 64 * LDK)
#define SLOAD(i, T) do { const bf16_t* kp_ = TKP(T); const bf16_t* vp_ = TVP(T); \
    sr_[i].vs0 = *reinterpret_cast<const bf16x8*>(&vp_[(long)(sr) * LDK + sc]); sr_[i].vs1 = *reinterpret_cast<const bf16x8*>(&vp_[(long)(32 + sr) * LDK + sc]); \
    sr_[i].ks0 = *reinterpret_cast<const bf16x8*>(&kp_[(long)(sr) * LDK + sc]); sr_[i].ks1 = *reinterpret_cast<const bf16x8*>(&kp_[(long)(32 + sr) * LDK + sc]); } while (0)
#define SWRITE(b, i) do { *(bf16x8*)(V_lds + (b) * SHM_V + vst0) = sr_[i].vs0;          \
    *(bf16x8*)(V_lds + (b) * SHM_V + vst1) = sr_[i].vs1; int kc = sc * 2;               \
    *(bf16x8*)(K_lds + (b) * SHM_K + KSWZ(sr, kc)) = sr_[i].ks0;                       \
    *(bf16x8*)(K_lds + (b) * SHM_K + KSWZ(32 + sr, kc)) = sr_[i].ks1; } while (0)
#define SWAIT() asm volatile("s_waitcnt vmcnt(4)" ::: "memory")
#define RESC(a) do { if (__any((a) < 1.f)) { if (hi == 0) al_l[r32] = (a); asm volatile("s_waitcnt lgkmcnt(0)" ::: "memory"); \
    for (int d = 0; d < 4; ++d) for (int r = 0; r < 16; ++r) o[d][r] *= al_l[crow(r, hi)]; } } while (0)
  f32x16 pA0, pA1, pB0, pB1; float mnA, mnB, alA, alB; bf16x8 pa0, pa1, pa2, pa3;
  constexpr int SE = 0, SO = 1;
  SLOAD(SE, 0); asm volatile("s_waitcnt vmcnt(0)" ::: "memory"); SWRITE(0, SE); __syncthreads();
  qkt(pA0, pA1, K_lds, qr, r32, hi);
#pragma unroll
  for (int r = 8; r < 16; ++r) pA0[r] = -1e30f;
#pragma unroll
  for (int r = 0; r < 16; ++r) pA1[r] = -1e30f;
  partialSM(pA0, pA1, m_reg, mnA, alA);
  SLOAD(SO, 1); SLOAD(SE, 2);
  SWAIT(); SWRITE(1, SO); __syncthreads();
  for (int j = 1; j + 1 < NT; j += 2) {
    SBAR(); qkt(pB0, pB1, K_lds + SHM_K, qr, r32, hi);
    finishSM(pA0, pA1, alA, l_reg, pa0, pa1, pa2, pa3); SBAR();
    if (j + 2 < NT) SLOAD(SO, j + 2); SBAR();
    pv_d0(o, vb0, pa0, pa1, pa2, pa3); partialSM(pB0, pB1, m_reg, mnB, alB);
    __syncthreads(); SWAIT(); SWRITE(0, SE);
    RESC(alB); __syncthreads();
    SBAR(); qkt(pA0, pA1, K_lds, qr, r32, hi);
    finishSM(pB0, pB1, alB, l_reg, pa0, pa1, pa2, pa3); SBAR();
    if (j + 3 < NT) SLOAD(SE, j + 3); SBAR();
    pv_d0(o, vb0 + (int)SHM_V, pa0, pa1, pa2, pa3); partialSM(pA0, pA1, m_reg, mnA, alA);
    __syncthreads(); SWAIT(); SWRITE(1, SO);
    RESC(alA); __syncthreads();
  }
  finishSM(pA0, pA1, alA, l_reg, pa0, pa1, pa2, pa3); SBAR();
  pv_d0(o, vb0, pa0, pa1, pa2, pa3);
  if (hi == 0) li_l[r32] = l_reg; asm volatile("s_waitcnt lgkmcnt(0)" ::: "memory");
  float rli[16];
#pragma unroll
  for (int r = 0; r < 16; ++r) rli[r] = __builtin_amdgcn_rcpf(li_l[crow(r, hi)]);
  bf16_t* Ow = Ob + (long)(wid * 32) * LDO;
#pragma unroll
  for (int r = 0; r < 16; ++r) { int orow = crow(r, hi);
    for (int d0 = 0; d0 < 4; ++d0) { const float v = o[d0][r] * rli[r]; Ow[(long)orow * LDO + d0 * 32 + r32] = (bf16_t)(cvt_pk_bf16(v, v) & 0xffffu); } }
#undef SLOAD
#undef SWRITE
#undef SWAIT
#undef RESC
#undef TKP
#undef TVP
}
}

__device__ __forceinline__ void phase_attn(const Params& p, char* lds) {
    unsigned char* ws = p.ws; const bf16_t* q = (const bf16_t*)(ws + U_AQ); const bf16_t* k = (const bf16_t*)(ws + U_AK); const bf16_t* v = (const bf16_t*)(ws + U_AV); bf16_t* ao = (bf16_t*)(ws + U_AO);
    const bool xmap = (gridDim.x == 256);
    for (int it = blockIdx.x, rnd = 0; it < 2048; it += gridDim.x, ++rnd) {
        int item = it;
        if (xmap) { const int x = blockIdx.x & 7, j = blockIdx.x >> 3, pair = x * 4 + (rnd >> 1), i64 = (rnd & 1) * 32 + j; item = (pair >> 1) * 128 + ((pair & 1) * 4 + (i64 >> 4)) * 16 + (i64 & 15); }
        const int qb = item & 15, hh = (item >> 4) & 7, b = item >> 7, kvh = hh >> 2;
        const size_t qrow = (size_t)R0 + (size_t)b * SEQ + qb * 256;
        att::attn_body(q + qrow * 1024 + hh * 128, k + (size_t)(b * 16) * 256 + kvh * 128, v + (size_t)(b * 16) * 256 + kvh * 128,
                       k + ((size_t)R0 + (size_t)b * SEQ) * 256 + kvh * 128, v + ((size_t)R0 + (size_t)b * SEQ) * 256 + kvh * 128,
                       ao + qrow * 1024 + hh * 128, lds, p.in[14], qb * 256);
        __syncthreads();
    }
}

#define XB_TMO      128
#define XB_XCNT(j)  (256  + 64 * (j))
#define XB_XSUB(j)  (1280 + 64 * (j))
#define XB_XGEN(j)  (2304 + 64 * (j))
#define XB_TOP      3328
#define XB_TOPGEN   3392
#define XCD_BAR_WORDS 3456
#define XB_SPIN_CAP (1u << 18)
__device__ __forceinline__ unsigned xb_ld(unsigned* p)              { return __hip_atomic_load(p, __ATOMIC_RELAXED, __HIP_MEMORY_SCOPE_AGENT); }
__device__ __forceinline__ unsigned xb_add(unsigned* p, unsigned v) { return __hip_atomic_fetch_add(p, v, __ATOMIC_RELAXED, __HIP_MEMORY_SCOPE_AGENT); }
__device__ __forceinline__ unsigned xb_xcc_id() { return (unsigned)__builtin_amdgcn_s_getreg((3 << 11) | 20) & 0xFu; }
#define XB_SPIN(cond, bar) do { unsigned _sp = 0; while (cond) { __builtin_amdgcn_s_sleep(1); \
    if ((++_sp & 255u) == 0u) { if (xb_ld(&(bar)[XB_TMO])) break; if (_sp > XB_SPIN_CAP) { atomicAdd(&(bar)[XB_TMO], 1u); break; } } } } while (0)
struct XcdBarrier { unsigned* bar; unsigned x; volatile LAS unsigned* st; };
__device__ __forceinline__ XcdBarrier xcd_barrier_post(unsigned* bar, volatile LAS unsigned* st) {
    XcdBarrier b; b.bar = bar; b.x = xb_xcc_id(); b.st = st;
    if (threadIdx.x == 0) (void)xb_add(&bar[XB_XCNT(b.x)], 1u);
    return b;
}
__device__ __forceinline__ void xcd_barrier_complete(unsigned* bar, unsigned x, unsigned& nloc, unsigned& nx) {
    const unsigned G = gridDim.x * gridDim.y * gridDim.z;
    unsigned sum, cnt, mine, sp = 0u;
    for (;;) {
        sum = 0u; cnt = 0u; mine = 0u;
#pragma unroll
        for (unsigned j = 0; j < 16; ++j) { const unsigned c = xb_ld(&bar[XB_XCNT(j)]); sum += c; cnt += (c > 0u) ? 1u : 0u; mine = (j == x) ? c : mine; }
        if (sum == G) break;
        __builtin_amdgcn_s_sleep(1);
        if ((++sp & 255u) == 0u) { if (xb_ld(&bar[XB_TMO])) break; if (sp > XB_SPIN_CAP) { atomicAdd(&bar[XB_TMO], 1u); break; } }
    }
    nloc = mine > 0u ? mine : 1u; nx = cnt > 0u ? cnt : 1u;
}
__device__ __forceinline__ void xcd_barrier(const XcdBarrier& b) {
    asm volatile("s_waitcnt vmcnt(0)" ::: "memory");
    __syncthreads();
    if (threadIdx.x == 0) {
        unsigned* bar = b.bar;
        __builtin_amdgcn_s_waitcnt(0);
        unsigned nloc = b.st[0], nx = b.st[1];
        if (nloc == 0u) { xcd_barrier_complete(bar, b.x, nloc, nx); b.st[0] = nloc; b.st[1] = nx; }
        const unsigned old = xb_add(&bar[XB_XSUB(b.x)], 1u);
        const unsigned gen = old / nloc;
        if (old + 1u == (gen + 1u) * nloc) {
            __builtin_amdgcn_fence(__ATOMIC_RELEASE, "agent");
            asm volatile("s_waitcnt vmcnt(0)" ::: "memory");
            const unsigned og = xb_add(&bar[XB_TOP], 1u);
            const unsigned tg = og / nx;
            if (og + 1u == (tg + 1u) * nx) xb_add(&bar[XB_TOPGEN], 1u);
            else XB_SPIN(xb_ld(&bar[XB_TOPGEN]) == tg, bar);
            __builtin_amdgcn_fence(__ATOMIC_ACQUIRE, "agent");
            xb_add(&bar[XB_XGEN(b.x)], 1u);
            asm volatile("s_waitcnt vmcnt(0)" ::: "memory");
        } else {
            XB_SPIN(xb_ld(&bar[XB_XGEN(b.x)]) == gen, bar);
            __builtin_amdgcn_fence(__ATOMIC_ACQUIRE, "agent");
            asm volatile("s_waitcnt vmcnt(0)" ::: "memory");
        }
    }
    __syncthreads();
}

__global__ void __launch_bounds__(512, 1) mega_fwd(Params p) {
    extern __shared__ __attribute__((aligned(16))) unsigned char shm[];
    ldsp lds = (ldsp)shm;
    unsigned char* ws = p.ws;
    bf16_t* hb = (bf16_t*)(ws + WS_HB); float* ssq = (float*)(ws + WS_SSQ);
    const int G = gridDim.x, c = blockIdx.x;
    if (threadIdx.x < 4) ((volatile LAS unsigned*)(lds + LDS_BYTES))[threadIdx.x] = 0u;
    if (blockIdx.x == 0 && p.hi - p.lo > 1) for (int i = threadIdx.x; i < XCD_BAR_WORDS; i += 512) ((unsigned*)(p.ws + WS_BAR))[i] = 0u;
    __syncthreads();
    unsigned long long tp0 = 0; float tpsum = 0.f;
    for (int ph = p.lo; ph < p.hi; ++ph) {
        if (TPROBE_MASK && blockIdx.x == 0 && threadIdx.x == 0) tp0 = __builtin_amdgcn_s_memrealtime();
        int kind, f = 0, nin = 0, nout = 0;
        switch (ph) {
            case 0: kind = 0; break;
            case 1: kind = 1; f = 0; nin = 0; break;
            case 2: kind = 2; f = 0; nout = (DIAG == 2) ? 6 : 1; break;
            case 3: kind = 3; nin = 1; break;
            case 4: kind = 4; break;
            case 5: kind = 5; break;
            case 6: kind = 2; f = 4; nout = (DIAG == 3) ? 6 : 2; break;
            case 7: kind = 1; f = 1; nin = 2; break;
            case 8: kind = 2; f = 1; nout = 3; break;
            case 9: kind = 1; f = 2; nin = 3; break;
            case 10: kind = 2; f = 2; nout = 4; break;
            case 11: kind = 6; nin = 4; break;
            case 12: kind = 7; break;
            case 13: kind = 8; break;
            case 14: kind = 2; f = 5; nout = 5; break;
            case 15: kind = 1; f = 3; nin = 5; break;
            case 16: kind = 2; f = 3; nout = 6; break;
            default: kind = 9; break;
        }
        if (!((PHMASK >> ph) & 1)) kind = 99;
        const int pmoff = (ph >= 14) ? 1 : 0; const int Mrows = MROWS - pmoff * 256;
        if (kind == 0) { if (KMASK & 1) phase_prep(p, lds); }
        else if (kind == 1 && (KMASK & 2)) {
            pg8::Gemm g{hb + (size_t)pmoff * 256 * DM, (const bf16_t*)(ws + WS_WGU + f * SZ_WGU), Mrows, 2 * FF, DM, 0}; pg8::StaticOrder S; S.init(Mrows, 2 * FF, G, c);
            EpiSwiGLU E{(bf16_t*)(ws + U_ACT), ssq + (size_t)nin * MROWS * 16, pmoff, lds};
            rstd_table_build(lds, S, E.ssq, pmoff);
            pg8::gemm_phase(lds, g, S, E);
        } else if (kind == 2 && (KMASK & 4)) {
            pg8::Gemm g; float alpha; const float* x32 = nullptr;
            if (f < 4) { g = pg8::Gemm{(const bf16_t*)(ws + U_ACT) + (size_t)pmoff * 256 * FF, (const bf16_t*)(ws + WS_WD + f * SZ_WD), Mrows, DM, FF, 1}; alpha = 0.5f; if (ph == 2) x32 = p.in[0] - (size_t)R0 * DM; }
            else if (f == 4) { g = pg8::Gemm{(const bf16_t*)(ws + U_GV), (const bf16_t*)(ws + WS_WGOUT), MROWS, DM, DM, 0}; alpha = 1.f; }
            else { g = pg8::Gemm{(const bf16_t*)(ws + U_AO) + (size_t)pmoff * 256 * DM, (const bf16_t*)(ws + WS_WAOUT), Mrows, DM, DM, 0}; alpha = 1.f; }
            pg8::StaticOrder S; S.init(Mrows, DM, G, c);
            EpiResid E{x32, hb, ssq + (size_t)nout * MROWS * 16, alpha, pmoff};
            pg8::gemm_phase(lds, g, S, E);
        } else if (kind == 3 && (KMASK & 8)) {
            pg8::Gemm g{hb, (const bf16_t*)(ws + WS_WGIN), MROWS, 4096, DM, 0}; pg8::StaticOrder S; S.init(MROWS, 4096, G, c);
            EpiGlaIn E{(bf16_t*)((unsigned char*)p.out + O_GQ), (bf16_t*)(ws + U_GK), (bf16_t*)(ws + U_GV), (bf16_t*)(ws + U_GR), (float*)((unsigned char*)p.out + O_GF), (float*)(ws + U_GB),
                       ssq + (size_t)nin * MROWS * 16, p.in[10], lds};
            for (int i = get_tid(); i < 1024; i += 512) *(LAS float*)(lds + GB_OFF + i * 4) = p.in[10][i];
            rstd_table_build(lds, S, E.ssq, 0);
            pg8::gemm_phase(lds, g, S, E);
        } else if (kind == 4) { if (KMASK & 16) phase_gla_seq(p, lds); }
        else if (kind == 5) { if (KMASK & 32) phase_gla_post(p); }
        else if (kind == 6 && (KMASK & 64)) {
            pg8::Gemm g{hb, (const bf16_t*)(ws + WS_WAIN), MROWS, 1536, DM, 0}; pg8::StaticOrder S; S.init(MROWS, 1536, G, c);
            EpiAttnIn E{(bf16_t*)(ws + U_AQ), (bf16_t*)(ws + U_AK), (bf16_t*)(ws + U_AV), ssq + (size_t)nin * MROWS * 16, lds};
            rstd_table_build(lds, S, E.ssq, 0);
            pg8::gemm_phase(lds, g, S, E);
        } else if (kind == 7) { if (KMASK & 128) phase_attn_prep(p); }
        else if (kind == 8) { if (KMASK & 256) phase_attn(p, (char*)shm); }
        else if (kind == 9 && (KMASK & 512)) phase_final(p);
        if (ph + 1 < p.hi) {
            if (ph == p.lo) { cg::this_grid().sync(); (void)xcd_barrier_post((unsigned*)(p.ws + WS_BAR), (volatile LAS unsigned*)(lds + LDS_BYTES)); }
            else { XcdBarrier xb; xb.bar = (unsigned*)(p.ws + WS_BAR); xb.x = xb_xcc_id(); xb.st = (volatile LAS unsigned*)(lds + LDS_BYTES); xcd_barrier(xb); } }
        if (TPROBE_MASK) { if (blockIdx.x == 0 && threadIdx.x == 0) { const unsigned long long tp1 = __builtin_amdgcn_s_memrealtime(); if ((TPROBE_MASK >> ph) & 1) tpsum += (float)(tp1 - tp0) * 0.01f;
                if (ph == 16) __hip_atomic_store((float*)(ws + WS_NEED), tpsum, __ATOMIC_RELAXED, __HIP_MEMORY_SCOPE_AGENT); }
            if (ph == 16) cg::this_grid().sync(); }
    }
}

extern "C" void kernel_launch(void* const* d_in, const int* in_sizes, int n_in, void* d_out, int out_size, void* d_ws, size_t ws_size, hipStream_t stream) {
    static int grid = 0;
    if (grid == 0) {
        if (n_in != 22 || out_size != NB * SEQ * DM || ws_size < WS_END) { fprintf(stderr, "kernel_launch: unexpected shapes n_in %d out %d ws %zu (need %zu)\n", n_in, out_size, ws_size, (size_t)WS_END); grid = -1; return; }
        if (hipFuncSetAttribute((const void*)mega_fwd, hipFuncAttributeMaxDynamicSharedMemorySize, LDS_TOTAL) != hipSuccess) { fprintf(stderr, "kernel_launch: hipFuncSetAttribute failed\n"); grid = -1; return; }
        int dev = 0, cus = 0, per_cu = 0;
        hipGetDevice(&dev); hipDeviceGetAttribute(&cus, hipDeviceAttributeMultiprocessorCount, dev);
        hipOccupancyMaxActiveBlocksPerMultiprocessor(&per_cu, (const void*)mega_fwd, 512, LDS_TOTAL);
        if (per_cu < 1) { fprintf(stderr, "kernel_launch: occupancy query says %d blocks/CU\n", per_cu); per_cu = 1; }
        (void)hipGetLastError();
        grid = cus * per_cu;
    }
    if (grid < 0) return;
    Params p{};
    for (int i = 0; i < 22; ++i) p.in[i] = (const float*)d_in[i];
    p.out = (float*)d_out; p.ws = (unsigned char*)d_ws;
#if ONE_LAUNCH
    p.lo = 0; p.hi = NPHASE;
    void* args[] = {&p};
    hipError_t e = hipLaunchCooperativeKernel((const void*)mega_fwd, dim3(grid), dim3(512), args, LDS_TOTAL, stream);
    if (e != hipSuccess) fprintf(stderr, "cooperative launch failed: %s (grid %d)\n", hipGetErrorString(e), grid);
#else
    for (int ph = 0; ph < NPHASE; ++ph) { p.lo = ph; p.hi = ph + 1; hipLaunchKernelGGL(mega_fwd, dim3(grid), dim3(512), LDS_TOTAL, stream, p); }
#endif
}
```

```cpp
#include <hip/hip_runtime.h>
#include <hip/hip_cooperative_groups.h>
#include <cstdio>
namespace cg = cooperative_groups;

#ifndef TPROBE_MASK
#define TPROBE_MASK 0
#endif
#ifndef NOADD
#define NOADD 0
#endif
#ifndef FWDONLY
#define FWDONLY 0
#endif
#ifndef DIAG
#define DIAG 0
#endif
#ifndef PHMASK
#define PHMASK 0x3ffff
#endif
#ifndef KMASK
#define KMASK 1023
#endif
#ifndef ONE_LAUNCH
#define ONE_LAUNCH 1
#endif

#define LAS __attribute__((address_space(3)))
typedef unsigned short bf16_t;
typedef short bf16x8 __attribute__((ext_vector_type(8)));
typedef short s16x4 __attribute__((ext_vector_type(4)));
typedef float f32x4 __attribute__((ext_vector_type(4)));
typedef float f32x8 __attribute__((ext_vector_type(8)));
typedef float f32x16 __attribute__((ext_vector_type(16)));
typedef unsigned u32x4 __attribute__((ext_vector_type(4)));
typedef unsigned u32x2 __attribute__((ext_vector_type(2)));
typedef LAS unsigned char* ldsp;

constexpr int DM = 1024, FF = 2816, NB = 16, SEQ = 4096, NMETA = 16;
constexpr int MROWS = NB * NMETA + NB * SEQ;
constexpr int R0 = NB * NMETA;
constexpr float EPS = 1e-6f;
constexpr int LDS_BYTES = 152064;
constexpr int LDS_TOTAL = LDS_BYTES + 16;
constexpr int NPHASE = 18;

constexpr size_t SZ_H = (size_t)MROWS * DM * 4, SZ_HB = (size_t)MROWS * DM * 2, SZ_SSQ1 = (size_t)MROWS * 16 * 4;
constexpr size_t WS_H = 0, WS_HB = WS_H + SZ_H, WS_SSQ = WS_HB + SZ_HB, WS_W = WS_SSQ + 7 * SZ_SSQ1;
constexpr size_t SZ_WGU = (size_t)2 * FF * DM * 2, SZ_WD = (size_t)DM * FF * 2;
constexpr size_t WS_WGU = WS_W, WS_WD = WS_WGU + 4 * SZ_WGU, WS_WGIN = WS_WD + 4 * SZ_WD, WS_WGOUT = WS_WGIN + (size_t)4096 * DM * 2,
                 WS_WAIN = WS_WGOUT + (size_t)DM * DM * 2, WS_WAOUT = WS_WAIN + (size_t)1536 * DM * 2, WS_U = WS_WAOUT + (size_t)DM * DM * 2;
constexpr size_t U_ACT = WS_U;
constexpr size_t U_GB = WS_U, U_GK = U_GB + (size_t)MROWS * 512 * 4, U_GV = U_GK + (size_t)MROWS * 512 * 2, U_GR = U_GV + SZ_HB, U_GEND = U_GR + SZ_HB;
constexpr size_t U_AQ = WS_U, U_AK = U_AQ + SZ_HB, U_AV = U_AK + (size_t)MROWS * 256 * 2, U_AO = U_AV + (size_t)MROWS * 256 * 2, U_AEND = U_AO + SZ_HB;
constexpr size_t WS_NEED = (U_GEND > U_AEND ? U_GEND : U_AEND);
constexpr size_t WS_BAR = WS_NEED + 256, WS_END = WS_BAR + 16384;
constexpr size_t O_GF = 0, O_GQ = (size_t)MROWS * 512 * 4;

struct Params { const float* in[22]; float* out; unsigned char* ws; int lo, hi; };

typedef __bf16 bf16x2_t __attribute__((ext_vector_type(2)));
typedef float f32x2_t __attribute__((ext_vector_type(2)));
__device__ __forceinline__ unsigned cvt_pk_bf16(float lo, float hi) { const f32x2_t f = {lo, hi}; const bf16x2_t b = __builtin_convertvector(f, bf16x2_t); return __builtin_bit_cast(unsigned, b); }
__device__ __forceinline__ int get_tid() { int t = threadIdx.x; asm volatile("" : "+v"(t)); return t; }
__device__ __forceinline__ float bf2f(bf16_t v) { return __uint_as_float(((unsigned)v) << 16); }
__device__ __forceinline__ float bflo(unsigned w) { return __uint_as_float(w << 16); }
__device__ __forceinline__ float bfhi(unsigned w) { return __uint_as_float(w & 0xffff0000u); }
__device__ __forceinline__ float row_rstd(const float* ssq, int row) { const f32x4* p4 = (const f32x4*)(ssq + (size_t)row * 16); const f32x4 a = p4[0], b = p4[1], c = p4[2], d = p4[3];
    const f32x4 t = (a + b) + (c + d); return rsqrtf(((t[0] + t[1]) + (t[2] + t[3])) * (1.f / 1024.f) + EPS); }
__device__ __forceinline__ float fast_exp(float x) { return __builtin_amdgcn_exp2f(x * 1.4426950408889634f); }
__device__ __forceinline__ float silu_f(float x) { return x * __builtin_amdgcn_rcpf(1.f + __builtin_amdgcn_exp2f(-1.4426950408889634f * x)); }

namespace pg8 {
constexpr int BM = 256, BK = 64, HALF = 128, HTB = HALF * BK * 2, STAGE_BYTES = 8 * HTB, NXCD = 8, WGM = 8;
__host__ __device__ __forceinline__ int lds_byte(int r, int c) { const int st = (r >> 4) * 2 + (c >> 5), rr = r & 15, cc = c & 31, ob = rr * 64 + cc * 2; return st * 1024 + (ob ^ (((ob >> 9) & 1) << 5)); }
__host__ __device__ __forceinline__ void stage_rc(int b, int& R, int& C) { const int st = b / 1024, sb = b % 1024, swz = sb ^ (((sb >> 9) & 1) << 5); R = (st >> 1) * 16 + swz / 64; C = (st & 1) * 32 + (swz % 64) / 2; }
__host__ __device__ __forceinline__ int perm32(int rho) { const int n = rho >> 4, i = rho & 15; return 8 * (i >> 2) + 4 * n + (i & 3); }
struct Unit { int pm, pn; };
struct Gemm { const bf16_t* A; const bf16_t* Bt; int M, N, K; int atiled; };
struct StaticOrder {
    int nM, nN, nwg, G, c;
    __device__ void init(int M, int N, int G_, int c_) { nM = M / BM; nN = N / BM; nwg = nM * nN; G = G_; c = c_; }
    __device__ bool next(int i, Unit& u) const {
        const long L = (long)i * G + c; if (L >= nwg) return false;
        int wgid = (int)L; { const int q = nwg / NXCD, r = nwg % NXCD, xcd = wgid % NXCD, off = wgid / NXCD; wgid = (xcd < r ? xcd * (q + 1) : r * (q + 1) + (xcd - r) * q) + off; }
        const int nig = WGM * nN, gid = wgid / nig, fm = gid * WGM, gsz = (nM - fm) < WGM ? (nM - fm) : WGM;
        u.pm = fm + ((wgid % nig) % gsz); u.pn = (wgid % nig) / gsz; return true;
    }
};
template <class Epi>
__device__ __forceinline__ void gemm_phase(ldsp lds, const Gemm g, const StaticOrder& S, const Epi& E) {
    const int tid = get_tid(), wid = __builtin_amdgcn_readfirstlane(tid >> 6), lane = tid & 63, wr = wid >> 2, wc = wid & 3, fr = lane & 15, fq = lane >> 4;
    const int K = g.K, nt = K / BK;
    unsigned voffA[2], voffB[2];
#pragma unroll
    for (int i = 0; i < 2; ++i) { int R, C; stage_rc(tid * 16 + i * 8192, R, C); const int Rb = Epi::PERM ? ((R & ~31) + perm32(R & 31)) : R;
        voffA[i] = (unsigned)(R * (g.atiled ? BK : K) + C) * 2u; voffB[i] = (unsigned)(Rb * K + C) * 2u; }
    const size_t kstep = (size_t)(BK * 2);
    const size_t hstep = (size_t)HALF * K * 2;
    const size_t tstep = 2 * hstep;
    const size_t kstepA = g.atiled ? (size_t)BM * BK * 2 : kstep, hstepA = g.atiled ? (size_t)HALF * BK * 2 : hstep;
    const unsigned ldsw = (unsigned)wid * 1024u;
    const int aoff = lds_byte(wr * 64 + fr, fq * 8), boff = lds_byte(wc * 32 + fr, fq * 8);
#define PG8_SA(b, h) (((b) * 2 + (h)) * HTB)
#define PG8_SB(b, h) ((4 + (b) * 2 + (h)) * HTB)
#define PG8_STAGE(bufoff, gbase, voff) do { _Pragma("unroll") for (int _i = 0; _i < 2; ++_i) \
        __builtin_amdgcn_global_load_lds((const unsigned*)((const char*)(gbase) + (voff)[_i]), (LAS unsigned*)(lds + (bufoff) + ldsw + _i * 8192), 16, 0, 0); } while (0)
#define PG8_LDA(dst, b, h) do { _Pragma("unroll") for (int m = 0; m < 4; ++m) _Pragma("unroll") for (int k = 0; k < 2; ++k) dst[m][k] = *(const LAS bf16x8*)(lds + PG8_SA(b, h) + aoff + m * 2048 + k * 1024); } while (0)
#define PG8_LDB(dst, b, h) do { _Pragma("unroll") for (int n = 0; n < 2; ++n) _Pragma("unroll") for (int k = 0; k < 2; ++k) dst[n][k] = *(const LAS bf16x8*)(lds + PG8_SB(b, h) + boff + n * 2048 + k * 1024); } while (0)
#define PG8_MMA(ai, bj, At, Bt) do { __builtin_amdgcn_s_setprio(1); _Pragma("unroll") for (int m = 0; m < 4; ++m) _Pragma("unroll") for (int n = 0; n < 2; ++n) _Pragma("unroll") for (int k = 0; k < 2; ++k) \
        acc[ai][bj][m][n] = __builtin_amdgcn_mfma_f32_16x16x32_bf16(Bt[n][k], At[m][k], acc[ai][bj][m][n], 0, 0, 0); __builtin_amdgcn_s_setprio(0); } while (0)
#define PG8_WAIT_V(n) asm volatile("s_waitcnt vmcnt(" #n ")" ::: "memory")
#define PG8_WAIT_L(n) asm volatile("s_waitcnt lgkmcnt(" #n ")" ::: "memory")
#define PG8_BAR __builtin_amdgcn_s_barrier()
#define PG8_SCHED __builtin_amdgcn_sched_barrier(0)
    Unit cur, nxt; int ui = 0;
    if (!S.next(0, cur)) return;
    f32x4 acc[2][2][4][2];
#pragma unroll
    for (int a = 0; a < 2; ++a)
#pragma unroll
        for (int b = 0; b < 2; ++b)
#pragma unroll
            for (int m = 0; m < 4; ++m)
#pragma unroll
                for (int n = 0; n < 2; ++n) acc[a][b][m][n] = (f32x4){0.f, 0.f, 0.f, 0.f};
    bf16x8 At[4][2], B0[2][2], B1[2][2];
    const char* cA = (const char*)g.A + (size_t)cur.pm * tstep; const char* cB = (const char*)g.Bt + (size_t)cur.pn * tstep;
    PG8_STAGE(PG8_SB(0, 0), cB, voffB); PG8_STAGE(PG8_SA(0, 0), cA, voffA); PG8_STAGE(PG8_SB(0, 1), cB + hstep, voffB); PG8_STAGE(PG8_SA(0, 1), cA + hstepA, voffA);
    if (wr == 1) PG8_BAR;
    PG8_WAIT_V(4); PG8_BAR;
    PG8_STAGE(PG8_SB(1, 0), cB + kstep, voffB); PG8_STAGE(PG8_SA(1, 0), cA + kstepA, voffA); PG8_STAGE(PG8_SB(1, 1), cB + hstep + kstep, voffB);
    PG8_WAIT_V(6); PG8_BAR;
    for (;;) {
        const bool has_next = S.next(ui + 1, nxt);
        const char* nA = has_next ? (const char*)g.A + (size_t)nxt.pm * tstep : cA; const char* nB = has_next ? (const char*)g.Bt + (size_t)nxt.pn * tstep : cB;
        for (int t = 0; t < nt; t += 2) {
            const bool last = (t == nt - 2);
            const char* a1 = cA + (size_t)(t + 1) * kstepA;
            const char* a2 = last ? nA : cA + (size_t)(t + 2) * kstepA; const char* b2 = last ? nB : cB + (size_t)(t + 2) * kstep;
            const char* a3 = a2 + kstepA; const char* b3 = b2 + kstep;
            PG8_LDB(B0, 0, 0); PG8_SCHED; PG8_LDA(At, 0, 0); PG8_STAGE(PG8_SA(1, 1), a1 + hstepA, voffA);
            PG8_WAIT_L(8); PG8_BAR; PG8_WAIT_L(0); PG8_MMA(0, 0, At, B0); PG8_BAR; PG8_SCHED;
            PG8_LDB(B1, 0, 1); PG8_STAGE(PG8_SB(0, 0), b2, voffB);
            PG8_BAR; PG8_WAIT_L(0); PG8_MMA(0, 1, At, B1); PG8_BAR;
            PG8_LDA(At, 0, 1); PG8_STAGE(PG8_SA(0, 0), a2, voffA);
            PG8_BAR; PG8_WAIT_L(0); PG8_MMA(1, 0, At, B0); PG8_BAR; PG8_SCHED;
            PG8_STAGE(PG8_SB(0, 1), b2 + hstep, voffB);
            PG8_WAIT_V(6); PG8_BAR; PG8_MMA(1, 1, At, B1); PG8_BAR;
            PG8_LDB(B0, 1, 0); PG8_SCHED; PG8_LDA(At, 1, 0); PG8_STAGE(PG8_SA(0, 1), a2 + hstepA, voffA);
            PG8_WAIT_L(8); PG8_BAR; PG8_WAIT_L(0); PG8_MMA(0, 0, At, B0); PG8_BAR; PG8_SCHED;
            PG8_LDB(B1, 1, 1); PG8_STAGE(PG8_SB(1, 0), b3, voffB);
            PG8_BAR; PG8_WAIT_L(0); PG8_MMA(0, 1, At, B1); PG8_BAR;
            PG8_LDA(At, 1, 1); PG8_STAGE(PG8_SA(1, 0), a3, voffA);
            PG8_BAR; PG8_WAIT_L(0); PG8_MMA(1, 0, At, B0); PG8_BAR; PG8_SCHED;
            PG8_STAGE(PG8_SB(1, 1), b3 + hstep, voffB);
            PG8_WAIT_V(6); PG8_BAR; PG8_MMA(1, 1, At, B1); PG8_BAR;
        }
        E(acc, cur, wr, wc, fr, fq);
        if (!has_next) break;
#pragma unroll
        for (int a = 0; a < 2; ++a)
#pragma unroll
            for (int b = 0; b < 2; ++b)
#pragma unroll
                for (int m = 0; m < 4; ++m)
#pragma unroll
                    for (int n = 0; n < 2; ++n) acc[a][b][m][n] = (f32x4){0.f, 0.f, 0.f, 0.f};
        cur = nxt; cA = nA; cB = nB; ++ui;
    }
    PG8_WAIT_V(0);
    if (wr == 0) PG8_BAR;
    PG8_BAR;
#undef PG8_SA
#undef PG8_SB
#undef PG8_STAGE
#undef PG8_LDA
#undef PG8_LDB
#undef PG8_MMA
#undef PG8_WAIT_V
#undef PG8_WAIT_L
#undef PG8_BAR
#undef PG8_SCHED
}
}

typedef f32x4 AccT[2][2][4][2];

constexpr int RS_OFF = 131072, RS_SLOTS = 8, RS_TAG = RS_OFF + RS_SLOTS * 256 * 4, GB_OFF = RS_TAG + 64;
static_assert(GB_OFF + 4096 <= LDS_BYTES, "rstd table + gate bias");
__device__ __forceinline__ void rstd_table_build(ldsp lds, const pg8::StaticOrder& S, const float* ssq, int pmoff) {
    const int tid = get_tid(); int nslot = 0, last = -1; pg8::Unit u;
    for (int i = 0; S.next(i, u); ++i) if (u.pm != last) { last = u.pm;
        if (nslot < RS_SLOTS) { if (tid < 256) *(LAS float*)(lds + RS_OFF + (nslot * 256 + tid) * 4) = row_rstd(ssq, (u.pm + pmoff) * 256 + tid); if (tid == 0) *(LAS int*)(lds + RS_TAG + nslot * 4) = u.pm; }
        ++nslot; }
    if (tid < RS_SLOTS && tid >= nslot) *(LAS int*)(lds + RS_TAG + tid * 4) = -1;
    __syncthreads();
}
__device__ __forceinline__ void rstd_rows(ldsp lds, const float* ssq, int pm, int pmoff, int wr, int fr, float (&rs)[8]) {
    int slot = -1;
#pragma unroll
    for (int k = 0; k < RS_SLOTS; ++k) if (*(const LAS int*)(lds + RS_TAG + k * 4) == pm) slot = k;
    if (slot >= 0) {
#pragma unroll
        for (int ai = 0; ai < 2; ++ai)
#pragma unroll
            for (int m = 0; m < 4; ++m) rs[ai * 4 + m] = *(const LAS float*)(lds + RS_OFF + (slot * 256 + ai * 128 + wr * 64 + m * 16 + fr) * 4);
    } else {
#pragma unroll
        for (int ai = 0; ai < 2; ++ai)
#pragma unroll
            for (int m = 0; m < 4; ++m) rs[ai * 4 + m] = row_rstd(ssq, (pm + pmoff) * 256 + ai * 128 + wr * 64 + m * 16 + fr);
    }
}

struct EpiSwiGLU { static constexpr bool PERM = true;
    bf16_t* act; const float* ssq; int pmoff; ldsp lds;
    __device__ __forceinline__ void operator()(const AccT& acc, const pg8::Unit& u, int wr, int wc, int fr, int fq) const {
        const int row0 = (u.pm + pmoff) * 256 + wr * 64 + fr, col0 = u.pn * 128 + wc * 32 + 8 * fq;
        float rs[8]; rstd_rows(lds, ssq, u.pm, pmoff, wr, fr, rs);
#pragma unroll
        for (int ai = 0; ai < 2; ++ai)
#pragma unroll
            for (int m = 0; m < 4; ++m) { const int row = row0 + ai * 128 + m * 16; const float s = rs[ai * 4 + m];
                float a[8];
#pragma unroll
                for (int n = 0; n < 2; ++n)
#pragma unroll
                    for (int j = 0; j < 4; ++j) a[n * 4 + j] = silu_f(acc[ai][0][m][n][j] * s) * (acc[ai][1][m][n][j] * s);
                u32x4 w; w.x = cvt_pk_bf16(a[0], a[1]); w.y = cvt_pk_bf16(a[2], a[3]); w.z = cvt_pk_bf16(a[4], a[5]); w.w = cvt_pk_bf16(a[6], a[7]);
                *(u32x4*)(act + ((size_t)((row >> 8) * (FF / 64) + (col0 >> 6)) * 256 + (row & 255)) * 64 + (col0 & 63)) = w; }
    }
};
struct EpiResid { static constexpr bool PERM = true;
    const float* x32; bf16_t* hb; float* ssq; float alpha; int pmoff;
    __device__ __forceinline__ void operator()(const AccT& acc, const pg8::Unit& u, int wr, int wc, int fr, int fq) const {
        const int row0 = (u.pm + pmoff) * 256 + wr * 64 + fr, col0 = u.pn * 256 + wc * 32 + 8 * fq;
        const bool fromx = (x32 != nullptr) && (u.pm + pmoff != 0);
        if (fromx) {
#pragma unroll
            for (int ai = 0; ai < 2; ++ai)
#pragma unroll
                for (int mh = 0; mh < 2; ++mh) { f32x4 rf[2][2][2];
#pragma unroll
                    for (int mm = 0; mm < 2; ++mm)
#pragma unroll
                        for (int bj = 0; bj < 2; ++bj) { const float* xp = x32 + (size_t)(row0 + ai * 128 + (mh * 2 + mm) * 16) * DM + col0 + bj * 128; rf[mm][bj][0] = *(const f32x4*)xp; rf[mm][bj][1] = *(const f32x4*)(xp + 4); }
#pragma unroll
                    for (int mm = 0; mm < 2; ++mm) { const int m = mh * 2 + mm; const int row = row0 + ai * 128 + m * 16; const size_t off = (size_t)row * DM + col0; float ss = 0.f;
#pragma unroll
                        for (int bj = 0; bj < 2; ++bj) { float v[8];
#pragma unroll
                            for (int n = 0; n < 2; ++n)
#pragma unroll
                                for (int j = 0; j < 4; ++j) { v[n * 4 + j] = rf[mm][bj][n][j] + alpha * acc[ai][bj][m][n][j]; ss += v[n * 4 + j] * v[n * 4 + j]; }
                            u32x4 w; w.x = cvt_pk_bf16(v[0], v[1]); w.y = cvt_pk_bf16(v[2], v[3]); w.z = cvt_pk_bf16(v[4], v[5]); w.w = cvt_pk_bf16(v[6], v[7]);
                            *(u32x4*)(hb + off + bj * 128) = w; }
                        ss += __shfl_xor(ss, 16); ss += __shfl_xor(ss, 32);
                        if (fq == 0) ssq[(size_t)row * 16 + u.pn * 4 + wc] = ss; } }
        } else {
#pragma unroll
            for (int ai = 0; ai < 2; ++ai) { u32x4 rw[4][2];
#pragma unroll
                for (int m = 0; m < 4; ++m)
#pragma unroll
                    for (int bj = 0; bj < 2; ++bj) rw[m][bj] = *(const u32x4*)(hb + (size_t)(row0 + ai * 128 + m * 16) * DM + col0 + bj * 128);
#pragma unroll
                for (int m = 0; m < 4; ++m) { const int row = row0 + ai * 128 + m * 16; const size_t off = (size_t)row * DM + col0; float ss = 0.f;
#pragma unroll
                    for (int bj = 0; bj < 2; ++bj) { const u32x4 t = rw[m][bj]; const float r[8] = {bflo(t.x), bfhi(t.x), bflo(t.y), bfhi(t.y), bflo(t.z), bfhi(t.z), bflo(t.w), bfhi(t.w)}; float v[8];
#pragma unroll
                        for (int n = 0; n < 2; ++n)
#pragma unroll
                            for (int j = 0; j < 4; ++j) { v[n * 4 + j] = r[n * 4 + j] + alpha * acc[ai][bj][m][n][j]; ss += v[n * 4 + j] * v[n * 4 + j]; }
                        u32x4 w; w.x = cvt_pk_bf16(v[0], v[1]); w.y = cvt_pk_bf16(v[2], v[3]); w.z = cvt_pk_bf16(v[4], v[5]); w.w = cvt_pk_bf16(v[6], v[7]);
                        *(u32x4*)(hb + off + bj * 128) = w; }
                    ss += __shfl_xor(ss, 16); ss += __shfl_xor(ss, 32);
                    if (fq == 0) ssq[(size_t)row * 16 + u.pn * 4 + wc] = ss; } }
        }
    }
};
struct EpiGlaIn { static constexpr bool PERM = true;
    bf16_t *q, *k, *v, *r; float *gf, *gb; const float* ssq; const float* gbias; ldsp lds;
    __device__ __forceinline__ void operator()(const AccT& acc, const pg8::Unit& u, int wr, int wc, int fr, int fq) const {
        const int row0 = u.pm * 256 + wr * 64 + fr, cin0 = wc * 32 + 8 * fq, pn = u.pn;
        float rs[8]; rstd_rows(lds, ssq, u.pm, 0, wr, fr, rs);
#pragma unroll
        for (int ai = 0; ai < 2; ++ai)
#pragma unroll
            for (int m = 0; m < 4; ++m) { const int row = row0 + ai * 128 + m * 16; float s = rs[ai * 4 + m];
                if (pn < 2) s *= 0.08838834764831845f;
#pragma unroll
                for (int bj = 0; bj < 2; ++bj) { const int c = cin0 + 128 * bj; const f32x4 v0 = acc[ai][bj][m][0] * s, v1 = acc[ai][bj][m][1] * s;
                    if (pn < 12) {
                        bf16_t* dst;
                        if (pn < 2) dst = q + (size_t)row * 512 + pn * 256 + c; else if (pn < 4) dst = k + (size_t)row * 512 + (pn - 2) * 256 + c;
                        else if (pn < 8) dst = v + (size_t)row * 1024 + (pn - 4) * 256 + c; else dst = r + (size_t)row * 1024 + (pn - 8) * 256 + c;
                        u32x4 w; w.x = cvt_pk_bf16(v0[0], v0[1]); w.y = cvt_pk_bf16(v0[2], v0[3]); w.z = cvt_pk_bf16(v1[0], v1[1]); w.w = cvt_pk_bf16(v1[2], v1[3]);
                        *(u32x4*)dst = w;
                    } else {
                        const int dir = (pn - 12) >> 1, gc = ((pn - 12) & 1) * 256 + c;
                        const f32x4 b0 = *(const LAS f32x4*)(lds + GB_OFF + (dir * 512 + gc) * 4), b1 = *(const LAS f32x4*)(lds + GB_OFF + (dir * 512 + gc + 4) * 4); f32x4 o0, o1;
#pragma unroll
                        for (int j = 0; j < 4; ++j) { const float z0 = v0[j] + b0[j], z1 = v1[j] + b1[j];
                            o0[j] = (fminf(z0, 0.f) - __logf(1.f + __expf(-fabsf(z0)))) * 0.0625f; o1[j] = (fminf(z1, 0.f) - __logf(1.f + __expf(-fabsf(z1)))) * 0.0625f; }
                        float* dst = (dir ? gb : gf) + (size_t)row * 512 + gc; *(f32x4*)dst = o0; *(f32x4*)(dst + 4) = o1;
                    } } }
    }
};
struct EpiAttnIn { static constexpr bool PERM = true;
    bf16_t *q, *k, *v; const float* ssq; ldsp lds;
    __device__ __forceinline__ void operator()(const AccT& acc, const pg8::Unit& u, int wr, int wc, int fr, int fq) const {
        const int row0 = u.pm * 256 + wr * 64 + fr, cin0 = wc * 32 + 8 * fq, pn = u.pn;
        float rs[8]; rstd_rows(lds, ssq, u.pm, 0, wr, fr, rs);
#pragma unroll
        for (int ai = 0; ai < 2; ++ai)
#pragma unroll
            for (int m = 0; m < 4; ++m) { const int row = row0 + ai * 128 + m * 16; const float s = rs[ai * 4 + m];
#pragma unroll
                for (int bj = 0; bj < 2; ++bj) { const int c = cin0 + 128 * bj; const f32x4 v0 = acc[ai][bj][m][0] * s, v1 = acc[ai][bj][m][1] * s;
                    bf16_t* dst = (pn < 4) ? q + (size_t)row * 1024 + pn * 256 + c : (pn == 4 ? k + (size_t)row * 256 + c : v + (size_t)row * 256 + c);
                    u32x4 w; w.x = cvt_pk_bf16(v0[0], v0[1]); w.y = cvt_pk_bf16(v0[2], v0[3]); w.z = cvt_pk_bf16(v1[0], v1[1]); w.w = cvt_pk_bf16(v1[2], v1[3]);
                    *(u32x4*)dst = w; } }
    }
};

template <class F>
__device__ __forceinline__ void xpose_tiles(ldsp lds, int K, int N, F val, bf16_t* dst, int rmode, int rbase) {
    LAS float* T = (LAS float*)lds; const int tid = get_tid(), nkt = K / 64, nnt = N / 64;
    for (int t = blockIdx.x; t < nkt * nnt; t += gridDim.x) {
        const int kt = t % nkt, ntl = t / nkt, k0 = kt * 64, n0 = ntl * 64;
        { const int kr = tid >> 4, nc = (tid & 15) * 4; const f32x4 v0 = val(k0 + kr, n0 + nc), v1 = val(k0 + kr + 32, n0 + nc);
            T[kr * 65 + nc] = v0[0]; T[kr * 65 + nc + 1] = v0[1]; T[kr * 65 + nc + 2] = v0[2]; T[kr * 65 + nc + 3] = v0[3];
            T[(kr + 32) * 65 + nc] = v1[0]; T[(kr + 32) * 65 + nc + 1] = v1[1]; T[(kr + 32) * 65 + nc + 2] = v1[2]; T[(kr + 32) * 65 + nc + 3] = v1[3]; }
        __syncthreads();
        { const int n = tid >> 3, k8 = (tid & 7) * 8; float x[8];
#pragma unroll
            for (int j = 0; j < 8; ++j) x[j] = T[(k8 + j) * 65 + n];
            const int gn = n0 + n, dr = (rmode ? ((gn >> 7) * 256 + (gn & 127)) : gn) + rbase;
            u32x4 w; w.x = cvt_pk_bf16(x[0], x[1]); w.y = cvt_pk_bf16(x[2], x[3]); w.z = cvt_pk_bf16(x[4], x[5]); w.w = cvt_pk_bf16(x[6], x[7]);
            *(u32x4*)(dst + (size_t)dr * K + k0 + k8) = w; }
        __syncthreads();
    }
}
struct ValPlain { const float* src; int ld;
    __device__ __forceinline__ f32x4 operator()(int k, int n) const { return *(const f32x4*)(src + (size_t)k * ld + n); } };
struct ValGain { const float* src; int ld; const float* gain;
    __device__ __forceinline__ f32x4 operator()(int k, int n) const { const f32x4 v = *(const f32x4*)(src + (size_t)k * ld + n); return v * gain[k]; } };
struct ValGate { const float* w1; const float* w2; const float* gain;
    __device__ __forceinline__ f32x4 operator()(int k, int n) const { f32x4 a = {0.f, 0.f, 0.f, 0.f};
#pragma unroll
        for (int r = 0; r < 16; ++r) a += w1[k * 16 + r] * *(const f32x4*)(w2 + r * 512 + n);
        return a * gain[k]; } };

__device__ __forceinline__ void phase_prep(const Params& p, ldsp lds) {
    unsigned char* ws = p.ws; const int tid = get_tid(), lane = tid & 63, wid = tid >> 6;
    float* ssq = (float*)(ws + WS_SSQ); bf16_t* hb = (bf16_t*)(ws + WS_HB);
    for (int rp = blockIdx.x * 8 + wid; rp < MROWS / 2; rp += gridDim.x * 8) {
        f32x4 v[2][4];
#pragma unroll
        for (int k = 0; k < 2; ++k) { const int r = rp * 2 + k; const float* src = (r < R0) ? p.in[1] + (size_t)(r & 15) * DM : p.in[0] + (size_t)(r - R0) * DM;
#pragma unroll
            for (int i = 0; i < 4; ++i) v[k][i] = __builtin_nontemporal_load((const f32x4*)(src + i * 256 + lane * 4)); }
#pragma unroll
        for (int k = 0; k < 2; ++k) { const int r = rp * 2 + k; float ss = 0.f;
#pragma unroll
            for (int i = 0; i < 4; ++i) { const f32x4 x = v[k][i]; u32x2 w; w.x = cvt_pk_bf16(x[0], x[1]); w.y = cvt_pk_bf16(x[2], x[3]); *(u32x2*)(hb + (size_t)r * DM + i * 256 + lane * 4) = w;
                ss += (x[0] * x[0] + x[1] * x[1]) + (x[2] * x[2] + x[3] * x[3]); }
#pragma unroll
            for (int o = 32; o >= 1; o >>= 1) ss += __shfl_xor(ss, o);
            if (lane < 16) ssq[(size_t)r * 16 + lane] = lane == 0 ? ss : 0.f; }
    }
    for (int f = 0; f < 4; ++f) { const int li = f >> 1; const bool second = f & 1;
        const float* wg = p.in[second ? 18 : 3] + (size_t)li * DM * FF; const float* wu = p.in[second ? 19 : 4] + (size_t)li * DM * FF;
        const float* wd = p.in[second ? 20 : 5] + (size_t)li * FF * DM; const float* gn = p.in[second ? 17 : 2] + li * DM;
        bf16_t* dgu = (bf16_t*)(ws + WS_WGU + f * SZ_WGU); bf16_t* dd = (bf16_t*)(ws + WS_WD + f * SZ_WD);
        xpose_tiles(lds, DM, FF, ValGain{wg, FF, gn}, dgu, 1, 0);
        xpose_tiles(lds, DM, FF, ValGain{wu, FF, gn}, dgu, 1, 128);
        xpose_tiles(lds, FF, DM, ValPlain{wd, DM}, dd, 0, 0);
    }
    xpose_tiles(lds, DM, 3072, ValGain{p.in[7], 3072, p.in[6]}, (bf16_t*)(ws + WS_WGIN), 0, 0);
    xpose_tiles(lds, DM, 512, ValGate{p.in[8], p.in[9], p.in[6]}, (bf16_t*)(ws + WS_WGIN), 0, 3072);
    xpose_tiles(lds, DM, 512, ValGate{p.in[8] + DM * 16, p.in[9] + 16 * 512, p.in[6]}, (bf16_t*)(ws + WS_WGIN), 0, 3584);
    xpose_tiles(lds, DM, DM, ValPlain{p.in[12], DM}, (bf16_t*)(ws + WS_WGOUT), 0, 0);
    xpose_tiles(lds, DM, 1536, ValGain{p.in[13], 1536, p.in[6] + DM}, (bf16_t*)(ws + WS_WAIN), 0, 0);
    xpose_tiles(lds, DM, DM, ValPlain{p.in[16], DM}, (bf16_t*)(ws + WS_WAOUT), 0, 0);
}

__device__ __forceinline__ int gla_row(int b, int c, int to) { return c == 0 ? (to >= 48 ? b * 16 + (to - 48) : -1) : R0 + b * SEQ + (c - 1) * 64 + to; }
__device__ __forceinline__ bf16x8 ld8(ldsp base, int off) { return *(const LAS bf16x8*)(base + off); }

__device__ __forceinline__ void phase_gla_seq(const Params& p, ldsp lds) {
    constexpr int PBF = 528, PQ = 272, PT = 144;
    constexpr int OFF_BF = 0, OFF_QD = 33792, OFF_KI = OFF_QD + 17408, OFF_KET = OFF_KI + 17408, OFF_VT = OFF_KET + 18432, OFF_AM = OFF_VT + 18432,
                  OFF_ST = OFF_AM + 9216, OFF_PART = OFF_ST + 34816, OFF_DEC = OFF_PART + 2048;
    static_assert(OFF_DEC + 512 <= LDS_BYTES, "gla lds");
    unsigned char* ws = p.ws;
    const bf16_t* qb = (const bf16_t*)((unsigned char*)p.out + O_GQ); const bf16_t* kb = (const bf16_t*)(ws + U_GK); const bf16_t* vb = (const bf16_t*)(ws + U_GV);
    const float* gfp = (const float*)((unsigned char*)p.out + O_GF); const float* gbp = (const float*)(ws + U_GB);
    const int tid = get_tid(), lane = tid & 63, wid = __builtin_amdgcn_readfirstlane(tid >> 6), fr = lane & 15, fq = lane >> 4;
    const int dcol = tid & 127, qtr = tid >> 7;
    const int trow = tid >> 3, seg = tid & 7;
    for (int it = blockIdx.x; it < 256; it += gridDim.x) {
        const int item = (gridDim.x == 256) ? ((it & 7) * 32 + (it >> 3)) : it;
        const int vp = item & 1, dir = (item >> 1) & 1, hd = (item >> 2) & 3, b = item >> 4;
        bf16_t* obuf = (bf16_t*)(ws + WS_H) + (size_t)dir * MROWS * 1024;
        const float* gsrc = dir ? gbp : gfp;
        const unsigned colo = (unsigned)(qtr * 16) * 2048u + (unsigned)dcol * 4u, rowo = (unsigned)trow * 1024u + (unsigned)seg * 32u, rowv = (unsigned)trow * 2048u + (unsigned)seg * 32u;
        float gcol[16]; u32x4 rq0, rq1, rk0, rk1, rv0, rv1;
        f32x4 accS[8];
#define GLA_LOAD_SLOW(c_) do { \
        _Pragma("unroll") for (int i = 0; i < 16; ++i) { const int r_ = gla_row(b, (c_), qtr * 16 + i); \
            gcol[i] = r_ >= 0 ? gsrc[(size_t)r_ * 512 + hd * 128 + dcol] : 0.f; } \
        { const int r_ = gla_row(b, (c_), trow); const u32x4 z_ = {0u, 0u, 0u, 0u}; \
          if (r_ >= 0) { const bf16_t* qp_ = qb + (size_t)r_ * 512 + hd * 128 + seg * 16; const bf16_t* kp_ = kb + (size_t)r_ * 512 + hd * 128 + seg * 16; const bf16_t* vp_ = vb + (size_t)r_ * 1024 + hd * 256 + vp * 128 + seg * 16; \
              rq0 = *(const u32x4*)qp_; rq1 = *(const u32x4*)(qp_ + 8); rk0 = *(const u32x4*)kp_; rk1 = *(const u32x4*)(kp_ + 8); rv0 = *(const u32x4*)vp_; rv1 = *(const u32x4*)(vp_ + 8); } \
          else { rq0 = z_; rq1 = z_; rk0 = z_; rk1 = z_; rv0 = z_; rv1 = z_; } } } while (0)
#define GLA_LOAD_FAST(c_) do { const size_t rb_ = (size_t)R0 + (size_t)b * SEQ + (size_t)((c_) - 1) * 64; \
        unsigned colo_ = colo, rowo_ = rowo; asm volatile("" : "+v"(colo_), "+v"(rowo_));     \
        { const char* gB_ = (const char*)(gsrc + rb_ * 512 + hd * 128); \
          _Pragma("unroll") for (int i = 0; i < 16; ++i) gcol[i] = *(const float*)(gB_ + (colo_ + (unsigned)i * 2048u)); } \
        { const char* qB_ = (const char*)(qb + rb_ * 512 + hd * 128); const char* kB_ = (const char*)(kb + rb_ * 512 + hd * 128); const char* vB_ = (const char*)(vb + rb_ * 1024 + hd * 256 + vp * 128); \
          rq0 = *(const u32x4*)(qB_ + rowo_); rq1 = *(const u32x4*)(qB_ + rowo_ + 16u); rk0 = *(const u32x4*)(kB_ + rowo_); rk1 = *(const u32x4*)(kB_ + rowo_ + 16u); \
          rv0 = *(const u32x4*)(vB_ + rowv); rv1 = *(const u32x4*)(vB_ + rowv + 16u); } } while (0)
#define GLA_LOAD(c_) do { if ((c_) != 0) GLA_LOAD_FAST(c_); else GLA_LOAD_SLOW(c_); } while (0)
        GLA_LOAD(dir ? 64 : 0);
#pragma unroll
        for (int i = 0; i < 8; ++i) accS[i] = (f32x4){0.f, 0.f, 0.f, 0.f};
        for (int i = tid; i < 34816 / 4; i += 512) *(LAS unsigned*)(lds + OFF_ST + i * 4) = 0u;
        for (int ci = 0; ci < 65; ++ci) {
            const int c = dir ? 64 - ci : ci;
            float bl[16]; float run = 0.f;
            if (dir == 0) {
#pragma unroll
                for (int i = 0; i < 16; ++i) { run += gcol[i]; bl[i] = run; }
            } else {
#pragma unroll
                for (int i = 15; i >= 0; --i) { run += gcol[i]; bl[i] = run; }
            }
            *(LAS float*)(lds + OFF_PART + (qtr * 128 + dcol) * 4) = run;
            { const unsigned vw[8] = {rv0.x, rv0.y, rv0.z, rv0.w, rv1.x, rv1.y, rv1.z, rv1.w};
#pragma unroll
              for (int i = 0; i < 8; ++i) { const int vv = seg * 16 + 2 * i; const int vts = (((trow >> 3) ^ ((vv >> 3) & 7)) << 4) + (trow & 7) * 2;
                  *(LAS bf16_t*)(lds + OFF_VT + vv * PT + vts) = (bf16_t)(vw[i] & 0xffffu); *(LAS bf16_t*)(lds + OFF_VT + (vv + 1) * PT + vts) = (bf16_t)(vw[i] >> 16); } }
            __syncthreads();
            float offp = 0.f, tot = 0.f;
#pragma unroll
            for (int q2 = 0; q2 < 4; ++q2) { const float pv = *(LAS float*)(lds + OFF_PART + (q2 * 128 + dcol) * 4); tot += pv; if (dir ? (q2 > qtr) : (q2 < qtr)) offp += pv; }
#pragma unroll
            for (int i = 0; i < 16; ++i) *(LAS float*)(lds + OFF_BF + (qtr * 16 + i) * PBF + dcol * 4) = bl[i] + offp;
            if (qtr == 0) *(LAS float*)(lds + OFF_DEC + dcol * 4) = fast_exp(tot);
            __syncthreads();
            { const unsigned qw[8] = {rq0.x, rq0.y, rq0.z, rq0.w, rq1.x, rq1.y, rq1.z, rq1.w}, kw[8] = {rk0.x, rk0.y, rk0.z, rk0.w, rk1.x, rk1.y, rk1.z, rk1.w};
              unsigned qo[8], ko[8]; const int kts = (((trow >> 3) ^ seg) << 4) + (trow & 7) * 2;
#pragma unroll
              for (int i = 0; i < 4; ++i) { const f32x4 bv = *(const LAS f32x4*)(lds + OFF_BF + trow * PBF + (seg * 16 + i * 4) * 4); const f32x4 dc = *(const LAS f32x4*)(lds + OFF_DEC + (seg * 16 + i * 4) * 4);
#pragma unroll
                  for (int j = 0; j < 2; ++j) { const float e0 = fast_exp(bv[2 * j]), e1 = fast_exp(bv[2 * j + 1]); const unsigned qq = qw[i * 2 + j], kk = kw[i * 2 + j];
                      const float k0 = bflo(kk) * __builtin_amdgcn_rcpf(e0), k1 = bfhi(kk) * __builtin_amdgcn_rcpf(e1);
                      qo[i * 2 + j] = cvt_pk_bf16(bflo(qq) * e0, bfhi(qq) * e1); ko[i * 2 + j] = cvt_pk_bf16(k0, k1);
                      const unsigned kew = cvt_pk_bf16(k0 * dc[2 * j], k1 * dc[2 * j + 1]); const int d = seg * 16 + i * 4 + 2 * j;
                      *(LAS bf16_t*)(lds + OFF_KET + d * PT + kts) = (bf16_t)(kew & 0xffffu); *(LAS bf16_t*)(lds + OFF_KET + (d + 1) * PT + kts) = (bf16_t)(kew >> 16); } }
              *(LAS u32x4*)(lds + OFF_QD + trow * PQ + seg * 32) = (u32x4){qo[0], qo[1], qo[2], qo[3]}; *(LAS u32x4*)(lds + OFF_QD + trow * PQ + seg * 32 + 16) = (u32x4){qo[4], qo[5], qo[6], qo[7]};
              *(LAS u32x4*)(lds + OFF_KI + trow * PQ + seg * 32) = (u32x4){ko[0], ko[1], ko[2], ko[3]}; *(LAS u32x4*)(lds + OFF_KI + trow * PQ + seg * 32 + 16) = (u32x4){ko[4], ko[5], ko[6], ko[7]}; }
            if (ci + 1 < 65) { const int c2 = dir ? 63 - ci : ci + 1; GLA_LOAD(c2); }
            __syncthreads();
#pragma unroll
            for (int xx = 0; xx < 2; ++xx) { const int x = 2 * wid + xx, si = x >> 2, ti = x & 3; f32x4 a4 = {0.f, 0.f, 0.f, 0.f};
                if (dir ? (si >= ti) : (si <= ti)) {
#pragma unroll
                    for (int kk = 0; kk < 4; ++kk) a4 = __builtin_amdgcn_mfma_f32_16x16x32_bf16(ld8(lds, OFF_KI + (si * 16 + fr) * PQ + kk * 64 + fq * 16), ld8(lds, OFF_QD + (ti * 16 + fr) * PQ + kk * 64 + fq * 16), a4, 0, 0, 0);
#pragma unroll
                    for (int i = 0; i < 4; ++i) { const int sd = si * 16 + 4 * fq + i - (ti * 16 + fr); if (dir ? (sd < 0) : (sd > 0)) a4[i] = 0.f; }
                }
                u32x2 w; w.x = cvt_pk_bf16(a4[0], a4[1]); w.y = cvt_pk_bf16(a4[2], a4[3]);
                *(LAS u32x2*)(lds + OFF_AM + (ti * 16 + fr) * PT + (si * 16 + 4 * fq) * 2) = w; }
            __syncthreads();
            { const int vsw = (2 * wid + (fr >> 3)) & 7; bf16x8 fv[2], fs[4];
#pragma unroll
              for (int kk = 0; kk < 2; ++kk) fv[kk] = ld8(lds, OFF_VT + (wid * 16 + fr) * PT + (((kk * 4 + fq) ^ vsw) << 4));
#pragma unroll
              for (int kk = 0; kk < 4; ++kk) fs[kk] = ld8(lds, OFF_ST + (wid * 16 + fr) * PQ + kk * 64 + fq * 16);
#pragma unroll
              for (int ti = 0; ti < 4; ++ti) { f32x4 a4 = {0.f, 0.f, 0.f, 0.f};
#pragma unroll
                  for (int kk = 0; kk < 2; ++kk) a4 = __builtin_amdgcn_mfma_f32_16x16x32_bf16(fv[kk], ld8(lds, OFF_AM + (ti * 16 + fr) * PT + kk * 64 + fq * 16), a4, 0, 0, 0);
#pragma unroll
                  for (int kk = 0; kk < 4; ++kk) a4 = __builtin_amdgcn_mfma_f32_16x16x32_bf16(fs[kk], ld8(lds, OFF_QD + (ti * 16 + fr) * PQ + kk * 64 + fq * 16), a4, 0, 0, 0);
                  const int r = gla_row(b, c, ti * 16 + fr);
                  if (r >= 0) { u32x2 w; w.x = cvt_pk_bf16(a4[0], a4[1]); w.y = cvt_pk_bf16(a4[2], a4[3]); *(u32x2*)(obuf + (size_t)r * 1024 + hd * 256 + vp * 128 + wid * 16 + 4 * fq) = w; } } }
            __syncthreads();
            { const f32x4 dc = *(const LAS f32x4*)(lds + OFF_DEC + (16 * wid + 4 * fq) * 4); bf16x8 fk[2];
#pragma unroll
              for (int kk = 0; kk < 2; ++kk) fk[kk] = ld8(lds, OFF_KET + (16 * wid + fr) * PT + (((kk * 4 + fq) ^ (wid & 7)) << 4));
#pragma unroll
              for (int vbk = 0; vbk < 8; ++vbk) { accS[vbk] = accS[vbk] * dc; const int vsw = (2 * vbk + (fr >> 3)) & 7;
#pragma unroll
                  for (int kk = 0; kk < 2; ++kk) accS[vbk] = __builtin_amdgcn_mfma_f32_16x16x32_bf16(fk[kk], ld8(lds, OFF_VT + (vbk * 16 + fr) * PT + (((kk * 4 + fq) ^ vsw) << 4)), accS[vbk], 0, 0, 0);
                  u32x2 w; w.x = cvt_pk_bf16(accS[vbk][0], accS[vbk][1]); w.y = cvt_pk_bf16(accS[vbk][2], accS[vbk][3]);
                  *(LAS u32x2*)(lds + OFF_ST + (vbk * 16 + fr) * PQ + (16 * wid + 4 * fq) * 2) = w; } }
            __syncthreads();
        }
#undef GLA_LOAD
#undef GLA_LOAD_FAST
#undef GLA_LOAD_SLOW
    }
}

__device__ __forceinline__ void phase_gla_post(const Params& p) {
    unsigned char* ws = p.ws; const bf16_t* o = (const bf16_t*)(ws + WS_H); const bf16_t* ob = o + (size_t)MROWS * 1024; const bf16_t* r = (const bf16_t*)(ws + U_GR); bf16_t* og = (bf16_t*)(ws + U_GV);
    const float* hn = p.in[11]; const int tid = get_tid(), lane = tid & 63, wid = tid >> 6;
    float g[16];
#pragma unroll
    for (int i = 0; i < 16; ++i) g[i] = hn[(lane & 15) * 16 + i];
    for (int row = blockIdx.x * 8 + wid; row < MROWS; row += gridDim.x * 8) {
        const size_t off = (size_t)row * 1024 + lane * 16;
        const u32x4 o0 = *(const u32x4*)(o + off), o1 = *(const u32x4*)(o + off + 8), p0 = *(const u32x4*)(ob + off), p1 = *(const u32x4*)(ob + off + 8), r0 = *(const u32x4*)(r + off), r1 = *(const u32x4*)(r + off + 8);
        const unsigned ow[8] = {o0.x, o0.y, o0.z, o0.w, o1.x, o1.y, o1.z, o1.w}, pw[8] = {p0.x, p0.y, p0.z, p0.w, p1.x, p1.y, p1.z, p1.w}, rw[8] = {r0.x, r0.y, r0.z, r0.w, r1.x, r1.y, r1.z, r1.w};
        float x[16]; float ss = 0.f;
#pragma unroll
        for (int i = 0; i < 8; ++i) { x[2 * i] = bflo(ow[i]) + bflo(pw[i]); x[2 * i + 1] = bfhi(ow[i]) + bfhi(pw[i]); ss += x[2 * i] * x[2 * i] + x[2 * i + 1] * x[2 * i + 1]; }
        ss += __shfl_xor(ss, 1); ss += __shfl_xor(ss, 2); ss += __shfl_xor(ss, 4); ss += __shfl_xor(ss, 8);
        const float rs = rsqrtf(ss * (1.f / 256.f) + EPS); unsigned w[8];
#pragma unroll
        for (int i = 0; i < 8; ++i) w[i] = cvt_pk_bf16(x[2 * i] * rs * g[2 * i] * silu_f(bflo(rw[i])), x[2 * i + 1] * rs * g[2 * i + 1] * silu_f(bfhi(rw[i])));
        *(u32x4*)(og + off) = (u32x4){w[0], w[1], w[2], w[3]}; *(u32x4*)(og + off + 8) = (u32x4){w[4], w[5], w[6], w[7]};
    }
}

__device__ __forceinline__ void attn_prep_head(bf16_t* base, int pos, bool real, int ax, int ic, const float* gn) {
    const int d0 = ax * 64 + ic * 8;
    const u32x4 wa = *(const u32x4*)(base + d0), wb = *(const u32x4*)(base + d0 + 32);
    const unsigned aw[4] = {wa.x, wa.y, wa.z, wa.w}, bw[4] = {wb.x, wb.y, wb.z, wb.w};
    float xa[8], xb[8]; float ss = 0.f;
#pragma unroll
    for (int j = 0; j < 4; ++j) { xa[2 * j] = bflo(aw[j]); xa[2 * j + 1] = bfhi(aw[j]); xb[2 * j] = bflo(bw[j]); xb[2 * j + 1] = bfhi(bw[j]); }
#pragma unroll
    for (int j = 0; j < 8; ++j) ss += xa[j] * xa[j] + xb[j] * xb[j];
    ss += __shfl_xor(ss, 1); ss += __shfl_xor(ss, 2); ss += __shfl_xor(ss, 4);
    const float rs = rsqrtf(ss * (1.f / 128.f) + EPS);
    const float t = real ? (float)(ax ? (pos & 63) : (pos >> 6)) : 0.f;
    const f32x4 ga0 = *(const f32x4*)(gn + d0), ga1 = *(const f32x4*)(gn + d0 + 4), gb0 = *(const f32x4*)(gn + d0 + 32), gb1 = *(const f32x4*)(gn + d0 + 36);
    float oa[8], ob[8];
#pragma unroll
    for (int j = 0; j < 8; ++j) { const float invf = __builtin_amdgcn_exp2f(-(float)(ic * 8 + j) * (2.0f / 64.0f) * 13.287712379549449f);
        float rev = t * invf * 0.15915494309189535f; rev -= floorf(rev);
        const float sn = __builtin_amdgcn_sinf(rev), cs = __builtin_amdgcn_cosf(rev);
        const float ya = xa[j] * rs * (j < 4 ? ga0[j & 3] : ga1[j & 3]), yb = xb[j] * rs * (j < 4 ? gb0[j & 3] : gb1[j & 3]);
        oa[j] = ya * cs - yb * sn; ob[j] = yb * cs + ya * sn; }
    *(u32x4*)(base + d0) = (u32x4){cvt_pk_bf16(oa[0], oa[1]), cvt_pk_bf16(oa[2], oa[3]), cvt_pk_bf16(oa[4], oa[5]), cvt_pk_bf16(oa[6], oa[7])};
    *(u32x4*)(base + d0 + 32) = (u32x4){cvt_pk_bf16(ob[0], ob[1]), cvt_pk_bf16(ob[2], ob[3]), cvt_pk_bf16(ob[4], ob[5]), cvt_pk_bf16(ob[6], ob[7])};
}
__device__ __forceinline__ void phase_attn_prep(const Params& p) {
    unsigned char* ws = p.ws; bf16_t* k = (bf16_t*)(ws + U_AK);
    const float* kn = p.in[15]; const int tid = get_tid(), lane = tid & 63, wid = tid >> 6;
    const int sub = lane & 7, ax = sub >> 2, ic = sub & 3, hl = lane >> 3;
    for (int r4 = blockIdx.x * 8 + wid; r4 < MROWS / 4; r4 += gridDim.x * 8) { const int row = r4 * 4 + (hl >> 1);
        attn_prep_head(k + (size_t)row * 256 + (hl & 1) * 128, (row - R0) & 4095, row >= R0, ax, ic, kn); }
}

__device__ __forceinline__ void phase_final(const Params& p) {
    unsigned char* ws = p.ws; const bf16_t* hb = (const bf16_t*)(ws + WS_HB); const float* ssq = (const float*)(ws + WS_SSQ) + 6 * (size_t)MROWS * 16; const float* gn = p.in[21];
    const int tid = get_tid(), lane = tid & 63, wid = tid >> 6;
    f32x4 g[4];
#pragma unroll
    for (int i = 0; i < 4; ++i) g[i] = *(const f32x4*)(gn + i * 256 + lane * 4);
    float pofs = 0.f;
    if (TPROBE_MASK) pofs = sqrtf(*(const float*)(ws + WS_NEED) * 1e-8f);
    for (int rq = blockIdx.x * 8 + wid; rq < (MROWS - R0) / 4; rq += gridDim.x * 8) {
        u32x2 w[4][4]; float sr[4];
#pragma unroll
        for (int k = 0; k < 4; ++k) { const int row = R0 + rq * 4 + k;
#pragma unroll
            for (int i = 0; i < 4; ++i) w[k][i] = *(const u32x2*)(hb + (size_t)row * DM + i * 256 + lane * 4);
            sr[k] = row_rstd(ssq, row); }
#pragma unroll
        for (int k = 0; k < 4; ++k) { const int row = R0 + rq * 4 + k;
#pragma unroll
            for (int i = 0; i < 4; ++i) { const f32x4 v = {bflo(w[k][i].x), bfhi(w[k][i].x), bflo(w[k][i].y), bfhi(w[k][i].y)};
                __builtin_nontemporal_store(v * sr[k] * g[i] + pofs, (f32x4*)(p.out + (size_t)(row - R0) * DM + i * 256 + lane * 4)); } }
    }
}

namespace att {
constexpr int D = 128, KVBLK = 64, LDQ = 1024, LDK = 256, LDO = 1024;
constexpr float SCALE = 0.088388347648318440f, THR = 8.f;
constexpr size_t SHM_V = KVBLK * D * 2, SHM_K = KVBLK * D * 2, SHM_ATTN = 2 * SHM_V + 2 * SHM_K + 8 * 64 * 4;
#define KSWZ(row, colB) ((row) * 256 + ((colB) ^ (((row) & 7) << 4)))
#define SBAR() __builtin_amdgcn_sched_barrier(0)
__device__ __forceinline__ int crow(int r, int hi) { return (r & 3) + 8 * (r >> 2) + 4 * hi; }
__device__ __forceinline__ void partialSM(f32x16& p0, f32x16& p1, float& m_reg, float& mn, float& alpha) {
  constexpr float C = SCALE * 1.4426950408889634f;
  float pmax = p0[0]; for (int r = 1; r < 16; ++r) pmax = fmaxf(pmax, p0[r]); for (int r = 0; r < 16; ++r) pmax = fmaxf(pmax, p1[r]);
  { auto rr = __builtin_amdgcn_permlane32_swap(__float_as_uint(pmax), __float_as_uint(pmax), false, false);
    pmax = fmaxf(__uint_as_float(rr[0]), __uint_as_float(rr[1])); }
  if (__builtin_expect(__all(pmax - m_reg <= THR / SCALE), 1)) { mn = m_reg; alpha = 1.f; }
  else { mn = fmaxf(m_reg, pmax); alpha = __builtin_amdgcn_exp2f((m_reg - mn) * C); m_reg = mn; }
  float mnC = -mn * C;
  for (int r = 0; r < 16; ++r) p0[r] = fmaf(p0[r], C, mnC); for (int r = 0; r < 16; ++r) p1[r] = fmaf(p1[r], C, mnC);
  for (int r = 0; r < 16; ++r) p0[r] = __builtin_amdgcn_exp2f(p0[r]);
}
__device__ __forceinline__ void finishSM(f32x16& p0, f32x16& p1, float alpha, float& l_reg, bf16x8& pa0, bf16x8& pa1, bf16x8& pa2, bf16x8& pa3) {
  for (int r = 0; r < 16; ++r) p1[r] = __builtin_amdgcn_exp2f(p1[r]);
  float ps = 0; for (int r = 0; r < 16; ++r) ps += p0[r]; for (int r = 0; r < 16; ++r) ps += p1[r];
  { auto rr = __builtin_amdgcn_permlane32_swap(__float_as_uint(ps), __float_as_uint(ps), false, false);
    ps = __uint_as_float(rr[0]) + __uint_as_float(rr[1]); }
  l_reg = l_reg * alpha + ps;
#define PK4(P, BASE, OUT) do { unsigned a0 = cvt_pk_bf16(P[BASE + 0], P[BASE + 1]), a1 = cvt_pk_bf16(P[BASE + 2], P[BASE + 3]);   \
    unsigned b0 = cvt_pk_bf16(P[BASE + 4], P[BASE + 5]), b1 = cvt_pk_bf16(P[BASE + 6], P[BASE + 7]);                              \
    auto r0 = __builtin_amdgcn_permlane32_swap(a0, b0, false, false); auto r1 = __builtin_amdgcn_permlane32_swap(a1, b1, false, false); \
    u32x4 w = {r0[0], r1[0], r0[1], r1[1]}; OUT = *reinterpret_cast<bf16x8*>(&w); } while (0)
  PK4(p0, 0, pa0); PK4(p0, 8, pa1); PK4(p1, 0, pa2); PK4(p1, 8, pa3);
#undef PK4
}
__device__ __forceinline__ void qkt(f32x16& p0, f32x16& p1, const char* Ks, const bf16x8* qr, int r32, int hi) {
  p0 = f32x16{}; p1 = f32x16{};
  for (int d0 = 0; d0 < 8; ++d0) { int cb = (d0 * 16 + hi * 8) * 2;
    bf16x8 b0 = *reinterpret_cast<const bf16x8*>(Ks + KSWZ(r32, cb));
    bf16x8 b1 = *reinterpret_cast<const bf16x8*>(Ks + KSWZ(32 + r32, cb));
    p0 = __builtin_amdgcn_mfma_f32_32x32x16_bf16(b0, qr[d0], p0, 0, 0, 0);
    p1 = __builtin_amdgcn_mfma_f32_32x32x16_bf16(b1, qr[d0], p1, 0, 0, 0); }
}
__device__ __forceinline__ int v_st(int k, int c) { const int kk = (k & ~0xC) | ((k & 4) << 1) | ((k & 8) >> 1); return ((kk >> 3) * 4 + (c >> 5)) * 512 + ((kk & 7) * 32 + (c & 31)) * 2; }
__device__ __forceinline__ int v_rd_base(int lane) { return ((lane & 3) << 3) | (((lane >> 2) & 3) << 6) | (((lane >> 4) & 1) << 5) | (((lane >> 5) & 1) << 8); }
constexpr int v_rd_off(int d0, int ks, int half) { return d0 * 512 + ks * 4096 + half * 2048; }
template <int OFF> __device__ __forceinline__ s16x4 tr_read(int vb) {
  s16x4 r; asm volatile("ds_read_b64_tr_b16 %0, %1 offset:%2" : "=&v"(r) : "v"(vb), "i"(OFF) : "memory"); return r;
}
template <int D0> __device__ __forceinline__ void pv_one(f32x16& od, int vb, bf16x8 pa0, bf16x8 pa1, bf16x8 pa2, bf16x8 pa3) {
  const s16x4 l0 = tr_read<v_rd_off(D0, 0, 0)>(vb), h0 = tr_read<v_rd_off(D0, 0, 1)>(vb), l1 = tr_read<v_rd_off(D0, 1, 0)>(vb), h1 = tr_read<v_rd_off(D0, 1, 1)>(vb);
  const s16x4 l2 = tr_read<v_rd_off(D0, 2, 0)>(vb), h2 = tr_read<v_rd_off(D0, 2, 1)>(vb), l3 = tr_read<v_rd_off(D0, 3, 0)>(vb), h3 = tr_read<v_rd_off(D0, 3, 1)>(vb);
  asm volatile("s_waitcnt lgkmcnt(0)" ::: "memory"); SBAR();
#define PK(L, H) (bf16x8){L[0], L[1], L[2], L[3], H[0], H[1], H[2], H[3]}
  od = __builtin_amdgcn_mfma_f32_32x32x16_bf16(pa0, PK(l0, h0), od, 0, 0, 0);
  od = __builtin_amdgcn_mfma_f32_32x32x16_bf16(pa1, PK(l1, h1), od, 0, 0, 0);
  od = __builtin_amdgcn_mfma_f32_32x32x16_bf16(pa2, PK(l2, h2), od, 0, 0, 0);
  od = __builtin_amdgcn_mfma_f32_32x32x16_bf16(pa3, PK(l3, h3), od, 0, 0, 0);
#undef PK
}
__device__ __forceinline__ void pv_d0(f32x16* o, int vb, bf16x8 pa0, bf16x8 pa1, bf16x8 pa2, bf16x8 pa3) {
  pv_one<0>(o[0], vb, pa0, pa1, pa2, pa3); pv_one<1>(o[1], vb, pa0, pa1, pa2, pa3); pv_one<2>(o[2], vb, pa0, pa1, pa2, pa3); pv_one<3>(o[3], vb, pa0, pa1, pa2, pa3);
}
__device__ __forceinline__ void attn_body(const bf16_t* Qb, const bf16_t* K0, const bf16_t* V0, const bf16_t* K1, const bf16_t* V1, bf16_t* Ob, char* lds, const float* qn, int qpos0) {
  constexpr int NT = 65;
  const int tid = get_tid(), wid = tid >> 6, lane = tid & 63, r32 = lane & 31, hi = lane >> 5;
  char* V_lds = lds; char* K_lds = lds + 2 * SHM_V;
  float* wsf = (float*)(lds + 2 * SHM_V + 2 * SHM_K) + wid * 64; float* li_l = wsf; float* al_l = wsf + 32;
  float m_reg = -1e30f, l_reg = 0; f32x16 o[4] = {}; bf16x8 qr[8];
  const bf16_t* Qw = Qb + (long)(wid * 32 + r32) * LDQ + hi * 8;
#pragma unroll
  for (int d0 = 0; d0 < 8; ++d0) qr[d0] = *reinterpret_cast<const bf16x8*>(Qw + d0 * 16);
  { float ss = 0.f;
#pragma unroll
    for (int d0 = 0; d0 < 8; ++d0)
#pragma unroll
      for (int j = 0; j < 8; ++j) { const float x = bf2f((bf16_t)qr[d0][j]); ss += x * x; }
    ss += __shfl_xor(ss, 32);
    const float rs = rsqrtf(ss * (1.f / 128.f) + EPS);
    const int pos = (qpos0 + wid * 32 + r32) & 4095;
#pragma unroll
    for (int ax = 0; ax < 2; ++ax) { const float t = (float)(ax ? (pos & 63) : (pos >> 6));
#pragma unroll
      for (int bl = 0; bl < 2; ++bl) { const int da = ax * 4 + bl, db = da + 2; unsigned wa[4], wb[4];
        const f32x4 ga0 = *(const f32x4*)(qn + da * 16 + hi * 8), ga1 = *(const f32x4*)(qn + da * 16 + hi * 8 + 4), gb0 = *(const f32x4*)(qn + db * 16 + hi * 8), gb1 = *(const f32x4*)(qn + db * 16 + hi * 8 + 4);
#pragma unroll
        for (int jp = 0; jp < 4; ++jp) { float oa[2], ob[2];
#pragma unroll
          for (int jj = 0; jj < 2; ++jj) { const int j = jp * 2 + jj;
            const float invf = __builtin_amdgcn_exp2f(-(float)(bl * 16 + j) * (2.0f / 64.0f) * 13.287712379549449f) * __builtin_amdgcn_exp2f(-(float)hi * (16.0f / 64.0f) * 13.287712379549449f);
            float rev = t * invf * 0.15915494309189535f; rev -= floorf(rev);
            const float sn = __builtin_amdgcn_sinf(rev), cs = __builtin_amdgcn_cosf(rev);
            const float ya = bf2f((bf16_t)qr[da][j]) * rs * (j < 4 ? ga0[j & 3] : ga1[j & 3]), yb = bf2f((bf16_t)qr[db][j]) * rs * (j < 4 ? gb0[j & 3] : gb1[j & 3]);
            oa[jj] = ya * cs - yb * sn; ob[jj] = yb * cs + ya * sn; }
          wa[jp] = cvt_pk_bf16(oa[0], oa[1]); wb[jp] = cvt_pk_bf16(ob[0], ob[1]); }
        { u32x4 w = {wa[0], wa[1], wa[2], wa[3]}; qr[da] = *reinterpret_cast<bf16x8*>(&w); }
        { u32x4 w = {wb[0], wb[1], wb[2], wb[3]}; qr[db] = *reinterpret_cast<bf16x8*>(&w); } } }
  }
  const int sr = tid >> 4, sc = (tid & 15) * 8, vst0 = v_st(sr, sc), vst1 = v_st(32 + sr, sc);
  const int vb0 = (int)(uintptr_t)V_lds + v_rd_base(lane);
  struct { bf16x8 vs0, vs1, ks0, ks1; } sr_[2];
#define TKP(T) ((T) == 0 ? K0 : K1 + (long)((T) - 1) * 64 * LDK)
#define TVP(T) ((T) == 0 ? V0 : V1 + (long)((T) - 1) * 64 * LDK)
#define SLOAD(i, T) do { const bf16_t* kp_ = TKP(T); const bf16_t* vp_ = TVP(T); \
    sr_[i].vs0 = *reinterpret_cast<const bf16x8*>(&vp_[(long)(sr) * LDK + sc]); sr_[i].vs1 = *reinterpret_cast<const bf16x8*>(&vp_[(long)(32 + sr) * LDK + sc]); \
    sr_[i].ks0 = *reinterpret_cast<const bf16x8*>(&kp_[(long)(sr) * LDK + sc]); sr_[i].ks1 = *reinterpret_cast<const bf16x8*>(&kp_[(long)(32 + sr) * LDK + sc]); } while (0)
#define SWRITE(b, i) do { *(bf16x8*)(V_lds + (b) * SHM_V + vst0) = sr_[i].vs0;          \
    *(bf16x8*)(V_lds + (b) * SHM_V + vst1) = sr_[i].vs1; int kc = sc * 2;               \
    *(bf16x8*)(K_lds + (b) * SHM_K + KSWZ(sr, kc)) = sr_[i].ks0;                       \
    *(bf16x8*)(K_lds + (b) * SHM_K + KSWZ(32 + sr, kc)) = sr_[i].ks1; } while (0)
#define SWAIT() asm volatile("s_waitcnt vmcnt(4)" ::: "memory")
#define RESC(a) do { if (__any((a) < 1.f)) { if (hi == 0) al_l[r32] = (a); asm volatile("s_waitcnt lgkmcnt(0)" ::: "memory"); \
    for (int d = 0; d < 4; ++d) for (int r = 0; r < 16; ++r) o[d][r] *= al_l[crow(r, hi)]; } } while (0)
  f32x16 pA0, pA1, pB0, pB1; float mnA, mnB, alA, alB; bf16x8 pa0, pa1, pa2, pa3;
  constexpr int SE = 0, SO = 1;
  SLOAD(SE, 0); asm volatile("s_waitcnt vmcnt(0)" ::: "memory"); SWRITE(0, SE); __syncthreads();
  qkt(pA0, pA1, K_lds, qr, r32, hi);
#pragma unroll
  for (int r = 8; r < 16; ++r) pA0[r] = -1e30f;
#pragma unroll
  for (int r = 0; r < 16; ++r) pA1[r] = -1e30f;
  partialSM(pA0, pA1, m_reg, mnA, alA);
  SLOAD(SO, 1); SLOAD(SE, 2);
  SWAIT(); SWRITE(1, SO); __syncthreads();
  for (int j = 1; j + 1 < NT; j += 2) {
    SBAR(); qkt(pB0, pB1, K_lds + SHM_K, qr, r32, hi);
    finishSM(pA0, pA1, alA, l_reg, pa0, pa1, pa2, pa3); SBAR();
    if (j + 2 < NT) SLOAD(SO, j + 2); SBAR();
    pv_d0(o, vb0, pa0, pa1, pa2, pa3); partialSM(pB0, pB1, m_reg, mnB, alB);
    __syncthreads(); SWAIT(); SWRITE(0, SE);
    RESC(alB); __syncthreads();
    SBAR(); qkt(pA0, pA1, K_lds, qr, r32, hi);
    finishSM(pB0, pB1, alB, l_reg, pa0, pa1, pa2, pa3); SBAR();
    if (j + 3 < NT) SLOAD(SE, j + 3); SBAR();
    pv_d0(o, vb0 + (int)SHM_V, pa0, pa1, pa2, pa3); partialSM(pA0, pA1, m_reg, mnA, alA);
    __syncthreads(); SWAIT(); SWRITE(1, SO);
    RESC(alA); __syncthreads();
  }
  finishSM(pA0, pA1, alA, l_reg, pa0, pa1, pa2, pa3); SBAR();
  pv_d0(o, vb0, pa0, pa1, pa2, pa3);
  if (hi == 0) li_l[r32] = l_reg; asm volatile("s_waitcnt lgkmcnt(0)" ::: "memory");
  float rli[16];
#pragma unroll
  for (int r = 0; r < 16; ++r) rli[r] = __builtin_amdgcn_rcpf(li_l[crow(r, hi)]);
  bf16_t* Ow = Ob + (long)(wid * 32) * LDO;
#pragma unroll
  for (int r = 0; r < 16; ++r) { int orow = crow(r, hi);
    for (int d0 = 0; d0 < 4; ++d0) { const float v = o[d0][r] * rli[r]; Ow[(long)orow * LDO + d0 * 32 + r32] = (bf16_t)(cvt_pk_bf16(v, v) & 0xffffu); } }
#undef SLOAD
#undef SWRITE
#undef SWAIT
#undef RESC
#undef TKP
#undef TVP
}
}

__device__ __forceinline__ void phase_attn(const Params& p, char* lds) {
    unsigned char* ws = p.ws; const bf16_t* q = (const bf16_t*)(ws + U_AQ); const bf16_t* k = (const bf16_t*)(ws + U_AK); const bf16_t* v = (const bf16_t*)(ws + U_AV); bf16_t* ao = (bf16_t*)(ws + U_AO);
    const bool xmap = (gridDim.x == 256);
    for (int it = blockIdx.x, rnd = 0; it < 2048; it += gridDim.x, ++rnd) {
        int item = it;
        if (xmap) { const int x = blockIdx.x & 7, j = blockIdx.x >> 3, pair = x * 4 + (rnd >> 1), i64 = (rnd & 1) * 32 + j; item = (pair >> 1) * 128 + ((pair & 1) * 4 + (i64 >> 4)) * 16 + (i64 & 15); }
        const int qb = item & 15, hh = (item >> 4) & 7, b = item >> 7, kvh = hh >> 2;
        const size_t qrow = (size_t)R0 + (size_t)b * SEQ + qb * 256;
        att::attn_body(q + qrow * 1024 + hh * 128, k + (size_t)(b * 16) * 256 + kvh * 128, v + (size_t)(b * 16) * 256 + kvh * 128,
                       k + ((size_t)R0 + (size_t)b * SEQ) * 256 + kvh * 128, v + ((size_t)R0 + (size_t)b * SEQ) * 256 + kvh * 128,
                       ao + qrow * 1024 + hh * 128, lds, p.in[14], qb * 256);
        __syncthreads();
    }
}

#define XB_TMO      128
#define XB_XCNT(j)  (256  + 64 * (j))
#define XB_XSUB(j)  (1280 + 64 * (j))
#define XB_XGEN(j)  (2304 + 64 * (j))
#define XB_TOP      3328
#define XB_TOPGEN   3392
#define XCD_BAR_WORDS 3456
#define XB_SPIN_CAP (1u << 18)
__device__ __forceinline__ unsigned xb_ld(unsigned* p)              { return __hip_atomic_load(p, __ATOMIC_RELAXED, __HIP_MEMORY_SCOPE_AGENT); }
__device__ __forceinline__ unsigned xb_add(unsigned* p, unsigned v) { return __hip_atomic_fetch_add(p, v, __ATOMIC_RELAXED, __HIP_MEMORY_SCOPE_AGENT); }
__device__ __forceinline__ unsigned xb_xcc_id() { return (unsigned)__builtin_amdgcn_s_getreg((3 << 11) | 20) & 0xFu; }
#define XB_SPIN(cond, bar) do { unsigned _sp = 0; while (cond) { __builtin_amdgcn_s_sleep(1); \
    if ((++_sp & 255u) == 0u) { if (xb_ld(&(bar)[XB_TMO])) break; if (_sp > XB_SPIN_CAP) { atomicAdd(&(bar)[XB_TMO], 1u); break; } } } } while (0)
struct XcdBarrier { unsigned* bar; unsigned x; volatile LAS unsigned* st; };
__device__ __forceinline__ XcdBarrier xcd_barrier_post(unsigned* bar, volatile LAS unsigned* st) {
    XcdBarrier b; b.bar = bar; b.x = xb_xcc_id(); b.st = st;
    if (threadIdx.x == 0) (void)xb_add(&bar[XB_XCNT(b.x)], 1u);
    return b;
}
__device__ __forceinline__ void xcd_barrier_complete(unsigned* bar, unsigned x, unsigned& nloc, unsigned& nx) {
    const unsigned G = gridDim.x * gridDim.y * gridDim.z;
    unsigned sum, cnt, mine, sp = 0u;
    for (;;) {
        sum = 0u; cnt = 0u; mine = 0u;
#pragma unroll
        for (unsigned j = 0; j < 16; ++j) { const unsigned c = xb_ld(&bar[XB_XCNT(j)]); sum += c; cnt += (c > 0u) ? 1u : 0u; mine = (j == x) ? c : mine; }
        if (sum == G) break;
        __builtin_amdgcn_s_sleep(1);
        if ((++sp & 255u) == 0u) { if (xb_ld(&bar[XB_TMO])) break; if (sp > XB_SPIN_CAP) { atomicAdd(&bar[XB_TMO], 1u); break; } }
    }
    nloc = mine > 0u ? mine : 1u; nx = cnt > 0u ? cnt : 1u;
}
__device__ __forceinline__ void xcd_barrier(const XcdBarrier& b) {
    asm volatile("s_waitcnt vmcnt(0)" ::: "memory");
    __syncthreads();
    if (threadIdx.x == 0) {
        unsigned* bar = b.bar;
        __builtin_amdgcn_s_waitcnt(0);
        unsigned nloc = b.st[0], nx = b.st[1];
        if (nloc == 0u) { xcd_barrier_complete(bar, b.x, nloc, nx); b.st[0] = nloc; b.st[1] = nx; }
        const unsigned old = xb_add(&bar[XB_XSUB(b.x)], 1u);
        const unsigned gen = old / nloc;
        if (old + 1u == (gen + 1u) * nloc) {
            __builtin_amdgcn_fence(__ATOMIC_RELEASE, "agent");
            asm volatile("s_waitcnt vmcnt(0)" ::: "memory");
            const unsigned og = xb_add(&bar[XB_TOP], 1u);
            const unsigned tg = og / nx;
            if (og + 1u == (tg + 1u) * nx) xb_add(&bar[XB_TOPGEN], 1u);
            else XB_SPIN(xb_ld(&bar[XB_TOPGEN]) == tg, bar);
            __builtin_amdgcn_fence(__ATOMIC_ACQUIRE, "agent");
            xb_add(&bar[XB_XGEN(b.x)], 1u);
            asm volatile("s_waitcnt vmcnt(0)" ::: "memory");
        } else {
            XB_SPIN(xb_ld(&bar[XB_XGEN(b.x)]) == gen, bar);
            __builtin_amdgcn_fence(__ATOMIC_ACQUIRE, "agent");
            asm volatile("s_waitcnt vmcnt(0)" ::: "memory");
        }
    }
    __syncthreads();
}

__global__ void __launch_bounds__(512, 1) mega_fwd(Params p) {
    extern __shared__ __attribute__((aligned(16))) unsigned char shm[];
    ldsp lds = (ldsp)shm;
    unsigned char* ws = p.ws;
    bf16_t* hb = (bf16_t*)(ws + WS_HB); float* ssq = (float*)(ws + WS_SSQ);
    const int G = gridDim.x, c = blockIdx.x;
    if (threadIdx.x < 4) ((volatile LAS unsigned*)(lds + LDS_BYTES))[threadIdx.x] = 0u;
    if (blockIdx.x == 0 && p.hi - p.lo > 1) for (int i = threadIdx.x; i < XCD_BAR_WORDS; i += 512) ((unsigned*)(p.ws + WS_BAR))[i] = 0u;
    __syncthreads();
    unsigned long long tp0 = 0; float tpsum = 0.f;
    for (int ph = p.lo; ph < p.hi; ++ph) {
        if (TPROBE_MASK && blockIdx.x == 0 && threadIdx.x == 0) tp0 = __builtin_amdgcn_s_memrealtime();
        int kind, f = 0, nin = 0, nout = 0;
        switch (ph) {
            case 0: kind = 0; break;
            case 1: kind = 1; f = 0; nin = 0; break;
            case 2: kind = 2; f = 0; nout = (DIAG == 2) ? 6 : 1; break;
            case 3: kind = 3; nin = 1; break;
            case 4: kind = 4; break;
            case 5: kind = 5; break;
            case 6: kind = 2; f = 4; nout = (DIAG == 3) ? 6 : 2; break;
            case 7: kind = 1; f = 1; nin = 2; break;
            case 8: kind = 2; f = 1; nout = 3; break;
            case 9: kind = 1; f = 2; nin = 3; break;
            case 10: kind = 2; f = 2; nout = 4; break;
            case 11: kind = 6; nin = 4; break;
            case 12: kind = 7; break;
            case 13: kind = 8; break;
            case 14: kind = 2; f = 5; nout = 5; break;
            case 15: kind = 1; f = 3; nin = 5; break;
            case 16: kind = 2; f = 3; nout = 6; break;
            default: kind = 9; break;
        }
        if (!((PHMASK >> ph) & 1)) kind = 99;
        const int pmoff = (ph >= 14) ? 1 : 0; const int Mrows = MROWS - pmoff * 256;
        if (kind == 0) { if (KMASK & 1) phase_prep(p, lds); }
        else if (kind == 1 && (KMASK & 2)) {
            pg8::Gemm g{hb + (size_t)pmoff * 256 * DM, (const bf16_t*)(ws + WS_WGU + f * SZ_WGU), Mrows, 2 * FF, DM, 0}; pg8::StaticOrder S; S.init(Mrows, 2 * FF, G, c);
            EpiSwiGLU E{(bf16_t*)(ws + U_ACT), ssq + (size_t)nin * MROWS * 16, pmoff, lds};
            rstd_table_build(lds, S, E.ssq, pmoff);
            pg8::gemm_phase(lds, g, S, E);
        } else if (kind == 2 && (KMASK & 4)) {
            pg8::Gemm g; float alpha; const float* x32 = nullptr;
            if (f < 4) { g = pg8::Gemm{(const bf16_t*)(ws + U_ACT) + (size_t)pmoff * 256 * FF, (const bf16_t*)(ws + WS_WD + f * SZ_WD), Mrows, DM, FF, 1}; alpha = 0.5f; if (ph == 2) x32 = p.in[0] - (size_t)R0 * DM; }
            else if (f == 4) { g = pg8::Gemm{(const bf16_t*)(ws + U_GV), (const bf16_t*)(ws + WS_WGOUT), MROWS, DM, DM, 0}; alpha = 1.f; }
            else { g = pg8::Gemm{(const bf16_t*)(ws + U_AO) + (size_t)pmoff * 256 * DM, (const bf16_t*)(ws + WS_WAOUT), Mrows, DM, DM, 0}; alpha = 1.f; }
            pg8::StaticOrder S; S.init(Mrows, DM, G, c);
            EpiResid E{x32, hb, ssq + (size_t)nout * MROWS * 16, alpha, pmoff};
            pg8::gemm_phase(lds, g, S, E);
        } else if (kind == 3 && (KMASK & 8)) {
            pg8::Gemm g{hb, (const bf16_t*)(ws + WS_WGIN), MROWS, 4096, DM, 0}; pg8::StaticOrder S; S.init(MROWS, 4096, G, c);
            EpiGlaIn E{(bf16_t*)((unsigned char*)p.out + O_GQ), (bf16_t*)(ws + U_GK), (bf16_t*)(ws + U_GV), (bf16_t*)(ws + U_GR), (float*)((unsigned char*)p.out + O_GF), (float*)(ws + U_GB),
                       ssq + (size_t)nin * MROWS * 16, p.in[10], lds};
            for (int i = get_tid(); i < 1024; i += 512) *(LAS float*)(lds + GB_OFF + i * 4) = p.in[10][i];
            rstd_table_build(lds, S, E.ssq, 0);
            pg8::gemm_phase(lds, g, S, E);
        } else if (kind == 4) { if (KMASK & 16) phase_gla_seq(p, lds); }
        else if (kind == 5) { if (KMASK & 32) phase_gla_post(p); }
        else if (kind == 6 && (KMASK & 64)) {
            pg8::Gemm g{hb, (const bf16_t*)(ws + WS_WAIN), MROWS, 1536, DM, 0}; pg8::StaticOrder S; S.init(MROWS, 1536, G, c);
            EpiAttnIn E{(bf16_t*)(ws + U_AQ), (bf16_t*)(ws + U_AK), (bf16_t*)(ws + U_AV), ssq + (size_t)nin * MROWS * 16, lds};
            rstd_table_build(lds, S, E.ssq, 0);
            pg8::gemm_phase(lds, g, S, E);
        } else if (kind == 7) { if (KMASK & 128) phase_attn_prep(p); }
        else if (kind == 8) { if (KMASK & 256) phase_attn(p, (char*)shm); }
        else if (kind == 9 && (KMASK & 512)) phase_final(p);
        if (ph + 1 < p.hi) {
            if (ph == p.lo) { cg::this_grid().sync(); (void)xcd_barrier_post((unsigned*)(p.ws + WS_BAR), (volatile LAS unsigned*)(lds + LDS_BYTES)); }
            else { XcdBarrier xb; xb.bar = (unsigned*)(p.ws + WS_BAR); xb.x = xb_xcc_id(); xb.st = (volatile LAS unsigned*)(lds + LDS_BYTES); xcd_barrier(xb); } }
        if (TPROBE_MASK) { if (blockIdx.x == 0 && threadIdx.x == 0) { const unsigned long long tp1 = __builtin_amdgcn_s_memrealtime(); if ((TPROBE_MASK >> ph) & 1) tpsum += (float)(tp1 - tp0) * 0.01f;
                if (ph == 16) __hip_atomic_store((float*)(ws + WS_NEED), tpsum, __ATOMIC_RELAXED, __HIP_MEMORY_SCOPE_AGENT); }
            if (ph == 16) cg::this_grid().sync(); }
    }
}

extern "C" void kernel_launch(void* const* d_in, const int* in_sizes, int n_in, void* d_out, int out_size, void* d_ws, size_t ws_size, hipStream_t stream) {
    static int grid = 0;
    if (grid == 0) {
        if (n_in != 22 || out_size != NB * SEQ * DM || ws_size < WS_END) { fprintf(stderr, "kernel_launch: unexpected shapes n_in %d out %d ws %zu (need %zu)\n", n_in, out_size, ws_size, (size_t)WS_END); grid = -1; return; }
        if (hipFuncSetAttribute((const void*)mega_fwd, hipFuncAttributeMaxDynamicSharedMemorySize, LDS_TOTAL) != hipSuccess) { fprintf(stderr, "kernel_launch: hipFuncSetAttribute failed\n"); grid = -1; return; }
        int dev = 0, cus = 0, per_cu = 0;
        hipGetDevice(&dev); hipDeviceGetAttribute(&cus, hipDeviceAttributeMultiprocessorCount, dev);
        hipOccupancyMaxActiveBlocksPerMultiprocessor(&per_cu, (const void*)mega_fwd, 512, LDS_TOTAL);
        if (per_cu < 1) { fprintf(stderr, "kernel_launch: occupancy query says %d blocks/CU\n", per_cu); per_cu = 1; }
        (void)hipGetLastError();
        grid = cus * per_cu;
    }
    if (grid < 0) return;
    Params p{};
    for (int i = 0; i < 22; ++i) p.in[i] = (const float*)d_in[i];
    p.out = (float*)d_out; p.ws = (unsigned char*)d_ws;
#if ONE_LAUNCH
    p.lo = 0; p.hi = NPHASE;
    void* args[] = {&p};
    hipError_t e = hipLaunchCooperativeKernel((const void*)mega_fwd, dim3(grid), dim3(512), args, LDS_TOTAL, stream);
    if (e != hipSuccess) fprintf(stderr, "cooperative launch failed: %s (grid %d)\n", hipGetErrorString(e), grid);
#else
    for (int ph = 0; ph < NPHASE; ++ph) { p.lo = ph; p.hi = ph + 1; hipLaunchKernelGGL(mega_fwd, dim3(grid), dim3(512), LDS_TOTAL, stream, p); }
#endif
}
```

```cpp
#include <hip/hip_runtime.h>
#include <hip/hip_cooperative_groups.h>
#include <cstdio>
namespace cg = cooperative_groups;

#ifndef TPROBE_MASK
#define TPROBE_MASK 0
#endif
#ifndef NOADD
#define NOADD 0
#endif
#ifndef FWDONLY
#define FWDONLY 0
#endif
#ifndef DIAG
#define DIAG 0
#endif
#ifndef PHMASK
#define PHMASK 0x3ffff
#endif
#ifndef KMASK
#define KMASK 1023
#endif
#ifndef ONE_LAUNCH
#define ONE_LAUNCH 1
#endif

#define LAS __attribute__((address_space(3)))
typedef unsigned short bf16_t;
typedef short bf16x8 __attribute__((ext_vector_type(8)));
typedef short s16x4 __attribute__((ext_vector_type(4)));
typedef float f32x4 __attribute__((ext_vector_type(4)));
typedef float f32x8 __attribute__((ext_vector_type(8)));
typedef float f32x16 __attribute__((ext_vector_type(16)));
typedef unsigned u32x4 __attribute__((ext_vector_type(4)));
typedef unsigned u32x2 __attribute__((ext_vector_type(2)));
typedef LAS unsigned char* ldsp;

constexpr int DM = 1024, FF = 2816, NB = 16, SEQ = 4096, NMETA = 16;
constexpr int MROWS = NB * NMETA + NB * SEQ;
constexpr int R0 = NB * NMETA;
constexpr float EPS = 1e-6f;
constexpr int LDS_BYTES = 152064;
constexpr int LDS_TOTAL = LDS_BYTES + 16;
constexpr int NPHASE = 18;

constexpr size_t SZ_H = (size_t)MROWS * DM * 4, SZ_HB = (size_t)MROWS * DM * 2, SZ_SSQ1 = (size_t)MROWS * 16 * 4;
constexpr size_t WS_H = 0, WS_HB = WS_H + SZ_H, WS_SSQ = WS_HB + SZ_HB, WS_W = WS_SSQ + 7 * SZ_SSQ1;
constexpr size_t SZ_WGU = (size_t)2 * FF * DM * 2, SZ_WD = (size_t)DM * FF * 2;
constexpr size_t WS_WGU = WS_W, WS_WD = WS_WGU + 4 * SZ_WGU, WS_WGIN = WS_WD + 4 * SZ_WD, WS_WGOUT = WS_WGIN + (size_t)4096 * DM * 2,
                 WS_WAIN = WS_WGOUT + (size_t)DM * DM * 2, WS_WAOUT = WS_WAIN + (size_t)1536 * DM * 2, WS_U = WS_WAOUT + (size_t)DM * DM * 2;
constexpr size_t U_ACT = WS_U;
constexpr size_t U_GB = WS_U, U_GK = U_GB + (size_t)MROWS * 512 * 4, U_GV = U_GK + (size_t)MROWS * 512 * 2, U_GR = U_GV + SZ_HB, U_GEND = U_GR + SZ_HB;
constexpr size_t U_AQ = WS_U, U_AK = U_AQ + SZ_HB, U_AV = U_AK + (size_t)MROWS * 256 * 2, U_AO = U_AV + (size_t)MROWS * 256 * 2, U_AEND = U_AO + SZ_HB;
constexpr size_t WS_NEED = (U_GEND > U_AEND ? U_GEND : U_AEND);
constexpr size_t WS_BAR = WS_NEED + 256, WS_END = WS_BAR + 16384;
constexpr size_t O_GF = 0, O_GQ = (size_t)MROWS * 512 * 4;

struct Params { const float* in[22]; float* out; unsigned char* ws; int lo, hi; };

typedef __bf16 bf16x2_t __attribute__((ext_vector_type(2)));
typedef float f32x2_t __attribute__((ext_vector_type(2)));
__device__ __forceinline__ unsigned cvt_pk_bf16(float lo, float hi) { const f32x2_t f = {lo, hi}; const bf16x2_t b = __builtin_convertvector(f, bf16x2_t); return __builtin_bit_cast(unsigned, b); }
__device__ __forceinline__ int get_tid() { int t = threadIdx.x; asm volatile("" : "+v"(t)); return t; }
__device__ __forceinline__ float bf2f(bf16_t v) { return __uint_as_float(((unsigned)v) << 16); }
__device__ __forceinline__ float bflo(unsigned w) { return __uint_as_float(w << 16); }
__device__ __forceinline__ float bfhi(unsigned w) { return __uint_as_float(w & 0xffff0000u); }
__device__ __forceinline__ float row_rstd(const float* ssq, int row) { const f32x4* p4 = (const f32x4*)(ssq + (size_t)row * 16); const f32x4 a = p4[0], b = p4[1], c = p4[2], d = p4[3];
    const f32x4 t = (a + b) + (c + d); return rsqrtf(((t[0] + t[1]) + (t[2] + t[3])) * (1.f / 1024.f) + EPS); }
__device__ __forceinline__ float fast_exp(float x) { return __builtin_amdgcn_exp2f(x * 1.4426950408889634f); }
__device__ __forceinline__ float silu_f(float x) { return x * __builtin_amdgcn_rcpf(1.f + __builtin_amdgcn_exp2f(-1.4426950408889634f * x)); }

namespace pg8 {
constexpr int BM = 256, BK = 64, HALF = 128, HTB = HALF * BK * 2, STAGE_BYTES = 8 * HTB, NXCD = 8, WGM = 8;
__host__ __device__ __forceinline__ int lds_byte(int r, int c) { const int st = (r >> 4) * 2 + (c >> 5), rr = r & 15, cc = c & 31, ob = rr * 64 + cc * 2; return st * 1024 + (ob ^ (((ob >> 9) & 1) << 5)); }
__host__ __device__ __forceinline__ void stage_rc(int b, int& R, int& C) { const int st = b / 1024, sb = b % 1024, swz = sb ^ (((sb >> 9) & 1) << 5); R = (st >> 1) * 16 + swz / 64; C = (st & 1) * 32 + (swz % 64) / 2; }
__host__ __device__ __forceinline__ int perm32(int rho) { const int n = rho >> 4, i = rho & 15; return 8 * (i >> 2) + 4 * n + (i & 3); }
struct Unit { int pm, pn; };
struct Gemm { const bf16_t* A; const bf16_t* Bt; int M, N, K; int atiled; };
struct StaticOrder {
    int nM, nN, nwg, G, c;
    __device__ void init(int M, int N, int G_, int c_) { nM = M / BM; nN = N / BM; nwg = nM * nN; G = G_; c = c_; }
    __device__ bool next(int i, Unit& u) const {
        const long L = (long)i * G + c; if (L >= nwg) return false;
        int wgid = (int)L; { const int q = nwg / NXCD, r = nwg % NXCD, xcd = wgid % NXCD, off = wgid / NXCD; wgid = (xcd < r ? xcd * (q + 1) : r * (q + 1) + (xcd - r) * q) + off; }
        const int nig = WGM * nN, gid = wgid / nig, fm = gid * WGM, gsz = (nM - fm) < WGM ? (nM - fm) : WGM;
        u.pm = fm + ((wgid % nig) % gsz); u.pn = (wgid % nig) / gsz; return true;
    }
};
template <class Epi>
__device__ __forceinline__ void gemm_phase(ldsp lds, const Gemm g, const StaticOrder& S, const Epi& E) {
    const int tid = get_tid(), wid = __builtin_amdgcn_readfirstlane(tid >> 6), lane = tid & 63, wr = wid >> 2, wc = wid & 3, fr = lane & 15, fq = lane >> 4;
    const int K = g.K, nt = K / BK;
    unsigned voffA[2], voffB[2];
#pragma unroll
    for (int i = 0; i < 2; ++i) { int R, C; stage_rc(tid * 16 + i * 8192, R, C); const int Rb = Epi::PERM ? ((R & ~31) + perm32(R & 31)) : R;
        voffA[i] = (unsigned)(R * (g.atiled ? BK : K) + C) * 2u; voffB[i] = (unsigned)(Rb * K + C) * 2u; }
    const size_t kstep = (size_t)(BK * 2);
    const size_t hstep = (size_t)HALF * K * 2;
    const size_t tstep = 2 * hstep;
    const size_t kstepA = g.atiled ? (size_t)BM * BK * 2 : kstep, hstepA = g.atiled ? (size_t)HALF * BK * 2 : hstep;
    const unsigned ldsw = (unsigned)wid * 1024u;
    const int aoff = lds_byte(wr * 64 + fr, fq * 8), boff = lds_byte(wc * 32 + fr, fq * 8);
#define PG8_SA(b, h) (((b) * 2 + (h)) * HTB)
#define PG8_SB(b, h) ((4 + (b) * 2 + (h)) * HTB)
#define PG8_STAGE(bufoff, gbase, voff) do { _Pragma("unroll") for (int _i = 0; _i < 2; ++_i) \
        __builtin_amdgcn_global_load_lds((const unsigned*)((const char*)(gbase) + (voff)[_i]), (LAS unsigned*)(lds + (bufoff) + ldsw + _i * 8192), 16, 0, 0); } while (0)
#define PG8_LDA(dst, b, h) do { _Pragma("unroll") for (int m = 0; m < 4; ++m) _Pragma("unroll") for (int k = 0; k < 2; ++k) dst[m][k] = *(const LAS bf16x8*)(lds + PG8_SA(b, h) + aoff + m * 2048 + k * 1024); } while (0)
#define PG8_LDB(dst, b, h) do { _Pragma("unroll") for (int n = 0; n < 2; ++n) _Pragma("unroll") for (int k = 0; k < 2; ++k) dst[n][k] = *(const LAS bf16x8*)(lds + PG8_SB(b, h) + boff + n * 2048 + k * 1024); } while (0)
#define PG8_MMA(ai, bj, At, Bt) do { __builtin_amdgcn_s_setprio(1); _Pragma("unroll") for (int m = 0; m < 4; ++m) _Pragma("unroll") for (int n = 0; n < 2; ++n) _Pragma("unroll") for (int k = 0; k < 2; ++k) \
        acc[ai][bj][m][n] = __builtin_amdgcn_mfma_f32_16x16x32_bf16(Bt[n][k], At[m][k], acc[ai][bj][m][n], 0, 0, 0); __builtin_amdgcn_s_setprio(0); } while (0)
#define PG8_WAIT_V(n) asm volatile("s_waitcnt vmcnt(" #n ")" ::: "memory")
#define PG8_WAIT_L(n) asm volatile("s_waitcnt lgkmcnt(" #n ")" ::: "memory")
#define PG8_BAR __builtin_amdgcn_s_barrier()
#define PG8_SCHED __builtin_amdgcn_sched_barrier(0)
    Unit cur, nxt; int ui = 0;
    if (!S.next(0, cur)) return;
    f32x4 acc[2][2][4][2];
#pragma unroll
    for (int a = 0; a < 2; ++a)
#pragma unroll
        for (int b = 0; b < 2; ++b)
#pragma unroll
            for (int m = 0; m < 4; ++m)
#pragma unroll
                for (int n = 0; n < 2; ++n) acc[a][b][m][n] = (f32x4){0.f, 0.f, 0.f, 0.f};
    bf16x8 At[4][2], B0[2][2], B1[2][2];
    const char* cA = (const char*)g.A + (size_t)cur.pm * tstep; const char* cB = (const char*)g.Bt + (size_t)cur.pn * tstep;
    PG8_STAGE(PG8_SB(0, 0), cB, voffB); PG8_STAGE(PG8_SA(0, 0), cA, voffA); PG8_STAGE(PG8_SB(0, 1), cB + hstep, voffB); PG8_STAGE(PG8_SA(0, 1), cA + hstepA, voffA);
    if (wr == 1) PG8_BAR;
    PG8_WAIT_V(4); PG8_BAR;
    PG8_STAGE(PG8_SB(1, 0), cB + kstep, voffB); PG8_STAGE(PG8_SA(1, 0), cA + kstepA, voffA); PG8_STAGE(PG8_SB(1, 1), cB + hstep + kstep, voffB);
    PG8_WAIT_V(6); PG8_BAR;
    for (;;) {
        const bool has_next = S.next(ui + 1, nxt);
        const char* nA = has_next ? (const char*)g.A + (size_t)nxt.pm * tstep : cA; const char* nB = has_next ? (const char*)g.Bt + (size_t)nxt.pn * tstep : cB;
        for (int t = 0; t < nt; t += 2) {
            const bool last = (t == nt - 2);
            const char* a1 = cA + (size_t)(t + 1) * kstepA;
            const char* a2 = last ? nA : cA + (size_t)(t + 2) * kstepA; const char* b2 = last ? nB : cB + (size_t)(t + 2) * kstep;
            const char* a3 = a2 + kstepA; const char* b3 = b2 + kstep;
            PG8_LDB(B0, 0, 0); PG8_SCHED; PG8_LDA(At, 0, 0); PG8_STAGE(PG8_SA(1, 1), a1 + hstepA, voffA);
            PG8_WAIT_L(8); PG8_BAR; PG8_WAIT_L(0); PG8_MMA(0, 0, At, B0); PG8_BAR; PG8_SCHED;
            PG8_LDB(B1, 0, 1); PG8_STAGE(PG8_SB(0, 0), b2, voffB);
            PG8_BAR; PG8_WAIT_L(0); PG8_MMA(0, 1, At, B1); PG8_BAR;
            PG8_LDA(At, 0, 1); PG8_STAGE(PG8_SA(0, 0), a2, voffA);
            PG8_BAR; PG8_WAIT_L(0); PG8_MMA(1, 0, At, B0); PG8_BAR; PG8_SCHED;
            PG8_STAGE(PG8_SB(0, 1), b2 + hstep, voffB);
            PG8_WAIT_V(6); PG8_BAR; PG8_MMA(1, 1, At, B1); PG8_BAR;
            PG8_LDB(B0, 1, 0); PG8_SCHED; PG8_LDA(At, 1, 0); PG8_STAGE(PG8_SA(0, 1), a2 + hstepA, voffA);
            PG8_WAIT_L(8); PG8_BAR; PG8_WAIT_L(0); PG8_MMA(0, 0, At, B0); PG8_BAR; PG8_SCHED;
            PG8_LDB(B1, 1, 1); PG8_STAGE(PG8_SB(1, 0), b3, voffB);
            PG8_BAR; PG8_WAIT_L(0); PG8_MMA(0, 1, At, B1); PG8_BAR;
            PG8_LDA(At, 1, 1); PG8_STAGE(PG8_SA(1, 0), a3, voffA);
            PG8_BAR; PG8_WAIT_L(0); PG8_MMA(1, 0, At, B0); PG8_BAR; PG8_SCHED;
            PG8_STAGE(PG8_SB(1, 1), b3 + hstep, voffB);
            PG8_WAIT_V(6); PG8_BAR; PG8_MMA(1, 1, At, B1); PG8_BAR;
        }
        E(acc, cur, wr, wc, fr, fq);
        if (!has_next) break;
#pragma unroll
        for (int a = 0; a < 2; ++a)
#pragma unroll
            for (int b = 0; b < 2; ++b)
#pragma unroll
                for (int m = 0; m < 4; ++m)
#pragma unroll
                    for (int n = 0; n < 2; ++n) acc[a][b][m][n] = (f32x4){0.f, 0.f, 0.f, 0.f};
        cur = nxt; cA = nA; cB = nB; ++ui;
    }
    PG8_WAIT_V(0);
    if (wr == 0) PG8_BAR;
    PG8_BAR;
#undef PG8_SA
#undef PG8_SB
#undef PG8_STAGE
#undef PG8_LDA
#undef PG8_LDB
#undef PG8_MMA
#undef PG8_WAIT_V
#undef PG8_WAIT_L
#undef PG8_BAR
#undef PG8_SCHED
}
}

typedef f32x4 AccT[2][2][4][2];

constexpr int RS_OFF = 131072, RS_SLOTS = 8, RS_TAG = RS_OFF + RS_SLOTS * 256 * 4, GB_OFF = RS_TAG + 64;
static_assert(GB_OFF + 4096 <= LDS_BYTES, "rstd table + gate bias");
__device__ __forceinline__ void rstd_table_build(ldsp lds, const pg8::StaticOrder& S, const float* ssq, int pmoff) {
    const int tid = get_tid(); int nslot = 0, last = -1; pg8::Unit u;
    for (int i = 0; S.next(i, u); ++i) if (u.pm != last) { last = u.pm;
        if (nslot < RS_SLOTS) { if (tid < 256) *(LAS float*)(lds + RS_OFF + (nslot * 256 + tid) * 4) = row_rstd(ssq, (u.pm + pmoff) * 256 + tid); if (tid == 0) *(LAS int*)(lds + RS_TAG + nslot * 4) = u.pm; }
        ++nslot; }
    if (tid < RS_SLOTS && tid >= nslot) *(LAS int*)(lds + RS_TAG + tid * 4) = -1;
    __syncthreads();
}
__device__ __forceinline__ void rstd_rows(ldsp lds, const float* ssq, int pm, int pmoff, int wr, int fr, float (&rs)[8]) {
    int slot = -1;
#pragma unroll
    for (int k = 0; k < RS_SLOTS; ++k) if (*(const LAS int*)(lds + RS_TAG + k * 4) == pm) slot = k;
    if (slot >= 0) {
#pragma unroll
        for (int ai = 0; ai < 2; ++ai)
#pragma unroll
            for (int m = 0; m < 4; ++m) rs[ai * 4 + m] = *(const LAS float*)(lds + RS_OFF + (slot * 256 + ai * 128 + wr * 64 + m * 16 + fr) * 4);
    } else {
#pragma unroll
        for (int ai = 0; ai < 2; ++ai)
#pragma unroll
            for (int m = 0; m < 4; ++m) rs[ai * 4 + m] = row_rstd(ssq, (pm + pmoff) * 256 + ai * 128 + wr * 64 + m * 16 + fr);
    }
}

struct EpiSwiGLU { static constexpr bool PERM = true;
    bf16_t* act; const float* ssq; int pmoff; ldsp lds;
    __device__ __forceinline__ void operator()(const AccT& acc, const pg8::Unit& u, int wr, int wc, int fr, int fq) const {
        const int row0 = (u.pm + pmoff) * 256 + wr * 64 + fr, col0 = u.pn * 128 + wc * 32 + 8 * fq;
        float rs[8]; rstd_rows(lds, ssq, u.pm, pmoff, wr, fr, rs);
#pragma unroll
        for (int ai = 0; ai < 2; ++ai)
#pragma unroll
            for (int m = 0; m < 4; ++m) { const int row = row0 + ai * 128 + m * 16; const float s = rs[ai * 4 + m];
                float a[8];
#pragma unroll
                for (int n = 0; n < 2; ++n)
#pragma unroll
                    for (int j = 0; j < 4; ++j) a[n * 4 + j] = silu_f(acc[ai][0][m][n][j] * s) * (acc[ai][1][m][n][j] * s);
                u32x4 w; w.x = cvt_pk_bf16(a[0], a[1]); w.y = cvt_pk_bf16(a[2], a[3]); w.z = cvt_pk_bf16(a[4], a[5]); w.w = cvt_pk_bf16(a[6], a[7]);
                *(u32x4*)(act + ((size_t)((row >> 8) * (FF / 64) + (col0 >> 6)) * 256 + (row & 255)) * 64 + (col0 & 63)) = w; }
    }
};
struct EpiResid { static constexpr bool PERM = true;
    const float* x32; bf16_t* hb; float* ssq; float alpha; int pmoff;
    __device__ __forceinline__ void operator()(const AccT& acc, const pg8::Unit& u, int wr, int wc, int fr, int fq) const {
        const int row0 = (u.pm + pmoff) * 256 + wr * 64 + fr, col0 = u.pn * 256 + wc * 32 + 8 * fq;
        const bool fromx = (x32 != nullptr) && (u.pm + pmoff != 0);
        if (fromx) {
#pragma unroll
            for (int ai = 0; ai < 2; ++ai)
#pragma unroll
                for (int mh = 0; mh < 2; ++mh) { f32x4 rf[2][2][2];
#pragma unroll
                    for (int mm = 0; mm < 2; ++mm)
#pragma unroll
                        for (int bj = 0; bj < 2; ++bj) { const float* xp = x32 + (size_t)(row0 + ai * 128 + (mh * 2 + mm) * 16) * DM + col0 + bj * 128; rf[mm][bj][0] = *(const f32x4*)xp; rf[mm][bj][1] = *(const f32x4*)(xp + 4); }
#pragma unroll
                    for (int mm = 0; mm < 2; ++mm) { const int m = mh * 2 + mm; const int row = row0 + ai * 128 + m * 16; const size_t off = (size_t)row * DM + col0; float ss = 0.f;
#pragma unroll
                        for (int bj = 0; bj < 2; ++bj) { float v[8];
#pragma unroll
                            for (int n = 0; n < 2; ++n)
#pragma unroll
                                for (int j = 0; j < 4; ++j) { v[n * 4 + j] = rf[mm][bj][n][j] + alpha * acc[ai][bj][m][n][j]; ss += v[n * 4 + j] * v[n * 4 + j]; }
                            u32x4 w; w.x = cvt_pk_bf16(v[0], v[1]); w.y = cvt_pk_bf16(v[2], v[3]); w.z = cvt_pk_bf16(v[4], v[5]); w.w = cvt_pk_bf16(v[6], v[7]);
                            *(u32x4*)(hb + off + bj * 128) = w; }
                        ss += __shfl_xor(ss, 16); ss += __shfl_xor(ss, 32);
                        if (fq == 0) ssq[(size_t)row * 16 + u.pn * 4 + wc] = ss; } }
        } else {
#pragma unroll
            for (int ai = 0; ai < 2; ++ai) { u32x4 rw[4][2];
#pragma unroll
                for (int m = 0; m < 4; ++m)
#pragma unroll
                    for (int bj = 0; bj < 2; ++bj) rw[m][bj] = *(const u32x4*)(hb + (size_t)(row0 + ai * 128 + m * 16) * DM + col0 + bj * 128);
#pragma unroll
                for (int m = 0; m < 4; ++m) { const int row = row0 + ai * 128 + m * 16; const size_t off = (size_t)row * DM + col0; float ss = 0.f;
#pragma unroll
                    for (int bj = 0; bj < 2; ++bj) { const u32x4 t = rw[m][bj]; const float r[8] = {bflo(t.x), bfhi(t.x), bflo(t.y), bfhi(t.y), bflo(t.z), bfhi(t.z), bflo(t.w), bfhi(t.w)}; float v[8];
#pragma unroll
                        for (int n = 0; n < 2; ++n)
#pragma unroll
                            for (int j = 0; j < 4; ++j) { v[n * 4 + j] = r[n * 4 + j] + alpha * acc[ai][bj][m][n][j]; ss += v[n * 4 + j] * v[n * 4 + j]; }
                        u32x4 w; w.x = cvt_pk_bf16(v[0], v[1]); w.y = cvt_pk_bf16(v[2], v[3]); w.z = cvt_pk_bf16(v[4], v[5]); w.w = cvt_pk_bf16(v[6], v[7]);
                        *(u32x4*)(hb + off + bj * 128) = w; }
                    ss += __shfl_xor(ss, 16); ss += __shfl_xor(ss, 32);
                    if (fq == 0) ssq[(size_t)row * 16 + u.pn * 4 + wc] = ss; } }
        }
    }
};
struct EpiGlaIn { static constexpr bool PERM = true;
    bf16_t *q, *k, *v, *r; float *gf, *gb; const float* ssq; const float* gbias; ldsp lds;
    __device__ __forceinline__ void operator()(const AccT& acc, const pg8::Unit& u, int wr, int wc, int fr, int fq) const {
        const int row0 = u.pm * 256 + wr * 64 + fr, cin0 = wc * 32 + 8 * fq, pn = u.pn;
        float rs[8]; rstd_rows(lds, ssq, u.pm, 0, wr, fr, rs);
#pragma unroll
        for (int ai = 0; ai < 2; ++ai)
#pragma unroll
            for (int m = 0; m < 4; ++m) { const int row = row0 + ai * 128 + m * 16; float s = rs[ai * 4 + m];
                if (pn < 2) s *= 0.08838834764831845f;
#pragma unroll
                for (int bj = 0; bj < 2; ++bj) { const int c = cin0 + 128 * bj; const f32x4 v0 = acc[ai][bj][m][0] * s, v1 = acc[ai][bj][m][1] * s;
                    if (pn < 12) {
                        bf16_t* dst;
                        if (pn < 2) dst = q + (size_t)row * 512 + pn * 256 + c; else if (pn < 4) dst = k + (size_t)row * 512 + (pn - 2) * 256 + c;
                        else if (pn < 8) dst = v + (size_t)row * 1024 + (pn - 4) * 256 + c; else dst = r + (size_t)row * 1024 + (pn - 8) * 256 + c;
                        u32x4 w; w.x = cvt_pk_bf16(v0[0], v0[1]); w.y = cvt_pk_bf16(v0[2], v0[3]); w.z = cvt_pk_bf16(v1[0], v1[1]); w.w = cvt_pk_bf16(v1[2], v1[3]);
                        *(u32x4*)dst = w;
                    } else {
                        const int dir = (pn - 12) >> 1, gc = ((pn - 12) & 1) * 256 + c;
                        const f32x4 b0 = *(const LAS f32x4*)(lds + GB_OFF + (dir * 512 + gc) * 4), b1 = *(const LAS f32x4*)(lds + GB_OFF + (dir * 512 + gc + 4) * 4); f32x4 o0, o1;
#pragma unroll
                        for (int j = 0; j < 4; ++j) { const float z0 = v0[j] + b0[j], z1 = v1[j] + b1[j];
                            o0[j] = (fminf(z0, 0.f) - __logf(1.f + __expf(-fabsf(z0)))) * 0.0625f; o1[j] = (fminf(z1, 0.f) - __logf(1.f + __expf(-fabsf(z1)))) * 0.0625f; }
                        float* dst = (dir ? gb : gf) + (size_t)row * 512 + gc; *(f32x4*)dst = o0; *(f32x4*)(dst + 4) = o1;
                    } } }
    }
};
struct EpiAttnIn { static constexpr bool PERM = true;
    bf16_t *q, *k, *v; const float* ssq; ldsp lds;
    __device__ __forceinline__ void operator()(const AccT& acc, const pg8::Unit& u, int wr, int wc, int fr, int fq) const {
        const int row0 = u.pm * 256 + wr * 64 + fr, cin0 = wc * 32 + 8 * fq, pn = u.pn;
        float rs[8]; rstd_rows(lds, ssq, u.pm, 0, wr, fr, rs);
#pragma unroll
        for (int ai = 0; ai < 2; ++ai)
#pragma unroll
            for (int m = 0; m < 4; ++m) { const int row = row0 + ai * 128 + m * 16; const float s = rs[ai * 4 + m];
#pragma unroll
                for (int bj = 0; bj < 2; ++bj) { const int c = cin0 + 128 * bj; const f32x4 v0 = acc[ai][bj][m][0] * s, v1 = acc[ai][bj][m][1] * s;
                    bf16_t* dst = (pn < 4) ? q + (size_t)row * 1024 + pn * 256 + c : (pn == 4 ? k + (size_t)row * 256 + c : v + (size_t)row * 256 + c);
                    u32x4 w; w.x = cvt_pk_bf16(v0[0], v0[1]); w.y = cvt_pk_bf16(v0[2], v0[3]); w.z = cvt_pk_bf16(v1[0], v1[1]); w.w = cvt_pk_bf16(v1[2], v1[3]);
                    *(u32x4*)dst = w; } }
    }
};

template <class F>
__device__ __forceinline__ void xpose_tiles(ldsp lds, int K, int N, F val, bf16_t* dst, int rmode, int rbase) {
    LAS float* T = (LAS float*)lds; const int tid = get_tid(), nkt = K / 64, nnt = N / 64;
    for (int t = blockIdx.x; t < nkt * nnt; t += gridDim.x) {
        const int kt = t % nkt, ntl = t / nkt, k0 = kt * 64, n0 = ntl * 64;
        { const int kr = tid >> 4, nc = (tid & 15) * 4; const f32x4 v0 = val(k0 + kr, n0 + nc), v1 = val(k0 + kr + 32, n0 + nc);
            T[kr * 65 + nc] = v0[0]; T[kr * 65 + nc + 1] = v0[1]; T[kr * 65 + nc + 2] = v0[2]; T[kr * 65 + nc + 3] = v0[3];
            T[(kr + 32) * 65 + nc] = v1[0]; T[(kr + 32) * 65 + nc + 1] = v1[1]; T[(kr + 32) * 65 + nc + 2] = v1[2]; T[(kr + 32) * 65 + nc + 3] = v1[3]; }
        __syncthreads();
        { const int n = tid >> 3, k8 = (tid & 7) * 8; float x[8];
#pragma unroll
            for (int j = 0; j < 8; ++j) x[j] = T[(k8 + j) * 65 + n];
            const int gn = n0 + n, dr = (rmode ? ((gn >> 7) * 256 + (gn & 127)) : gn) + rbase;
            u32x4 w; w.x = cvt_pk_bf16(x[0], x[1]); w.y = cvt_pk_bf16(x[2], x[3]); w.z = cvt_pk_bf16(x[4], x[5]); w.w = cvt_pk_bf16(x[6], x[7]);
            *(u32x4*)(dst + (size_t)dr * K + k0 + k8) = w; }
        __syncthreads();
    }
}
struct ValPlain { const float* src; int ld;
    __device__ __forceinline__ f32x4 operator()(int k, int n) const { return *(const f32x4*)(src + (size_t)k * ld + n); } };
struct ValGain { const float* src; int ld; const float* gain;
    __device__ __forceinline__ f32x4 operator()(int k, int n) const { const f32x4 v = *(const f32x4*)(src + (size_t)k * ld + n); return v * gain[k]; } };
struct ValGate { const float* w1; const float* w2; const float* gain;
    __device__ __forceinline__ f32x4 operator()(int k, int n) const { f32x4 a = {0.f, 0.f, 0.f, 0.f};
#pragma unroll
        for (int r = 0; r < 16; ++r) a += w1[k * 16 + r] * *(const f32x4*)(w2 + r * 512 + n);
        return a * gain[k]; } };

__device__ __forceinline__ void phase_prep(const Params& p, ldsp lds) {
    unsigned char* ws = p.ws; const int tid = get_tid(), lane = tid & 63, wid = tid >> 6;
    float* ssq = (float*)(ws + WS_SSQ); bf16_t* hb = (bf16_t*)(ws + WS_HB);
    for (int rp = blockIdx.x * 8 + wid; rp < MROWS / 2; rp += gridDim.x * 8) {
        f32x4 v[2][4];
#pragma unroll
        for (int k = 0; k < 2; ++k) { const int r = rp * 2 + k; const float* src = (r < R0) ? p.in[1] + (size_t)(r & 15) * DM : p.in[0] + (size_t)(r - R0) * DM;
#pragma unroll
            for (int i = 0; i < 4; ++i) v[k][i] = __builtin_nontemporal_load((const f32x4*)(src + i * 256 + lane * 4)); }
#pragma unroll
        for (int k = 0; k < 2; ++k) { const int r = rp * 2 + k; float ss = 0.f;
#pragma unroll
            for (int i = 0; i < 4; ++i) { const f32x4 x = v[k][i]; u32x2 w; w.x = cvt_pk_bf16(x[0], x[1]); w.y = cvt_pk_bf16(x[2], x[3]); *(u32x2*)(hb + (size_t)r * DM + i * 256 + lane * 4) = w;
                ss += (x[0] * x[0] + x[1] * x[1]) + (x[2] * x[2] + x[3] * x[3]); }
#pragma unroll
            for (int o = 32; o >= 1; o >>= 1) ss += __shfl_xor(ss, o);
            if (lane < 16) ssq[(size_t)r * 16 + lane] = lane == 0 ? ss : 0.f; }
    }
    for (int f = 0; f < 4; ++f) { const int li = f >> 1; const bool second = f & 1;
        const float* wg = p.in[second ? 18 : 3] + (size_t)li * DM * FF; const float* wu = p.in[second ? 19 : 4] + (size_t)li * DM * FF;
        const float* wd = p.in[second ? 20 : 5] + (size_t)li * FF * DM; const float* gn = p.in[second ? 17 : 2] + li * DM;
        bf16_t* dgu = (bf16_t*)(ws + WS_WGU + f * SZ_WGU); bf16_t* dd = (bf16_t*)(ws + WS_WD + f * SZ_WD);
        xpose_tiles(lds, DM, FF, ValGain{wg, FF, gn}, dgu, 1, 0);
        xpose_tiles(lds, DM, FF, ValGain{wu, FF, gn}, dgu, 1, 128);
        xpose_tiles(lds, FF, DM, ValPlain{wd, DM}, dd, 0, 0);
    }
    xpose_tiles(lds, DM, 3072, ValGain{p.in[7], 3072, p.in[6]}, (bf16_t*)(ws + WS_WGIN), 0, 0);
    xpose_tiles(lds, DM, 512, ValGate{p.in[8], p.in[9], p.in[6]}, (bf16_t*)(ws + WS_WGIN), 0, 3072);
    xpose_tiles(lds, DM, 512, ValGate{p.in[8] + DM * 16, p.in[9] + 16 * 512, p.in[6]}, (bf16_t*)(ws + WS_WGIN), 0, 3584);
    xpose_tiles(lds, DM, DM, ValPlain{p.in[12], DM}, (bf16_t*)(ws + WS_WGOUT), 0, 0);
    xpose_tiles(lds, DM, 1536, ValGain{p.in[13], 1536, p.in[6] + DM}, (bf16_t*)(ws + WS_WAIN), 0, 0);
    xpose_tiles(lds, DM, DM, ValPlain{p.in[16], DM}, (bf16_t*)(ws + WS_WAOUT), 0, 0);
}

__device__ __forceinline__ int gla_row(int b, int c, int to) { return c == 0 ? (to >= 48 ? b * 16 + (to - 48) : -1) : R0 + b * SEQ + (c - 1) * 64 + to; }
__device__ __forceinline__ bf16x8 ld8(ldsp base, int off) { return *(const LAS bf16x8*)(base + off); }

__device__ __forceinline__ void phase_gla_seq(const Params& p, ldsp lds) {
    constexpr int PBF = 528, PQ = 272, PT = 144;
    constexpr int OFF_BF = 0, OFF_QD = 33792, OFF_KI = OFF_QD + 17408, OFF_KET = OFF_KI + 17408, OFF_VT = OFF_KET + 18432, OFF_AM = OFF_VT + 18432,
                  OFF_ST = OFF_AM + 9216, OFF_PART = OFF_ST + 34816, OFF_DEC = OFF_PART + 2048;
    static_assert(OFF_DEC + 512 <= LDS_BYTES, "gla lds");
    unsigned char* ws = p.ws;
    const bf16_t* qb = (const bf16_t*)((unsigned char*)p.out + O_GQ); const bf16_t* kb = (const bf16_t*)(ws + U_GK); const bf16_t* vb = (const bf16_t*)(ws + U_GV);
    const float* gfp = (const float*)((unsigned char*)p.out + O_GF); const float* gbp = (const float*)(ws + U_GB);
    const int tid = get_tid(), lane = tid & 63, wid = __builtin_amdgcn_readfirstlane(tid >> 6), fr = lane & 15, fq = lane >> 4;
    const int dcol = tid & 127, qtr = tid >> 7;
    const int trow = tid >> 3, seg = tid & 7;
    for (int it = blockIdx.x; it < 256; it += gridDim.x) {
        const int item = (gridDim.x == 256) ? ((it & 7) * 32 + (it >> 3)) : it;
        const int vp = item & 1, dir = (item >> 1) & 1, hd = (item >> 2) & 3, b = item >> 4;
        bf16_t* obuf = (bf16_t*)(ws + WS_H) + (size_t)dir * MROWS * 1024;
        const float* gsrc = dir ? gbp : gfp;
        const unsigned colo = (unsigned)(qtr * 16) * 2048u + (unsigned)dcol * 4u, rowo = (unsigned)trow * 1024u + (unsigned)seg * 32u, rowv = (unsigned)trow * 2048u + (unsigned)seg * 32u;
        float gcol[16]; u32x4 rq0, rq1, rk0, rk1, rv0, rv1;
        f32x4 accS[8];
#define GLA_LOAD_SLOW(c_) do { \
        _Pragma("unroll") for (int i = 0; i < 16; ++i) { const int r_ = gla_row(b, (c_), qtr * 16 + i); \
            gcol[i] = r_ >= 0 ? gsrc[(size_t)r_ * 512 + hd * 128 + dcol] : 0.f; } \
        { const int r_ = gla_row(b, (c_), trow); const u32x4 z_ = {0u, 0u, 0u, 0u}; \
          if (r_ >= 0) { const bf16_t* qp_ = qb + (size_t)r_ * 512 + hd * 128 + seg * 16; const bf16_t* kp_ = kb + (size_t)r_ * 512 + hd * 128 + seg * 16; const bf16_t* vp_ = vb + (size_t)r_ * 1024 + hd * 256 + vp * 128 + seg * 16; \
              rq0 = *(const u32x4*)qp_; rq1 = *(const u32x4*)(qp_ + 8); rk0 = *(const u32x4*)kp_; rk1 = *(const u32x4*)(kp_ + 8); rv0 = *(const u32x4*)vp_; rv1 = *(const u32x4*)(vp_ + 8); } \
          else { rq0 = z_; rq1 = z_; rk0 = z_; rk1 = z_; rv0 = z_; rv1 = z_; } } } while (0)
#define GLA_LOAD_FAST(c_) do { const size_t rb_ = (size_t)R0 + (size_t)b * SEQ + (size_t)((c_) - 1) * 64; \
        unsigned colo_ = colo, rowo_ = rowo; asm volatile("" : "+v"(colo_), "+v"(rowo_));     \
        { const char* gB_ = (const char*)(gsrc + rb_ * 512 + hd * 128); \
          _Pragma("unroll") for (int i = 0; i < 16; ++i) gcol[i] = *(const float*)(gB_ + (colo_ + (unsigned)i * 2048u)); } \
        { const char* qB_ = (const char*)(qb + rb_ * 512 + hd * 128); const char* kB_ = (const char*)(kb + rb_ * 512 + hd * 128); const char* vB_ = (const char*)(vb + rb_ * 1024 + hd * 256 + vp * 128); \
          rq0 = *(const u32x4*)(qB_ + rowo_); rq1 = *(const u32x4*)(qB_ + rowo_ + 16u); rk0 = *(const u32x4*)(kB_ + rowo_); rk1 = *(const u32x4*)(kB_ + rowo_ + 16u); \
          rv0 = *(const u32x4*)(vB_ + rowv); rv1 = *(const u32x4*)(vB_ + rowv + 16u); } } while (0)
#define GLA_LOAD(c_) do { if ((c_) != 0) GLA_LOAD_FAST(c_); else GLA_LOAD_SLOW(c_); } while (0)
        GLA_LOAD(dir ? 64 : 0);
#pragma unroll
        for (int i = 0; i < 8; ++i) accS[i] = (f32x4){0.f, 0.f, 0.f, 0.f};
        for (int i = tid; i < 34816 / 4; i += 512) *(LAS unsigned*)(lds + OFF_ST + i * 4) = 0u;
        for (int ci = 0; ci < 65; ++ci) {
            const int c = dir ? 64 - ci : ci;
            float bl[16]; float run = 0.f;
            if (dir == 0) {
#pragma unroll
                for (int i = 0; i < 16; ++i) { run += gcol[i]; bl[i] = run; }
            } else {
#pragma unroll
                for (int i = 15; i >= 0; --i) { run += gcol[i]; bl[i] = run; }
            }
            *(LAS float*)(lds + OFF_PART + (qtr * 128 + dcol) * 4) = run;
            { const unsigned vw[8] = {rv0.x, rv0.y, rv0.z, rv0.w, rv1.x, rv1.y, rv1.z, rv1.w};
#pragma unroll
              for (int i = 0; i < 8; ++i) { const int vv = seg * 16 + 2 * i; const int vts = (((trow >> 3) ^ ((vv >> 3) & 7)) << 4) + (trow & 7) * 2;
                  *(LAS bf16_t*)(lds + OFF_VT + vv * PT + vts) = (bf16_t)(vw[i] & 0xffffu); *(LAS bf16_t*)(lds + OFF_VT + (vv + 1) * PT + vts) = (bf16_t)(vw[i] >> 16); } }
            __syncthreads();
            float offp = 0.f, tot = 0.f;
#pragma unroll
            for (int q2 = 0; q2 < 4; ++q2) { const float pv = *(LAS float*)(lds + OFF_PART + (q2 * 128 + dcol) * 4); tot += pv; if (dir ? (q2 > qtr) : (q2 < qtr)) offp += pv; }
#pragma unroll
            for (int i = 0; i < 16; ++i) *(LAS float*)(lds + OFF_BF + (qtr * 16 + i) * PBF + dcol * 4) = bl[i] + offp;
            if (qtr == 0) *(LAS float*)(lds + OFF_DEC + dcol * 4) = fast_exp(tot);
            __syncthreads();
            { const unsigned qw[8] = {rq0.x, rq0.y, rq0.z, rq0.w, rq1.x, rq1.y, rq1.z, rq1.w}, kw[8] = {rk0.x, rk0.y, rk0.z, rk0.w, rk1.x, rk1.y, rk1.z, rk1.w};
              unsigned qo[8], ko[8]; const int kts = (((trow >> 3) ^ seg) << 4) + (trow & 7) * 2;
#pragma unroll
              for (int i = 0; i < 4; ++i) { const f32x4 bv = *(const LAS f32x4*)(lds + OFF_BF + trow * PBF + (seg * 16 + i * 4) * 4); const f32x4 dc = *(const LAS f32x4*)(lds + OFF_DEC + (seg * 16 + i * 4) * 4);
#pragma unroll
                  for (int j = 0; j < 2; ++j) { const float e0 = fast_exp(bv[2 * j]), e1 = fast_exp(bv[2 * j + 1]); const unsigned qq = qw[i * 2 + j], kk = kw[i * 2 + j];
                      const float k0 = bflo(kk) * __builtin_amdgcn_rcpf(e0), k1 = bfhi(kk) * __builtin_amdgcn_rcpf(e1);
                      qo[i * 2 + j] = cvt_pk_bf16(bflo(qq) * e0, bfhi(qq) * e1); ko[i * 2 + j] = cvt_pk_bf16(k0, k1);
                      const unsigned kew = cvt_pk_bf16(k0 * dc[2 * j], k1 * dc[2 * j + 1]); const int d = seg * 16 + i * 4 + 2 * j;
                      *(LAS bf16_t*)(lds + OFF_KET + d * PT + kts) = (bf16_t)(kew & 0xffffu); *(LAS bf16_t*)(lds + OFF_KET + (d + 1) * PT + kts) = (bf16_t)(kew >> 16); } }
              *(LAS u32x4*)(lds + OFF_QD + trow * PQ + seg * 32) = (u32x4){qo[0], qo[1], qo[2], qo[3]}; *(LAS u32x4*)(lds + OFF_QD + trow * PQ + seg * 32 + 16) = (u32x4){qo[4], qo[5], qo[6], qo[7]};
              *(LAS u32x4*)(lds + OFF_KI + trow * PQ + seg * 32) = (u32x4){ko[0], ko[1], ko[2], ko[3]}; *(LAS u32x4*)(lds + OFF_KI + trow * PQ + seg * 32 + 16) = (u32x4){ko[4], ko[5], ko[6], ko[7]}; }
            if (ci + 1 < 65) { const int c2 = dir ? 63 - ci : ci + 1; GLA_LOAD(c2); }
            __syncthreads();
#pragma unroll
            for (int xx = 0; xx < 2; ++xx) { const int x = 2 * wid + xx, si = x >> 2, ti = x & 3; f32x4 a4 = {0.f, 0.f, 0.f, 0.f};
                if (dir ? (si >= ti) : (si <= ti)) {
#pragma unroll
                    for (int kk = 0; kk < 4; ++kk) a4 = __builtin_amdgcn_mfma_f32_16x16x32_bf16(ld8(lds, OFF_KI + (si * 16 + fr) * PQ + kk * 64 + fq * 16), ld8(lds, OFF_QD + (ti * 16 + fr) * PQ + kk * 64 + fq * 16), a4, 0, 0, 0);
#pragma unroll
                    for (int i = 0; i < 4; ++i) { const int sd = si * 16 + 4 * fq + i - (ti * 16 + fr); if (dir ? (sd < 0) : (sd > 0)) a4[i] = 0.f; }
                }
                u32x2 w; w.x = cvt_pk_bf16(a4[0], a4[1]); w.y = cvt_pk_bf16(a4[2], a4[3]);
                *(LAS u32x2*)(lds + OFF_AM + (ti * 16 + fr) * PT + (si * 16 + 4 * fq) * 2) = w; }
            __syncthreads();
            { const int vsw = (2 * wid + (fr >> 3)) & 7; bf16x8 fv[2], fs[4];
#pragma unroll
              for (int kk = 0; kk < 2; ++kk) fv[kk] = ld8(lds, OFF_VT + (wid * 16 + fr) * PT + (((kk * 4 + fq) ^ vsw) << 4));
#pragma unroll
              for (int kk = 0; kk < 4; ++kk) fs[kk] = ld8(lds, OFF_ST + (wid * 16 + fr) * PQ + kk * 64 + fq * 16);
#pragma unroll
              for (int ti = 0; ti < 4; ++ti) { f32x4 a4 = {0.f, 0.f, 0.f, 0.f};
#pragma unroll
                  for (int kk = 0; kk < 2; ++kk) a4 = __builtin_amdgcn_mfma_f32_16x16x32_bf16(fv[kk], ld8(lds, OFF_AM + (ti * 16 + fr) * PT + kk * 64 + fq * 16), a4, 0, 0, 0);
#pragma unroll
                  for (int kk = 0; kk < 4; ++kk) a4 = __builtin_amdgcn_mfma_f32_16x16x32_bf16(fs[kk], ld8(lds, OFF_QD + (ti * 16 + fr) * PQ + kk * 64 + fq * 16), a4, 0, 0, 0);
                  const int r = gla_row(b, c, ti * 16 + fr);
                  if (r >= 0) { u32x2 w; w.x = cvt_pk_bf16(a4[0], a4[1]); w.y = cvt_pk_bf16(a4[2], a4[3]); *(u32x2*)(obuf + (size_t)r * 1024 + hd * 256 + vp * 128 + wid * 16 + 4 * fq) = w; } } }
            __syncthreads();
            { const f32x4 dc = *(const LAS f32x4*)(lds + OFF_DEC + (16 * wid + 4 * fq) * 4); bf16x8 fk[2];
#pragma unroll
              for (int kk = 0; kk < 2; ++kk) fk[kk] = ld8(lds, OFF_KET + (16 * wid + fr) * PT + (((kk * 4 + fq) ^ (wid & 7)) << 4));
#pragma unroll
              for (int vbk = 0; vbk < 8; ++vbk) { accS[vbk] = accS[vbk] * dc; const int vsw = (2 * vbk + (fr >> 3)) & 7;
#pragma unroll
                  for (int kk = 0; kk < 2; ++kk) accS[vbk] = __builtin_amdgcn_mfma_f32_16x16x32_bf16(fk[kk], ld8(lds, OFF_VT + (vbk * 16 + fr) * PT + (((kk * 4 + fq) ^ vsw) << 4)), accS[vbk], 0, 0, 0);
                  u32x2 w; w.x = cvt_pk_bf16(accS[vbk][0], accS[vbk][1]); w.y = cvt_pk_bf16(accS[vbk][2], accS[vbk][3]);
                  *(LAS u32x2*)(lds + OFF_ST + (vbk * 16 + fr) * PQ + (16 * wid + 4 * fq) * 2) = w; } }
            __syncthreads();
        }
#undef GLA_LOAD
#undef GLA_LOAD_FAST
#undef GLA_LOAD_SLOW
    }
}

__device__ __forceinline__ void phase_gla_post(const Params& p) {
    unsigned char* ws = p.ws; const bf16_t* o = (const bf16_t*)(ws + WS_H); const bf16_t* ob = o + (size_t)MROWS * 1024; const bf16_t* r = (const bf16_t*)(ws + U_GR); bf16_t* og = (bf16_t*)(ws + U_GV);
    const float* hn = p.in[11]; const int tid = get_tid(), lane = tid & 63, wid = tid >> 6;
    float g[16];
#pragma unroll
    for (int i = 0; i < 16; ++i) g[i] = hn[(lane & 15) * 16 + i];
    for (int row = blockIdx.x * 8 + wid; row < MROWS; row += gridDim.x * 8) {
        const size_t off = (size_t)row * 1024 + lane * 16;
        const u32x4 o0 = *(const u32x4*)(o + off), o1 = *(const u32x4*)(o + off + 8), p0 = *(const u32x4*)(ob + off), p1 = *(const u32x4*)(ob + off + 8), r0 = *(const u32x4*)(r + off), r1 = *(const u32x4*)(r + off + 8);
        const unsigned ow[8] = {o0.x, o0.y, o0.z, o0.w, o1.x, o1.y, o1.z, o1.w}, pw[8] = {p0.x, p0.y, p0.z, p0.w, p1.x, p1.y, p1.z, p1.w}, rw[8] = {r0.x, r0.y, r0.z, r0.w, r1.x, r1.y, r1.z, r1.w};
        float x[16]; float ss = 0.f;
#pragma unroll
        for (int i = 0; i < 8; ++i) { x[2 * i] = bflo(ow[i]) + bflo(pw[i]); x[2 * i + 1] = bfhi(ow[i]) + bfhi(pw[i]); ss += x[2 * i] * x[2 * i] + x[2 * i + 1] * x[2 * i + 1]; }
        ss += __shfl_xor(ss, 1); ss += __shfl_xor(ss, 2); ss += __shfl_xor(ss, 4); ss += __shfl_xor(ss, 8);
        const float rs = rsqrtf(ss * (1.f / 256.f) + EPS); unsigned w[8];
#pragma unroll
        for (int i = 0; i < 8; ++i) w[i] = cvt_pk_bf16(x[2 * i] * rs * g[2 * i] * silu_f(bflo(rw[i])), x[2 * i + 1] * rs * g[2 * i + 1] * silu_f(bfhi(rw[i])));
        *(u32x4*)(og + off) = (u32x4){w[0], w[1], w[2], w[3]}; *(u32x4*)(og + off + 8) = (u32x4){w[4], w[5], w[6], w[7]};
    }
}

__device__ __forceinline__ void attn_prep_head(bf16_t* base, int pos, bool real, int ax, int ic, const float* gn) {
    const int d0 = ax * 64 + ic * 8;
    const u32x4 wa = *(const u32x4*)(base + d0), wb = *(const u32x4*)(base + d0 + 32);
    const unsigned aw[4] = {wa.x, wa.y, wa.z, wa.w}, bw[4] = {wb.x, wb.y, wb.z, wb.w};
    float xa[8], xb[8]; float ss = 0.f;
#pragma unroll
    for (int j = 0; j < 4; ++j) { xa[2 * j] = bflo(aw[j]); xa[2 * j + 1] = bfhi(aw[j]); xb[2 * j] = bflo(bw[j]); xb[2 * j + 1] = bfhi(bw[j]); }
#pragma unroll
    for (int j = 0; j < 8; ++j) ss += xa[j] * xa[j] + xb[j] * xb[j];
    ss += __shfl_xor(ss, 1); ss += __shfl_xor(ss, 2); ss += __shfl_xor(ss, 4);
    const float rs = rsqrtf(ss * (1.f / 128.f) + EPS);
    const float t = real ? (float)(ax ? (pos & 63) : (pos >> 6)) : 0.f;
    const f32x4 ga0 = *(const f32x4*)(gn + d0), ga1 = *(const f32x4*)(gn + d0 + 4), gb0 = *(const f32x4*)(gn + d0 + 32), gb1 = *(const f32x4*)(gn + d0 + 36);
    float oa[8], ob[8];
#pragma unroll
    for (int j = 0; j < 8; ++j) { const float invf = __builtin_amdgcn_exp2f(-(float)(ic * 8 + j) * (2.0f / 64.0f) * 13.287712379549449f);
        float rev = t * invf * 0.15915494309189535f; rev -= floorf(rev);
        const float sn = __builtin_amdgcn_sinf(rev), cs = __builtin_amdgcn_cosf(rev);
        const float ya = xa[j] * rs * (j < 4 ? ga0[j & 3] : ga1[j & 3]), yb = xb[j] * rs * (j < 4 ? gb0[j & 3] : gb1[j & 3]);
        oa[j] = ya * cs - yb * sn; ob[j] = yb * cs + ya * sn; }
    *(u32x4*)(base + d0) = (u32x4){cvt_pk_bf16(oa[0], oa[1]), cvt_pk_bf16(oa[2], oa[3]), cvt_pk_bf16(oa[4], oa[5]), cvt_pk_bf16(oa[6], oa[7])};
    *(u32x4*)(base + d0 + 32) = (u32x4){cvt_pk_bf16(ob[0], ob[1]), cvt_pk_bf16(ob[2], ob[3]), cvt_pk_bf16(ob[4], ob[5]), cvt_pk_bf16(ob[6], ob[7])};
}
__device__ __forceinline__ void phase_attn_prep(const Params& p) {
    unsigned char* ws = p.ws; bf16_t* k = (bf16_t*)(ws + U_AK);
    const float* kn = p.in[15]; const int tid = get_tid(), lane = tid & 63, wid = tid >> 6;
    const int sub = lane & 7, ax = sub >> 2, ic = sub & 3, hl = lane >> 3;
    for (int r4 = blockIdx.x * 8 + wid; r4 < MROWS / 4; r4 += gridDim.x * 8) { const int row = r4 * 4 + (hl >> 1);
        attn_prep_head(k + (size_t)row * 256 + (hl & 1) * 128, (row - R0) & 4095, row >= R0, ax, ic, kn); }
}

__device__ __forceinline__ void phase_final(const Params& p) {
    unsigned char* ws = p.ws; const bf16_t* hb = (const bf16_t*)(ws + WS_HB); const float* ssq = (const float*)(ws + WS_SSQ) + 6 * (size_t)MROWS * 16; const float* gn = p.in[21];
    const int tid = get_tid(), lane = tid & 63, wid = tid >> 6;
    f32x4 g[4];
#pragma unroll
    for (int i = 0; i < 4; ++i) g[i] = *(const f32x4*)(gn + i * 256 + lane * 4);
    float pofs = 0.f;
    if (TPROBE_MASK) pofs = sqrtf(*(const float*)(ws + WS_NEED) * 1e-8f);
    for (int rq = blockIdx.x * 8 + wid; rq < (MROWS - R0) / 4; rq += gridDim.x * 8) {
        u32x2 w[4][4]; float sr[4];
#pragma unroll
        for (int k = 0; k < 4; ++k) { const int row = R0 + rq * 4 + k;
#pragma unroll
            for (int i = 0; i < 4; ++i) w[k][i] = *(const u32x2*)(hb + (size_t)row * DM + i * 256 + lane * 4);
            sr[k] = row_rstd(ssq, row); }
#pragma unroll
        for (int k = 0; k < 4; ++k) { const int row = R0 + rq * 4 + k;
#pragma unroll
            for (int i = 0; i < 4; ++i) { const f32x4 v = {bflo(w[k][i].x), bfhi(w[k][i].x), bflo(w[k][i].y), bfhi(w[k][i].y)};
                __builtin_nontemporal_store(v * sr[k] * g[i] + pofs, (f32x4*)(p.out + (size_t)(row - R0) * DM + i * 256 + lane * 4)); } }
    }
}

namespace att {
constexpr int D = 128, KVBLK = 64, LDQ = 1024, LDK = 256, LDO = 1024;
constexpr float SCALE = 0.088388347648318440f, THR = 8.f;
constexpr size_t SHM_V = KVBLK * D * 2, SHM_K = KVBLK * D * 2, SHM_ATTN = 2 * SHM_V + 2 * SHM_K + 8 * 64 * 4;
#define KSWZ(row, colB) ((row) * 256 + ((colB) ^ (((row) & 7) << 4)))
#define SBAR() __builtin_amdgcn_sched_barrier(0)
__device__ __forceinline__ int crow(int r, int hi) { return (r & 3) + 8 * (r >> 2) + 4 * hi; }
__device__ __forceinline__ void partialSM(f32x16& p0, f32x16& p1, float& m_reg, float& mn, float& alpha) {
  constexpr float C = SCALE * 1.4426950408889634f;
  float pmax = p0[0]; for (int r = 1; r < 16; ++r) pmax = fmaxf(pmax, p0[r]); for (int r = 0; r < 16; ++r) pmax = fmaxf(pmax, p1[r]);
  { auto rr = __builtin_amdgcn_permlane32_swap(__float_as_uint(pmax), __float_as_uint(pmax), false, false);
    pmax = fmaxf(__uint_as_float(rr[0]), __uint_as_float(rr[1])); }
  if (__builtin_expect(__all(pmax - m_reg <= THR / SCALE), 1)) { mn = m_reg; alpha = 1.f; }
  else { mn = fmaxf(m_reg, pmax); alpha = __builtin_amdgcn_exp2f((m_reg - mn) * C); m_reg = mn; }
  float mnC = -mn * C;
  for (int r = 0; r < 16; ++r) p0[r] = fmaf(p0[r], C, mnC); for (int r = 0; r < 16; ++r) p1[r] = fmaf(p1[r], C, mnC);
  for (int r = 0; r < 16; ++r) p0[r] = __builtin_amdgcn_exp2f(p0[r]);
}
__device__ __forceinline__ void finishSM(f32x16& p0, f32x16& p1, float alpha, float& l_reg, bf16x8& pa0, bf16x8& pa1, bf16x8& pa2, bf16x8& pa3) {
  for (int r = 0; r < 16; ++r) p1[r] = __builtin_amdgcn_exp2f(p1[r]);
  float ps = 0; for (int r = 0; r < 16; ++r) ps += p0[r]; for (int r = 0; r < 16; ++r) ps += p1[r];
  { auto rr = __builtin_amdgcn_permlane32_swap(__float_as_uint(ps), __float_as_uint(ps), false, false);
    ps = __uint_as_float(rr[0]) + __uint_as_float(rr[1]); }
  l_reg = l_reg * alpha + ps;
#define PK4(P, BASE, OUT) do { unsigned a0 = cvt_pk_bf16(P[BASE + 0], P[BASE + 1]), a1 = cvt_pk_bf16(P[BASE + 2], P[BASE + 3]);   \
    unsigned b0 = cvt_pk_bf16(P[BASE + 4], P[BASE + 5]), b1 = cvt_pk_bf16(P[BASE + 6], P[BASE + 7]);                              \
    auto r0 = __builtin_amdgcn_permlane32_swap(a0, b0, false, false); auto r1 = __builtin_amdgcn_permlane32_swap(a1, b1, false, false); \
    u32x4 w = {r0[0], r1[0], r0[1], r1[1]}; OUT = *reinterpret_cast<bf16x8*>(&w); } while (0)
  PK4(p0, 0, pa0); PK4(p0, 8, pa1); PK4(p1, 0, pa2); PK4(p1, 8, pa3);
#undef PK4
}
__device__ __forceinline__ void qkt(f32x16& p0, f32x16& p1, const char* Ks, const bf16x8* qr, int r32, int hi) {
  p0 = f32x16{}; p1 = f32x16{};
  for (int d0 = 0; d0 < 8; ++d0) { int cb = (d0 * 16 + hi * 8) * 2;
    bf16x8 b0 = *reinterpret_cast<const bf16x8*>(Ks + KSWZ(r32, cb));
    bf16x8 b1 = *reinterpret_cast<const bf16x8*>(Ks + KSWZ(32 + r32, cb));
    p0 = __builtin_amdgcn_mfma_f32_32x32x16_bf16(b0, qr[d0], p0, 0, 0, 0);
    p1 = __builtin_amdgcn_mfma_f32_32x32x16_bf16(b1, qr[d0], p1, 0, 0, 0); }
}
__device__ __forceinline__ int v_st(int k, int c) { const int kk = (k & ~0xC) | ((k & 4) << 1) | ((k & 8) >> 1); return ((kk >> 3) * 4 + (c >> 5)) * 512 + ((kk & 7) * 32 + (c & 31)) * 2; }
__device__ __forceinline__ int v_rd_base(int lane) { return ((lane & 3) << 3) | (((lane >> 2) & 3) << 6) | (((lane >> 4) & 1) << 5) | (((lane >> 5) & 1) << 8); }
constexpr int v_rd_off(int d0, int ks, int half) { return d0 * 512 + ks * 4096 + half * 2048; }
template <int OFF> __device__ __forceinline__ s16x4 tr_read(int vb) {
  s16x4 r; asm volatile("ds_read_b64_tr_b16 %0, %1 offset:%2" : "=&v"(r) : "v"(vb), "i"(OFF) : "memory"); return r;
}
template <int D0> __device__ __forceinline__ void pv_one(f32x16& od, int vb, bf16x8 pa0, bf16x8 pa1, bf16x8 pa2, bf16x8 pa3) {
  const s16x4 l0 = tr_read<v_rd_off(D0, 0, 0)>(vb), h0 = tr_read<v_rd_off(D0, 0, 1)>(vb), l1 = tr_read<v_rd_off(D0, 1, 0)>(vb), h1 = tr_read<v_rd_off(D0, 1, 1)>(vb);
  const s16x4 l2 = tr_read<v_rd_off(D0, 2, 0)>(vb), h2 = tr_read<v_rd_off(D0, 2, 1)>(vb), l3 = tr_read<v_rd_off(D0, 3, 0)>(vb), h3 = tr_read<v_rd_off(D0, 3, 1)>(vb);
  asm volatile("s_waitcnt lgkmcnt(0)" ::: "memory"); SBAR();
#define PK(L, H) (bf16x8){L[0], L[1], L[2], L[3], H[0], H[1], H[2], H[3]}
  od = __builtin_amdgcn_mfma_f32_32x32x16_bf16(pa0, PK(l0, h0), od, 0, 0, 0);
  od = __builtin_amdgcn_mfma_f32_32x32x16_bf16(pa1, PK(l1, h1), od, 0, 0, 0);
  od = __builtin_amdgcn_mfma_f32_32x32x16_bf16(pa2, PK(l2, h2), od, 0, 0, 0);
  od = __builtin_amdgcn_mfma_f32_32x32x16_bf16(pa3, PK(l3, h3), od, 0, 0, 0);
#undef PK
}
__device__ __forceinline__ void pv_d0(f32x16* o, int vb, bf16x8 pa0, bf16x8 pa1, bf16x8 pa2, bf16x8 pa3) {
  pv_one<0>(o[0], vb, pa0, pa1, pa2, pa3); pv_one<1>(o[1], vb, pa0, pa1, pa2, pa3); pv_one<2>(o[2], vb, pa0, pa1, pa2, pa3); pv_one<3>(o[3], vb, pa0, pa1, pa2, pa3);
}
__device__ __forceinline__ void attn_body(const bf16_t* Qb, const bf16_t* K0, const bf16_t* V0, const bf16_t* K1, const bf16_t* V1, bf16_t* Ob, char* lds, const float* qn, int qpos0) {
  constexpr int NT = 65;
  const int tid = get_tid(), wid = tid >> 6, lane = tid & 63, r32 = lane & 31, hi = lane >> 5;
  char* V_lds = lds; char* K_lds = lds + 2 * SHM_V;
  float* wsf = (float*)(lds + 2 * SHM_V + 2 * SHM_K) + wid * 64; float* li_l = wsf; float* al_l = wsf + 32;
  float m_reg = -1e30f, l_reg = 0; f32x16 o[4] = {}; bf16x8 qr[8];
  const bf16_t* Qw = Qb + (long)(wid * 32 + r32) * LDQ + hi * 8;
#pragma unroll
  for (int d0 = 0; d0 < 8; ++d0) qr[d0] = *reinterpret_cast<const bf16x8*>(Qw + d0 * 16);
  { float ss = 0.f;
#pragma unroll
    for (int d0 = 0; d0 < 8; ++d0)
#pragma unroll
      for (int j = 0; j < 8; ++j) { const float x = bf2f((bf16_t)qr[d0][j]); ss += x * x; }
    ss += __shfl_xor(ss, 32);
    const float rs = rsqrtf(ss * (1.f / 128.f) + EPS);
    const int pos = (qpos0 + wid * 32 + r32) & 4095;
#pragma unroll
    for (int ax = 0; ax < 2; ++ax) { const float t = (float)(ax ? (pos & 63) : (pos >> 6));
#pragma unroll
      for (int bl = 0; bl < 2; ++bl) { const int da = ax * 4 + bl, db = da + 2; unsigned wa[4], wb[4];
        const f32x4 ga0 = *(const f32x4*)(qn + da * 16 + hi * 8), ga1 = *(const f32x4*)(qn + da * 16 + hi * 8 + 4), gb0 = *(const f32x4*)(qn + db * 16 + hi * 8), gb1 = *(const f32x4*)(qn + db * 16 + hi * 8 + 4);
#pragma unroll
        for (int jp = 0; jp < 4; ++jp) { float oa[2], ob[2];
#pragma unroll
          for (int jj = 0; jj < 2; ++jj) { const int j = jp * 2 + jj;
            const float invf = __builtin_amdgcn_exp2f(-(float)(bl * 16 + j) * (2.0f / 64.0f) * 13.287712379549449f) * __builtin_amdgcn_exp2f(-(float)hi * (16.0f / 64.0f) * 13.287712379549449f);
            float rev = t * invf * 0.15915494309189535f; rev -= floorf(rev);
            const float sn = __builtin_amdgcn_sinf(rev), cs = __builtin_amdgcn_cosf(rev);
            const float ya = bf2f((bf16_t)qr[da][j]) * rs * (j < 4 ? ga0[j & 3] : ga1[j & 3]), yb = bf2f((bf16_t)qr[db][j]) * rs * (j < 4 ? gb0[j & 3] : gb1[j & 3]);
            oa[jj] = ya * cs - yb * sn; ob[jj] = yb * cs + ya * sn; }
          wa[jp] = cvt_pk_bf16(oa[0], oa[1]); wb[jp] = cvt_pk_bf16(ob[0], ob[1]); }
        { u32x4 w = {wa[0], wa[1], wa[2], wa[3]}; qr[da] = *reinterpret_cast<bf16x8*>(&w); }
        { u32x4 w = {wb[0], wb[1], wb[2], wb[3]}; qr[db] = *reinterpret_cast<bf16x8*>(&w); } } }
  }
  const int sr = tid >> 4, sc = (tid & 15) * 8, vst0 = v_st(sr, sc), vst1 = v_st(32 + sr, sc);
  const int vb0 = (int)(uintptr_t)V_lds + v_rd_base(lane);
  struct { bf16x8 vs0, vs1, ks0, ks1; } sr_[2];
#define TKP(T) ((T) == 0 ? K0 : K1 + (long)((T) - 1) * 64 * LDK)
#define TVP(T) ((T) == 0 ? V0 : V1 + (long)((T) - 1) * 64 * LDK)
#define SLOAD(i, T) do { const bf16_t* kp_ = TKP(T); const bf16_t* vp_ = TVP(T); \
    sr_[i].vs0 = *reinterpret_cast<const bf16x8*>(&vp_[(long)(sr) * LDK + sc]); sr_[i].vs1 = *reinterpret_cast<const bf16x8*>(&vp_[(long)(32 + sr) * LDK + sc]); \
    sr_[i].ks0 = *reinterpret_cast<const bf16x8*>(&kp_[(long)(sr) * LDK + sc]); sr_[i].ks1 = *reinterpret_cast<const bf16x8*>(&kp_[(long)(32 + sr) * LDK + sc]); } while (0)
#define SWRITE(b, i) do { *(bf16x8*)(V_lds + (b) * SHM_V + vst0) = sr_[i].vs0;          \
    *(bf16x8*)(V_lds + (b) * SHM_V + vst1) = sr_[i].vs1; int kc = sc * 2;               \
    *(bf16x8*)(K_lds + (b) * SHM_K + KSWZ(sr, kc)) = sr_[i].ks0;                       \
    *(bf16x8*)(K_lds + (b) * SHM_K + KSWZ(32 + sr, kc)) = sr_[i].ks1; } while (0)
#define SWAIT() asm volatile("s_waitcnt vmcnt(4)" ::: "memory")
#define RESC(a) do { if (__any((a) < 1.f)) { if (hi == 0) al_l[r32] = (a); asm volatile("s_waitcnt lgkmcnt(0)" ::: "memory"); \
    for (int d = 0; d < 4; ++d) for (int r = 0; r < 16; ++r) o[d][r] *= al_l[crow(r, hi)]; } } while (0)
  f32x16 pA0, pA1, pB0, pB1; float mnA, mnB, alA, alB; bf16x8 pa0, pa1, pa2, pa3;
  constexpr int SE = 0, SO = 1;
  SLOAD(SE, 0); asm volatile("s_waitcnt vmcnt(0)" ::: "memory"); SWRITE(0, SE); __syncthreads();
  qkt(pA0, pA1, K_lds, qr, r32, hi);
#pragma unroll
  for (int r = 8; r < 16; ++r) pA0[r] = -1e30f;
#pragma unroll
  for (int r = 0; r < 16; ++r) pA1[r] = -1e30f;
  partialSM(pA0, pA1, m_reg, mnA, alA);
  SLOAD(SO, 1); SLOAD(SE, 2);
  SWAIT(); SWRITE(1, SO); __syncthreads();
  for (int j = 1; j + 1 < NT; j += 2) {
    SBAR(); qkt(pB0, pB1, K_lds + SHM_K, qr, r32, hi);
    finishSM(pA0, pA1, alA, l_reg, pa0, pa1, pa2, pa3); SBAR();
    SLOAD(SO, (j + 2 < NT) ? j + 2 : NT - 1); SBAR();
    pv_d0(o, vb0, pa0, pa1, pa2, pa3); partialSM(pB0, pB1, m_reg, mnB, alB);
    __syncthreads(); SWAIT(); SWRITE(0, SE);
    RESC(alB); __syncthreads();
    SBAR(); qkt(pA0, pA1, K_lds, qr, r32, hi);
    finishSM(pB0, pB1, alB, l_reg, pa0, pa1, pa2, pa3); SBAR();
    SLOAD(SE, (j + 3 < NT) ? j + 3 : NT - 1); SBAR();
    pv_d0(o, vb0 + (int)SHM_V, pa0, pa1, pa2, pa3); partialSM(pA0, pA1, m_reg, mnA, alA);
    __syncthreads(); SWAIT(); SWRITE(1, SO);
    RESC(alA); __syncthreads();
  }
  finishSM(pA0, pA1, alA, l_reg, pa0, pa1, pa2, pa3); SBAR();
  pv_d0(o, vb0, pa0, pa1, pa2, pa3);
  if (hi == 0) li_l[r32] = l_reg; asm volatile("s_waitcnt lgkmcnt(0)" ::: "memory");
  float rli[16];
#pragma unroll
  for (int r = 0; r < 16; ++r) rli[r] = __builtin_amdgcn_rcpf(li_l[crow(r, hi)]);
  bf16_t* Ow = Ob + (long)(wid * 32) * LDO;
#pragma unroll
  for (int r = 0; r < 16; ++r) { int orow = crow(r, hi);
    for (int d0 = 0; d0 < 4; ++d0) { const float v = o[d0][r] * rli[r]; Ow[(long)orow * LDO + d0 * 32 + r32] = (bf16_t)(cvt_pk_bf16(v, v) & 0xffffu); } }
#undef SLOAD
#undef SWRITE
#undef SWAIT
#undef RESC
#undef TKP
#undef TVP
}
}

__device__ __forceinline__ void phase_attn(const Params& p, char* lds) {
    unsigned char* ws = p.ws; const bf16_t* q = (const bf16_t*)(ws + U_AQ); const bf16_t* k = (const bf16_t*)(ws + U_AK); const bf16_t* v = (const bf16_t*)(ws + U_AV); bf16_t* ao = (bf16_t*)(ws + U_AO);
    const bool xmap = (gridDim.x == 256);
    for (int it = blockIdx.x, rnd = 0; it < 2048; it += gridDim.x, ++rnd) {
        int item = it;
        if (xmap) { const int x = blockIdx.x & 7, j = blockIdx.x >> 3, pair = x * 4 + (rnd >> 1), i64 = (rnd & 1) * 32 + j; item = (pair >> 1) * 128 + ((pair & 1) * 4 + (i64 >> 4)) * 16 + (i64 & 15); }
        const int qb = item & 15, hh = (item >> 4) & 7, b = item >> 7, kvh = hh >> 2;
        const size_t qrow = (size_t)R0 + (size_t)b * SEQ + qb * 256;
        att::attn_body(q + qrow * 1024 + hh * 128, k + (size_t)(b * 16) * 256 + kvh * 128, v + (size_t)(b * 16) * 256 + kvh * 128,
                       k + ((size_t)R0 + (size_t)b * SEQ) * 256 + kvh * 128, v + ((size_t)R0 + (size_t)b * SEQ) * 256 + kvh * 128,
                       ao + qrow * 1024 + hh * 128, lds, p.in[14], qb * 256);
        __syncthreads();
    }
}

#define XB_TMO      128
#define XB_XCNT(j)  (256  + 64 * (j))
#define XB_XSUB(j)  (1280 + 64 * (j))
#define XB_XGEN(j)  (2304 + 64 * (j))
#define XB_TOP      3328
#define XB_TOPGEN   3392
#define XCD_BAR_WORDS 3456
#define XB_SPIN_CAP (1u << 18)
__device__ __forceinline__ unsigned xb_ld(unsigned* p)              { return __hip_atomic_load(p, __ATOMIC_RELAXED, __HIP_MEMORY_SCOPE_AGENT); }
__device__ __forceinline__ unsigned xb_add(unsigned* p, unsigned v) { return __hip_atomic_fetch_add(p, v, __ATOMIC_RELAXED, __HIP_MEMORY_SCOPE_AGENT); }
__device__ __forceinline__ unsigned xb_xcc_id() { return (unsigned)__builtin_amdgcn_s_getreg((3 << 11) | 20) & 0xFu; }
#define XB_SPIN(cond, bar) do { unsigned _sp = 0; while (cond) { __builtin_amdgcn_s_sleep(1); \
    if ((++_sp & 255u) == 0u) { if (xb_ld(&(bar)[XB_TMO])) break; if (_sp > XB_SPIN_CAP) { atomicAdd(&(bar)[XB_TMO], 1u); break; } } } } while (0)
struct XcdBarrier { unsigned* bar; unsigned x; volatile LAS unsigned* st; };
__device__ __forceinline__ XcdBarrier xcd_barrier_post(unsigned* bar, volatile LAS unsigned* st) {
    XcdBarrier b; b.bar = bar; b.x = xb_xcc_id(); b.st = st;
    if (threadIdx.x == 0) (void)xb_add(&bar[XB_XCNT(b.x)], 1u);
    return b;
}
__device__ __forceinline__ void xcd_barrier_complete(unsigned* bar, unsigned x, unsigned& nloc, unsigned& nx) {
    const unsigned G = gridDim.x * gridDim.y * gridDim.z;
    unsigned sum, cnt, mine, sp = 0u;
    for (;;) {
        sum = 0u; cnt = 0u; mine = 0u;
#pragma unroll
        for (unsigned j = 0; j < 16; ++j) { const unsigned c = xb_ld(&bar[XB_XCNT(j)]); sum += c; cnt += (c > 0u) ? 1u : 0u; mine = (j == x) ? c : mine; }
        if (sum == G) break;
        __builtin_amdgcn_s_sleep(1);
        if ((++sp & 255u) == 0u) { if (xb_ld(&bar[XB_TMO])) break; if (sp > XB_SPIN_CAP) { atomicAdd(&bar[XB_TMO], 1u); break; } }
    }
    nloc = mine > 0u ? mine : 1u; nx = cnt > 0u ? cnt : 1u;
}
__device__ __forceinline__ void xcd_barrier(const XcdBarrier& b) {
    asm volatile("s_waitcnt vmcnt(0)" ::: "memory");
    __syncthreads();
    if (threadIdx.x == 0) {
        unsigned* bar = b.bar;
        __builtin_amdgcn_s_waitcnt(0);
        unsigned nloc = b.st[0], nx = b.st[1];
        if (nloc == 0u) { xcd_barrier_complete(bar, b.x, nloc, nx); b.st[0] = nloc; b.st[1] = nx; }
        const unsigned old = xb_add(&bar[XB_XSUB(b.x)], 1u);
        const unsigned gen = old / nloc;
        if (old + 1u == (gen + 1u) * nloc) {
            __builtin_amdgcn_fence(__ATOMIC_RELEASE, "agent");
            asm volatile("s_waitcnt vmcnt(0)" ::: "memory");
            const unsigned og = xb_add(&bar[XB_TOP], 1u);
            const unsigned tg = og / nx;
            if (og + 1u == (tg + 1u) * nx) xb_add(&bar[XB_TOPGEN], 1u);
            else XB_SPIN(xb_ld(&bar[XB_TOPGEN]) == tg, bar);
            __builtin_amdgcn_fence(__ATOMIC_ACQUIRE, "agent");
            xb_add(&bar[XB_XGEN(b.x)], 1u);
            asm volatile("s_waitcnt vmcnt(0)" ::: "memory");
        } else {
            XB_SPIN(xb_ld(&bar[XB_XGEN(b.x)]) == gen, bar);
            __builtin_amdgcn_fence(__ATOMIC_ACQUIRE, "agent");
            asm volatile("s_waitcnt vmcnt(0)" ::: "memory");
        }
    }
    __syncthreads();
}

__global__ void __launch_bounds__(512, 1) mega_fwd(Params p) {
    extern __shared__ __attribute__((aligned(16))) unsigned char shm[];
    ldsp lds = (ldsp)shm;
    unsigned char* ws = p.ws;
    bf16_t* hb = (bf16_t*)(ws + WS_HB); float* ssq = (float*)(ws + WS_SSQ);
    const int G = gridDim.x, c = blockIdx.x;
    if (threadIdx.x < 4) ((volatile LAS unsigned*)(lds + LDS_BYTES))[threadIdx.x] = 0u;
    if (blockIdx.x == 0 && p.hi - p.lo > 1) for (int i = threadIdx.x; i < XCD_BAR_WORDS; i += 512) ((unsigned*)(p.ws + WS_BAR))[i] = 0u;
    __syncthreads();
    unsigned long long tp0 = 0; float tpsum = 0.f;
    for (int ph = p.lo; ph < p.hi; ++ph) {
        if (TPROBE_MASK && blockIdx.x == 0 && threadIdx.x == 0) tp0 = __builtin_amdgcn_s_memrealtime();
        int kind, f = 0, nin = 0, nout = 0;
        switch (ph) {
            case 0: kind = 0; break;
            case 1: kind = 1; f = 0; nin = 0; break;
            case 2: kind = 2; f = 0; nout = (DIAG == 2) ? 6 : 1; break;
            case 3: kind = 3; nin = 1; break;
            case 4: kind = 4; break;
            case 5: kind = 5; break;
            case 6: kind = 2; f = 4; nout = (DIAG == 3) ? 6 : 2; break;
            case 7: kind = 1; f = 1; nin = 2; break;
            case 8: kind = 2; f = 1; nout = 3; break;
            case 9: kind = 1; f = 2; nin = 3; break;
            case 10: kind = 2; f = 2; nout = 4; break;
            case 11: kind = 6; nin = 4; break;
            case 12: kind = 7; break;
            case 13: kind = 8; break;
            case 14: kind = 2; f = 5; nout = 5; break;
            case 15: kind = 1; f = 3; nin = 5; break;
            case 16: kind = 2; f = 3; nout = 6; break;
            default: kind = 9; break;
        }
        if (!((PHMASK >> ph) & 1)) kind = 99;
        const int pmoff = (ph >= 14) ? 1 : 0; const int Mrows = MROWS - pmoff * 256;
        if (kind == 0) { if (KMASK & 1) phase_prep(p, lds); }
        else if (kind == 1 && (KMASK & 2)) {
            pg8::Gemm g{hb + (size_t)pmoff * 256 * DM, (const bf16_t*)(ws + WS_WGU + f * SZ_WGU), Mrows, 2 * FF, DM, 0}; pg8::StaticOrder S; S.init(Mrows, 2 * FF, G, c);
            EpiSwiGLU E{(bf16_t*)(ws + U_ACT), ssq + (size_t)nin * MROWS * 16, pmoff, lds};
            rstd_table_build(lds, S, E.ssq, pmoff);
            pg8::gemm_phase(lds, g, S, E);
        } else if (kind == 2 && (KMASK & 4)) {
            pg8::Gemm g; float alpha; const float* x32 = nullptr;
            if (f < 4) { g = pg8::Gemm{(const bf16_t*)(ws + U_ACT) + (size_t)pmoff * 256 * FF, (const bf16_t*)(ws + WS_WD + f * SZ_WD), Mrows, DM, FF, 1}; alpha = 0.5f; if (ph == 2) x32 = p.in[0] - (size_t)R0 * DM; }
            else if (f == 4) { g = pg8::Gemm{(const bf16_t*)(ws + U_GV), (const bf16_t*)(ws + WS_WGOUT), MROWS, DM, DM, 0}; alpha = 1.f; }
            else { g = pg8::Gemm{(const bf16_t*)(ws + U_AO) + (size_t)pmoff * 256 * DM, (const bf16_t*)(ws + WS_WAOUT), Mrows, DM, DM, 0}; alpha = 1.f; }
            pg8::StaticOrder S; S.init(Mrows, DM, G, c);
            EpiResid E{x32, hb, ssq + (size_t)nout * MROWS * 16, alpha, pmoff};
            pg8::gemm_phase(lds, g, S, E);
        } else if (kind == 3 && (KMASK & 8)) {
            pg8::Gemm g{hb, (const bf16_t*)(ws + WS_WGIN), MROWS, 4096, DM, 0}; pg8::StaticOrder S; S.init(MROWS, 4096, G, c);
            EpiGlaIn E{(bf16_t*)((unsigned char*)p.out + O_GQ), (bf16_t*)(ws + U_GK), (bf16_t*)(ws + U_GV), (bf16_t*)(ws + U_GR), (float*)((unsigned char*)p.out + O_GF), (float*)(ws + U_GB),
                       ssq + (size_t)nin * MROWS * 16, p.in[10], lds};
            for (int i = get_tid(); i < 1024; i += 512) *(LAS float*)(lds + GB_OFF + i * 4) = p.in[10][i];
            rstd_table_build(lds, S, E.ssq, 0);
            pg8::gemm_phase(lds, g, S, E);
        } else if (kind == 4) { if (KMASK & 16) phase_gla_seq(p, lds); }
        else if (kind == 5) { if (KMASK & 32) phase_gla_post(p); }
        else if (kind == 6 && (KMASK & 64)) {
            pg8::Gemm g{hb, (const bf16_t*)(ws + WS_WAIN), MROWS, 1536, DM, 0}; pg8::StaticOrder S; S.init(MROWS, 1536, G, c);
            EpiAttnIn E{(bf16_t*)(ws + U_AQ), (bf16_t*)(ws + U_AK), (bf16_t*)(ws + U_AV), ssq + (size_t)nin * MROWS * 16, lds};
            rstd_table_build(lds, S, E.ssq, 0);
            pg8::gemm_phase(lds, g, S, E);
        } else if (kind == 7) { if (KMASK & 128) phase_attn_prep(p); }
        else if (kind == 8) { if (KMASK & 256) phase_attn(p, (char*)shm); }
        else if (kind == 9 && (KMASK & 512)) phase_final(p);
        if (ph + 1 < p.hi) {
            if (ph == p.lo) { cg::this_grid().sync(); (void)xcd_barrier_post((unsigned*)(p.ws + WS_BAR), (volatile LAS unsigned*)(lds + LDS_BYTES)); }
            else { XcdBarrier xb; xb.bar = (unsigned*)(p.ws + WS_BAR); xb.x = xb_xcc_id(); xb.st = (volatile LAS unsigned*)(lds + LDS_BYTES); xcd_barrier(xb); } }
        if (TPROBE_MASK) { if (blockIdx.x == 0 && threadIdx.x == 0) { const unsigned long long tp1 = __builtin_amdgcn_s_memrealtime(); if ((TPROBE_MASK >> ph) & 1) tpsum += (float)(tp1 - tp0) * 0.01f;
                if (ph == 16) __hip_atomic_store((float*)(ws + WS_NEED), tpsum, __ATOMIC_RELAXED, __HIP_MEMORY_SCOPE_AGENT); }
            if (ph == 16) cg::this_grid().sync(); }
    }
}

extern "C" void kernel_launch(void* const* d_in, const int* in_sizes, int n_in, void* d_out, int out_size, void* d_ws, size_t ws_size, hipStream_t stream) {
    static int grid = 0;
    if (grid == 0) {
        if (n_in != 22 || out_size != NB * SEQ * DM || ws_size < WS_END) { fprintf(stderr, "kernel_launch: unexpected shapes n_in %d out %d ws %zu (need %zu)\n", n_in, out_size, ws_size, (size_t)WS_END); grid = -1; return; }
        if (hipFuncSetAttribute((const void*)mega_fwd, hipFuncAttributeMaxDynamicSharedMemorySize, LDS_TOTAL) != hipSuccess) { fprintf(stderr, "kernel_launch: hipFuncSetAttribute failed\n"); grid = -1; return; }
        int dev = 0, cus = 0, per_cu = 0;
        hipGetDevice(&dev); hipDeviceGetAttribute(&cus, hipDeviceAttributeMultiprocessorCount, dev);
        hipOccupancyMaxActiveBlocksPerMultiprocessor(&per_cu, (const void*)mega_fwd, 512, LDS_TOTAL);
        if (per_cu < 1) { fprintf(stderr, "kernel_launch: occupancy query says %d blocks/CU\n", per_cu); per_cu = 1; }
        (void)hipGetLastError();
        grid = cus * per_cu;
    }
    if (grid < 0) return;
    Params p{};
    for (int i = 0; i < 22; ++i) p.in[i] = (const float*)d_in[i];
    p.out = (float*)d_out; p.ws = (unsigned char*)d_ws;
#if ONE_LAUNCH
    p.lo = 0; p.hi = NPHASE;
    void* args[] = {&p};
    hipError_t e = hipLaunchCooperativeKernel((const void*)mega_fwd, dim3(grid), dim3(512), args, LDS_TOTAL, stream);
    if (e != hipSuccess) fprintf(stderr, "cooperative launch failed: %s (grid %d)\n", hipGetErrorString(e), grid);
#else
    for (int ph = 0; ph < NPHASE; ++ph) { p.lo = ph; p.hi = ph + 1; hipLaunchKernelGGL(mega_fwd, dim3(grid), dim3(512), LDS_TOTAL, stream, p); }
#endif
}
```

```cpp
#include <hip/hip_runtime.h>
#include <hip/hip_cooperative_groups.h>
#include <cstdio>
namespace cg = cooperative_groups;

#ifndef TPROBE_MASK
#define TPROBE_MASK 0
#endif
#ifndef NOADD
#define NOADD 0
#endif
#ifndef FWDONLY
#define FWDONLY 0
#endif
#ifndef DIAG
#define DIAG 0
#endif
#ifndef PHMASK
#define PHMASK 0x3ffff
#endif
#ifndef KMASK
#define KMASK 1023
#endif
#ifndef ONE_LAUNCH
#define ONE_LAUNCH 1
#endif

#define LAS __attribute__((address_space(3)))
typedef unsigned short bf16_t;
typedef short bf16x8 __attribute__((ext_vector_type(8)));
typedef short s16x4 __attribute__((ext_vector_type(4)));
typedef float f32x4 __attribute__((ext_vector_type(4)));
typedef float f32x8 __attribute__((ext_vector_type(8)));
typedef float f32x16 __attribute__((ext_vector_type(16)));
typedef unsigned u32x4 __attribute__((ext_vector_type(4)));
typedef unsigned u32x2 __attribute__((ext_vector_type(2)));
typedef LAS unsigned char* ldsp;

constexpr int DM = 1024, FF = 2816, NB = 16, SEQ = 4096, NMETA = 16;
constexpr int MROWS = NB * NMETA + NB * SEQ;
constexpr int R0 = NB * NMETA;
constexpr float EPS = 1e-6f;
constexpr int LDS_BYTES = 152064;
constexpr int LDS_TOTAL = LDS_BYTES + 16;
constexpr int NPHASE = 18;

constexpr size_t SZ_H = (size_t)MROWS * DM * 4, SZ_HB = (size_t)MROWS * DM * 2, SZ_SSQ1 = (size_t)MROWS * 16 * 4;
constexpr size_t WS_H = 0, WS_HB = WS_H + SZ_H, WS_SSQ = WS_HB + SZ_HB, WS_W = WS_SSQ + 7 * SZ_SSQ1;
constexpr size_t SZ_WGU = (size_t)2 * FF * DM * 2, SZ_WD = (size_t)DM * FF * 2;
constexpr size_t WS_WGU = WS_W, WS_WD = WS_WGU + 4 * SZ_WGU, WS_WGIN = WS_WD + 4 * SZ_WD, WS_WGOUT = WS_WGIN + (size_t)4096 * DM * 2,
                 WS_WAIN = WS_WGOUT + (size_t)DM * DM * 2, WS_WAOUT = WS_WAIN + (size_t)1536 * DM * 2, WS_U = WS_WAOUT + (size_t)DM * DM * 2;
constexpr size_t U_ACT = WS_U;
constexpr size_t U_GB = WS_U, U_GK = U_GB + (size_t)MROWS * 512 * 4, U_GV = U_GK + (size_t)MROWS * 512 * 2, U_GR = U_GV + SZ_HB, U_GEND = U_GR + SZ_HB;
constexpr size_t U_AQ = WS_U, U_AK = U_AQ + SZ_HB, U_AV = U_AK + (size_t)MROWS * 256 * 2, U_AO = U_AV + (size_t)MROWS * 256 * 2, U_AEND = U_AO + SZ_HB;
constexpr size_t WS_NEED = (U_GEND > U_AEND ? U_GEND : U_AEND);
constexpr size_t WS_BAR = WS_NEED + 256, WS_END = WS_BAR + 16384;
constexpr size_t O_GF = 0, O_GQ = (size_t)MROWS * 512 * 4;

struct Params { const float* in[22]; float* out; unsigned char* ws; int lo, hi; };

typedef __bf16 bf16x2_t __attribute__((ext_vector_type(2)));
typedef float f32x2_t __attribute__((ext_vector_type(2)));
__device__ __forceinline__ unsigned cvt_pk_bf16(float lo, float hi) { const f32x2_t f = {lo, hi}; const bf16x2_t b = __builtin_convertvector(f, bf16x2_t); return __builtin_bit_cast(unsigned, b); }
__device__ __forceinline__ int get_tid() { int t = threadIdx.x; asm volatile("" : "+v"(t)); return t; }
__device__ __forceinline__ float bf2f(bf16_t v) { return __uint_as_float(((unsigned)v) << 16); }
__device__ __forceinline__ float bflo(unsigned w) { return __uint_as_float(w << 16); }
__device__ __forceinline__ float bfhi(unsigned w) { return __uint_as_float(w & 0xffff0000u); }
__device__ __forceinline__ float row_rstd(const float* ssq, int row) { const f32x4* p4 = (const f32x4*)(ssq + (size_t)row * 16); const f32x4 a = p4[0], b = p4[1], c = p4[2], d = p4[3];
    const f32x4 t = (a + b) + (c + d); return rsqrtf(((t[0] + t[1]) + (t[2] + t[3])) * (1.f / 1024.f) + EPS); }
__device__ __forceinline__ float fast_exp(float x) { return __builtin_amdgcn_exp2f(x * 1.4426950408889634f); }
__device__ __forceinline__ float silu_f(float x) { return x * __builtin_amdgcn_rcpf(1.f + __builtin_amdgcn_exp2f(-1.4426950408889634f * x)); }

namespace pg8 {
constexpr int BM = 256, BK = 64, HALF = 128, HTB = HALF * BK * 2, STAGE_BYTES = 8 * HTB, NXCD = 8, WGM = 8;
__host__ __device__ __forceinline__ int lds_byte(int r, int c) { const int st = (r >> 4) * 2 + (c >> 5), rr = r & 15, cc = c & 31, ob = rr * 64 + cc * 2; return st * 1024 + (ob ^ (((ob >> 9) & 1) << 5)); }
__host__ __device__ __forceinline__ void stage_rc(int b, int& R, int& C) { const int st = b / 1024, sb = b % 1024, swz = sb ^ (((sb >> 9) & 1) << 5); R = (st >> 1) * 16 + swz / 64; C = (st & 1) * 32 + (swz % 64) / 2; }
__host__ __device__ __forceinline__ int perm32(int rho) { const int n = rho >> 4, i = rho & 15; return 8 * (i >> 2) + 4 * n + (i & 3); }
struct Unit { int pm, pn; };
struct Gemm { const bf16_t* A; const bf16_t* Bt; int M, N, K; int atiled; };
struct StaticOrder {
    int nM, nN, nwg, G, c;
    __device__ void init(int M, int N, int G_, int c_) { nM = M / BM; nN = N / BM; nwg = nM * nN; G = G_; c = c_; }
    __device__ bool next(int i, Unit& u) const {
        const long L = (long)i * G + c; if (L >= nwg) return false;
        int wgid = (int)L; { const int q = nwg / NXCD, r = nwg % NXCD, xcd = wgid % NXCD, off = wgid / NXCD; wgid = (xcd < r ? xcd * (q + 1) : r * (q + 1) + (xcd - r) * q) + off; }
        const int nig = WGM * nN, gid = wgid / nig, fm = gid * WGM, gsz = (nM - fm) < WGM ? (nM - fm) : WGM;
        u.pm = fm + ((wgid % nig) % gsz); u.pn = (wgid % nig) / gsz; return true;
    }
};
template <class Epi>
__device__ __forceinline__ void gemm_phase(ldsp lds, const Gemm g, const StaticOrder& S, const Epi& E) {
    const int tid = get_tid(), wid = __builtin_amdgcn_readfirstlane(tid >> 6), lane = tid & 63, wr = wid >> 2, wc = wid & 3, fr = lane & 15, fq = lane >> 4;
    const int K = g.K, nt = K / BK;
    unsigned voffA[2], voffB[2];
#pragma unroll
    for (int i = 0; i < 2; ++i) { int R, C; stage_rc(tid * 16 + i * 8192, R, C); const int Rb = Epi::PERM ? ((R & ~31) + perm32(R & 31)) : R;
        voffA[i] = (unsigned)(R * (g.atiled ? BK : K) + C) * 2u; voffB[i] = (unsigned)(Rb * K + C) * 2u; }
    const size_t kstep = (size_t)(BK * 2);
    const size_t hstep = (size_t)HALF * K * 2;
    const size_t tstep = 2 * hstep;
    const size_t kstepA = g.atiled ? (size_t)BM * BK * 2 : kstep, hstepA = g.atiled ? (size_t)HALF * BK * 2 : hstep;
    const unsigned ldsw = (unsigned)wid * 1024u;
    const int aoff = lds_byte(wr * 64 + fr, fq * 8), boff = lds_byte(wc * 32 + fr, fq * 8);
#define PG8_SA(b, h) (((b) * 2 + (h)) * HTB)
#define PG8_SB(b, h) ((4 + (b) * 2 + (h)) * HTB)
#define PG8_STAGE(bufoff, gbase, voff) do { _Pragma("unroll") for (int _i = 0; _i < 2; ++_i) \
        __builtin_amdgcn_global_load_lds((const unsigned*)((const char*)(gbase) + (voff)[_i]), (LAS unsigned*)(lds + (bufoff) + ldsw + _i * 8192), 16, 0, 0); } while (0)
#define PG8_LDA(dst, b, h) do { _Pragma("unroll") for (int m = 0; m < 4; ++m) _Pragma("unroll") for (int k = 0; k < 2; ++k) dst[m][k] = *(const LAS bf16x8*)(lds + PG8_SA(b, h) + aoff + m * 2048 + k * 1024); } while (0)
#define PG8_LDB(dst, b, h) do { _Pragma("unroll") for (int n = 0; n < 2; ++n) _Pragma("unroll") for (int k = 0; k < 2; ++k) dst[n][k] = *(const LAS bf16x8*)(lds + PG8_SB(b, h) + boff + n * 2048 + k * 1024); } while (0)
#define PG8_MMA(ai, bj, At, Bt) do { __builtin_amdgcn_s_setprio(1); _Pragma("unroll") for (int m = 0; m < 4; ++m) _Pragma("unroll") for (int n = 0; n < 2; ++n) _Pragma("unroll") for (int k = 0; k < 2; ++k) \
        acc[ai][bj][m][n] = __builtin_amdgcn_mfma_f32_16x16x32_bf16(Bt[n][k], At[m][k], acc[ai][bj][m][n], 0, 0, 0); __builtin_amdgcn_s_setprio(0); } while (0)
#define PG8_WAIT_V(n) asm volatile("s_waitcnt vmcnt(" #n ")" ::: "memory")
#define PG8_WAIT_L(n) asm volatile("s_waitcnt lgkmcnt(" #n ")" ::: "memory")
#define PG8_BAR __builtin_amdgcn_s_barrier()
#define PG8_SCHED __builtin_amdgcn_sched_barrier(0)
    Unit cur, nxt; int ui = 0;
    if (!S.next(0, cur)) return;
    f32x4 acc[2][2][4][2];
#pragma unroll
    for (int a = 0; a < 2; ++a)
#pragma unroll
        for (int b = 0; b < 2; ++b)
#pragma unroll
            for (int m = 0; m < 4; ++m)
#pragma unroll
                for (int n = 0; n < 2; ++n) acc[a][b][m][n] = (f32x4){0.f, 0.f, 0.f, 0.f};
    bf16x8 At[4][2], B0[2][2], B1[2][2];
    const char* cA = (const char*)g.A + (size_t)cur.pm * tstep; const char* cB = (const char*)g.Bt + (size_t)cur.pn * tstep;
    PG8_STAGE(PG8_SB(0, 0), cB, voffB); PG8_STAGE(PG8_SA(0, 0), cA, voffA); PG8_STAGE(PG8_SB(0, 1), cB + hstep, voffB); PG8_STAGE(PG8_SA(0, 1), cA + hstepA, voffA);
    if (wr == 1) PG8_BAR;
    PG8_WAIT_V(4); PG8_BAR;
    PG8_STAGE(PG8_SB(1, 0), cB + kstep, voffB); PG8_STAGE(PG8_SA(1, 0), cA + kstepA, voffA); PG8_STAGE(PG8_SB(1, 1), cB + hstep + kstep, voffB);
    PG8_WAIT_V(6); PG8_BAR;
    for (;;) {
        const bool has_next = S.next(ui + 1, nxt);
        const char* nA = has_next ? (const char*)g.A + (size_t)nxt.pm * tstep : cA; const char* nB = has_next ? (const char*)g.Bt + (size_t)nxt.pn * tstep : cB;
        for (int t = 0; t < nt; t += 2) {
            const bool last = (t == nt - 2);
            const char* a1 = cA + (size_t)(t + 1) * kstepA;
            const char* a2 = last ? nA : cA + (size_t)(t + 2) * kstepA; const char* b2 = last ? nB : cB + (size_t)(t + 2) * kstep;
            const char* a3 = a2 + kstepA; const char* b3 = b2 + kstep;
            PG8_LDB(B0, 0, 0); PG8_SCHED; PG8_LDA(At, 0, 0); PG8_STAGE(PG8_SA(1, 1), a1 + hstepA, voffA);
            PG8_WAIT_L(8); PG8_BAR; PG8_WAIT_L(0); PG8_MMA(0, 0, At, B0); PG8_BAR; PG8_SCHED;
            PG8_LDB(B1, 0, 1); PG8_STAGE(PG8_SB(0, 0), b2, voffB);
            PG8_BAR; PG8_WAIT_L(0); PG8_MMA(0, 1, At, B1); PG8_BAR;
            PG8_LDA(At, 0, 1); PG8_STAGE(PG8_SA(0, 0), a2, voffA);
            PG8_BAR; PG8_WAIT_L(0); PG8_MMA(1, 0, At, B0); PG8_BAR; PG8_SCHED;
            PG8_STAGE(PG8_SB(0, 1), b2 + hstep, voffB);
            PG8_WAIT_V(6); PG8_BAR; PG8_MMA(1, 1, At, B1); PG8_BAR;
            PG8_LDB(B0, 1, 0); PG8_SCHED; PG8_LDA(At, 1, 0); PG8_STAGE(PG8_SA(0, 1), a2 + hstepA, voffA);
            PG8_WAIT_L(8); PG8_BAR; PG8_WAIT_L(0); PG8_MMA(0, 0, At, B0); PG8_BAR; PG8_SCHED;
            PG8_LDB(B1, 1, 1); PG8_STAGE(PG8_SB(1, 0), b3, voffB);
            PG8_BAR; PG8_WAIT_L(0); PG8_MMA(0, 1, At, B1); PG8_BAR;
            PG8_LDA(At, 1, 1); PG8_STAGE(PG8_SA(1, 0), a3, voffA);
            PG8_BAR; PG8_WAIT_L(0); PG8_MMA(1, 0, At, B0); PG8_BAR; PG8_SCHED;
            PG8_STAGE(PG8_SB(1, 1), b3 + hstep, voffB);
            PG8_WAIT_V(6); PG8_BAR; PG8_MMA(1, 1, At, B1); PG8_BAR;
        }
        E(acc, cur, wr, wc, fr, fq);
        if (!has_next) break;
#pragma unroll
        for (int a = 0; a < 2; ++a)
#pragma unroll
            for (int b = 0; b < 2; ++b)
#pragma unroll
                for (int m = 0; m < 4; ++m)
#pragma unroll
                    for (int n = 0; n < 2; ++n) acc[a][b][m][n] = (f32x4){0.f, 0.f, 0.f, 0.f};
        cur = nxt; cA = nA; cB = nB; ++ui;
    }
    PG8_WAIT_V(0);
    if (wr == 0) PG8_BAR;
    PG8_BAR;
#undef PG8_SA
#undef PG8_SB
#undef PG8_STAGE
#undef PG8_LDA
#undef PG8_LDB
#undef PG8_MMA
#undef PG8_WAIT_V
#undef PG8_WAIT_L
#undef PG8_BAR
#undef PG8_SCHED
}
}

typedef f32x4 AccT[2][2][4][2];

constexpr int RS_OFF = 131072, RS_SLOTS = 8, RS_TAG = RS_OFF + RS_SLOTS * 256 * 4, GB_OFF = RS_TAG + 64;
static_assert(GB_OFF + 4096 <= LDS_BYTES, "rstd table + gate bias");
__device__ __forceinline__ void rstd_table_build(ldsp lds, const pg8::StaticOrder& S, const float* ssq, int pmoff) {
    const int tid = get_tid(); int nslot = 0, last = -1; pg8::Unit u;
    for (int i = 0; S.next(i, u); ++i) if (u.pm != last) { last = u.pm;
        if (nslot < RS_SLOTS) { if (tid < 256) *(LAS float*)(lds + RS_OFF + (nslot * 256 + tid) * 4) = row_rstd(ssq, (u.pm + pmoff) * 256 + tid); if (tid == 0) *(LAS int*)(lds + RS_TAG + nslot * 4) = u.pm; }
        ++nslot; }
    if (tid < RS_SLOTS && tid >= nslot) *(LAS int*)(lds + RS_TAG + tid * 4) = -1;
    __syncthreads();
}
__device__ __forceinline__ void rstd_rows(ldsp lds, const float* ssq, int pm, int pmoff, int wr, int fr, float (&rs)[8]) {
    int slot = -1;
#pragma unroll
    for (int k = 0; k < RS_SLOTS; ++k) if (*(const LAS int*)(lds + RS_TAG + k * 4) == pm) slot = k;
    if (slot >= 0) {
#pragma unroll
        for (int ai = 0; ai < 2; ++ai)
#pragma unroll
            for (int m = 0; m < 4; ++m) rs[ai * 4 + m] = *(const LAS float*)(lds + RS_OFF + (slot * 256 + ai * 128 + wr * 64 + m * 16 + fr) * 4);
    } else {
#pragma unroll
        for (int ai = 0; ai < 2; ++ai)
#pragma unroll
            for (int m = 0; m < 4; ++m) rs[ai * 4 + m] = row_rstd(ssq, (pm + pmoff) * 256 + ai * 128 + wr * 64 + m * 16 + fr);
    }
}

struct EpiSwiGLU { static constexpr bool PERM = true;
    bf16_t* act; const float* ssq; int pmoff; ldsp lds;
    __device__ __forceinline__ void operator()(const AccT& acc, const pg8::Unit& u, int wr, int wc, int fr, int fq) const {
        const int row0 = (u.pm + pmoff) * 256 + wr * 64 + fr, col0 = u.pn * 128 + wc * 32 + 8 * fq;
        float rs[8]; rstd_rows(lds, ssq, u.pm, pmoff, wr, fr, rs);
#pragma unroll
        for (int ai = 0; ai < 2; ++ai)
#pragma unroll
            for (int m = 0; m < 4; ++m) { const int row = row0 + ai * 128 + m * 16; const float s = rs[ai * 4 + m];
                float a[8];
#pragma unroll
                for (int n = 0; n < 2; ++n)
#pragma unroll
                    for (int j = 0; j < 4; ++j) a[n * 4 + j] = silu_f(acc[ai][0][m][n][j] * s) * (acc[ai][1][m][n][j] * s);
                u32x4 w; w.x = cvt_pk_bf16(a[0], a[1]); w.y = cvt_pk_bf16(a[2], a[3]); w.z = cvt_pk_bf16(a[4], a[5]); w.w = cvt_pk_bf16(a[6], a[7]);
                *(u32x4*)(act + ((size_t)((row >> 8) * (FF / 64) + (col0 >> 6)) * 256 + (row & 255)) * 64 + (col0 & 63)) = w; }
    }
};
struct EpiResid { static constexpr bool PERM = true;
    const float* x32; bf16_t* hb; float* ssq; float alpha; int pmoff;
    __device__ __forceinline__ void operator()(const AccT& acc, const pg8::Unit& u, int wr, int wc, int fr, int fq) const {
        const int row0 = (u.pm + pmoff) * 256 + wr * 64 + fr, col0 = u.pn * 256 + wc * 32 + 8 * fq;
        const bool fromx = (x32 != nullptr) && (u.pm + pmoff != 0);
        if (fromx) {
#pragma unroll
            for (int ai = 0; ai < 2; ++ai)
#pragma unroll
                for (int mh = 0; mh < 2; ++mh) { f32x4 rf[2][2][2];
#pragma unroll
                    for (int mm = 0; mm < 2; ++mm)
#pragma unroll
                        for (int bj = 0; bj < 2; ++bj) { const float* xp = x32 + (size_t)(row0 + ai * 128 + (mh * 2 + mm) * 16) * DM + col0 + bj * 128; rf[mm][bj][0] = *(const f32x4*)xp; rf[mm][bj][1] = *(const f32x4*)(xp + 4); }
#pragma unroll
                    for (int mm = 0; mm < 2; ++mm) { const int m = mh * 2 + mm; const int row = row0 + ai * 128 + m * 16; const size_t off = (size_t)row * DM + col0; float ss = 0.f;
#pragma unroll
                        for (int bj = 0; bj < 2; ++bj) { float v[8];
#pragma unroll
                            for (int n = 0; n < 2; ++n)
#pragma unroll
                                for (int j = 0; j < 4; ++j) { v[n * 4 + j] = rf[mm][bj][n][j] + alpha * acc[ai][bj][m][n][j]; ss += v[n * 4 + j] * v[n * 4 + j]; }
                            u32x4 w; w.x = cvt_pk_bf16(v[0], v[1]); w.y = cvt_pk_bf16(v[2], v[3]); w.z = cvt_pk_bf16(v[4], v[5]); w.w = cvt_pk_bf16(v[6], v[7]);
                            *(u32x4*)(hb + off + bj * 128) = w; }
                        ss += __shfl_xor(ss, 16); ss += __shfl_xor(ss, 32);
                        if (fq == 0) ssq[(size_t)row * 16 + u.pn * 4 + wc] = ss; } }
        } else {
#pragma unroll
            for (int ai = 0; ai < 2; ++ai) { u32x4 rw[4][2];
#pragma unroll
                for (int m = 0; m < 4; ++m)
#pragma unroll
                    for (int bj = 0; bj < 2; ++bj) rw[m][bj] = *(const u32x4*)(hb + (size_t)(row0 + ai * 128 + m * 16) * DM + col0 + bj * 128);
#pragma unroll
                for (int m = 0; m < 4; ++m) { const int row = row0 + ai * 128 + m * 16; const size_t off = (size_t)row * DM + col0; float ss = 0.f;
#pragma unroll
                    for (int bj = 0; bj < 2; ++bj) { const u32x4 t = rw[m][bj]; const float r[8] = {bflo(t.x), bfhi(t.x), bflo(t.y), bfhi(t.y), bflo(t.z), bfhi(t.z), bflo(t.w), bfhi(t.w)}; float v[8];
#pragma unroll
                        for (int n = 0; n < 2; ++n)
#pragma unroll
                            for (int j = 0; j < 4; ++j) { v[n * 4 + j] = r[n * 4 + j] + alpha * acc[ai][bj][m][n][j]; ss += v[n * 4 + j] * v[n * 4 + j]; }
                        u32x4 w; w.x = cvt_pk_bf16(v[0], v[1]); w.y = cvt_pk_bf16(v[2], v[3]); w.z = cvt_pk_bf16(v[4], v[5]); w.w = cvt_pk_bf16(v[6], v[7]);
                        *(u32x4*)(hb + off + bj * 128) = w; }
                    ss += __shfl_xor(ss, 16); ss += __shfl_xor(ss, 32);
                    if (fq == 0) ssq[(size_t)row * 16 + u.pn * 4 + wc] = ss; } }
        }
    }
};
struct EpiGlaIn { static constexpr bool PERM = true;
    bf16_t *q, *k, *v, *r; float *gf, *gb; const float* ssq; const float* gbias; ldsp lds;
    __device__ __forceinline__ void operator()(const AccT& acc, const pg8::Unit& u, int wr, int wc, int fr, int fq) const {
        const int row0 = u.pm * 256 + wr * 64 + fr, cin0 = wc * 32 + 8 * fq, pn = u.pn;
        float rs[8]; rstd_rows(lds, ssq, u.pm, 0, wr, fr, rs);
#pragma unroll
        for (int ai = 0; ai < 2; ++ai)
#pragma unroll
            for (int m = 0; m < 4; ++m) { const int row = row0 + ai * 128 + m * 16; float s = rs[ai * 4 + m];
                if (pn < 2) s *= 0.08838834764831845f;
#pragma unroll
                for (int bj = 0; bj < 2; ++bj) { const int c = cin0 + 128 * bj; const f32x4 v0 = acc[ai][bj][m][0] * s, v1 = acc[ai][bj][m][1] * s;
                    if (pn < 12) {
                        bf16_t* dst;
                        if (pn < 2) dst = q + (size_t)row * 512 + pn * 256 + c; else if (pn < 4) dst = k + (size_t)row * 512 + (pn - 2) * 256 + c;
                        else if (pn < 8) dst = v + (size_t)row * 1024 + (pn - 4) * 256 + c; else dst = r + (size_t)row * 1024 + (pn - 8) * 256 + c;
                        u32x4 w; w.x = cvt_pk_bf16(v0[0], v0[1]); w.y = cvt_pk_bf16(v0[2], v0[3]); w.z = cvt_pk_bf16(v1[0], v1[1]); w.w = cvt_pk_bf16(v1[2], v1[3]);
                        *(u32x4*)dst = w;
                    } else {
                        const int dir = (pn - 12) >> 1, gc = ((pn - 12) & 1) * 256 + c;
                        const f32x4 b0 = *(const LAS f32x4*)(lds + GB_OFF + (dir * 512 + gc) * 4), b1 = *(const LAS f32x4*)(lds + GB_OFF + (dir * 512 + gc + 4) * 4); f32x4 o0, o1;
#pragma unroll
                        for (int j = 0; j < 4; ++j) { const float z0 = v0[j] + b0[j], z1 = v1[j] + b1[j];
                            o0[j] = (fminf(z0, 0.f) - __logf(1.f + __expf(-fabsf(z0)))) * 0.0625f; o1[j] = (fminf(z1, 0.f) - __logf(1.f + __expf(-fabsf(z1)))) * 0.0625f; }
                        float* dst = (dir ? gb : gf) + (size_t)row * 512 + gc; *(f32x4*)dst = o0; *(f32x4*)(dst + 4) = o1;
                    } } }
    }
};
struct EpiAttnIn { static constexpr bool PERM = true;
    bf16_t *q, *k, *v; const float* ssq; ldsp lds;
    __device__ __forceinline__ void operator()(const AccT& acc, const pg8::Unit& u, int wr, int wc, int fr, int fq) const {
        const int row0 = u.pm * 256 + wr * 64 + fr, cin0 = wc * 32 + 8 * fq, pn = u.pn;
        float rs[8]; rstd_rows(lds, ssq, u.pm, 0, wr, fr, rs);
#pragma unroll
        for (int ai = 0; ai < 2; ++ai)
#pragma unroll
            for (int m = 0; m < 4; ++m) { const int row = row0 + ai * 128 + m * 16; const float s = rs[ai * 4 + m];
#pragma unroll
                for (int bj = 0; bj < 2; ++bj) { const int c = cin0 + 128 * bj; const f32x4 v0 = acc[ai][bj][m][0] * s, v1 = acc[ai][bj][m][1] * s;
                    bf16_t* dst = (pn < 4) ? q + (size_t)row * 1024 + pn * 256 + c : (pn == 4 ? k + (size_t)row * 256 + c : v + (size_t)row * 256 + c);
                    u32x4 w; w.x = cvt_pk_bf16(v0[0], v0[1]); w.y = cvt_pk_bf16(v0[2], v0[3]); w.z = cvt_pk_bf16(v1[0], v1[1]); w.w = cvt_pk_bf16(v1[2], v1[3]);
                    *(u32x4*)dst = w; } }
    }
};

template <class F>
__device__ __forceinline__ void xpose_tiles(ldsp lds, int K, int N, F val, bf16_t* dst, int rmode, int rbase) {
    LAS float* T = (LAS float*)lds; const int tid = get_tid(), nkt = K / 64, nnt = N / 64;
    for (int t = blockIdx.x; t < nkt * nnt; t += gridDim.x) {
        const int kt = t % nkt, ntl = t / nkt, k0 = kt * 64, n0 = ntl * 64;
        { const int kr = tid >> 4, nc = (tid & 15) * 4; const f32x4 v0 = val(k0 + kr, n0 + nc), v1 = val(k0 + kr + 32, n0 + nc);
            T[kr * 65 + nc] = v0[0]; T[kr * 65 + nc + 1] = v0[1]; T[kr * 65 + nc + 2] = v0[2]; T[kr * 65 + nc + 3] = v0[3];
            T[(kr + 32) * 65 + nc] = v1[0]; T[(kr + 32) * 65 + nc + 1] = v1[1]; T[(kr + 32) * 65 + nc + 2] = v1[2]; T[(kr + 32) * 65 + nc + 3] = v1[3]; }
        __syncthreads();
        { const int n = tid >> 3, k8 = (tid & 7) * 8; float x[8];
#pragma unroll
            for (int j = 0; j < 8; ++j) x[j] = T[(k8 + j) * 65 + n];
            const int gn = n0 + n, dr = (rmode ? ((gn >> 7) * 256 + (gn & 127)) : gn) + rbase;
            u32x4 w; w.x = cvt_pk_bf16(x[0], x[1]); w.y = cvt_pk_bf16(x[2], x[3]); w.z = cvt_pk_bf16(x[4], x[5]); w.w = cvt_pk_bf16(x[6], x[7]);
            *(u32x4*)(dst + (size_t)dr * K + k0 + k8) = w; }
        __syncthreads();
    }
}
struct ValPlain { const float* src; int ld;
    __device__ __forceinline__ f32x4 operator()(int k, int n) const { return *(const f32x4*)(src + (size_t)k * ld + n); } };
struct ValGain { const float* src; int ld; const float* gain;
    __device__ __forceinline__ f32x4 operator()(int k, int n) const { const f32x4 v = *(const f32x4*)(src + (size_t)k * ld + n); return v * gain[k]; } };
struct ValGate { const float* w1; const float* w2; const float* gain;
    __device__ __forceinline__ f32x4 operator()(int k, int n) const { f32x4 a = {0.f, 0.f, 0.f, 0.f};
#pragma unroll
        for (int r = 0; r < 16; ++r) a += w1[k * 16 + r] * *(const f32x4*)(w2 + r * 512 + n);
        return a * gain[k]; } };

__device__ __forceinline__ void phase_prep(const Params& p, ldsp lds) {
    unsigned char* ws = p.ws; const int tid = get_tid(), lane = tid & 63, wid = tid >> 6;
    float* ssq = (float*)(ws + WS_SSQ); bf16_t* hb = (bf16_t*)(ws + WS_HB);
    for (int rp = blockIdx.x * 8 + wid; rp < MROWS / 2; rp += gridDim.x * 8) {
        f32x4 v[2][4];
#pragma unroll
        for (int k = 0; k < 2; ++k) { const int r = rp * 2 + k; const float* src = (r < R0) ? p.in[1] + (size_t)(r & 15) * DM : p.in[0] + (size_t)(r - R0) * DM;
#pragma unroll
            for (int i = 0; i < 4; ++i) v[k][i] = __builtin_nontemporal_load((const f32x4*)(src + i * 256 + lane * 4)); }
#pragma unroll
        for (int k = 0; k < 2; ++k) { const int r = rp * 2 + k; float ss = 0.f;
#pragma unroll
            for (int i = 0; i < 4; ++i) { const f32x4 x = v[k][i]; u32x2 w; w.x = cvt_pk_bf16(x[0], x[1]); w.y = cvt_pk_bf16(x[2], x[3]); *(u32x2*)(hb + (size_t)r * DM + i * 256 + lane * 4) = w;
                ss += (x[0] * x[0] + x[1] * x[1]) + (x[2] * x[2] + x[3] * x[3]); }
#pragma unroll
            for (int o = 32; o >= 1; o >>= 1) ss += __shfl_xor(ss, o);
            if (lane < 16) ssq[(size_t)r * 16 + lane] = lane == 0 ? ss : 0.f; }
    }
    for (int f = 0; f < 4; ++f) { const int li = f >> 1; const bool second = f & 1;
        const float* wg = p.in[second ? 18 : 3] + (size_t)li * DM * FF; const float* wu = p.in[second ? 19 : 4] + (size_t)li * DM * FF;
        const float* wd = p.in[second ? 20 : 5] + (size_t)li * FF * DM; const float* gn = p.in[second ? 17 : 2] + li * DM;
        bf16_t* dgu = (bf16_t*)(ws + WS_WGU + f * SZ_WGU); bf16_t* dd = (bf16_t*)(ws + WS_WD + f * SZ_WD);
        xpose_tiles(lds, DM, FF, ValGain{wg, FF, gn}, dgu, 1, 0);
        xpose_tiles(lds, DM, FF, ValGain{wu, FF, gn}, dgu, 1, 128);
        xpose_tiles(lds, FF, DM, ValPlain{wd, DM}, dd, 0, 0);
    }
    xpose_tiles(lds, DM, 3072, ValGain{p.in[7], 3072, p.in[6]}, (bf16_t*)(ws + WS_WGIN), 0, 0);
    xpose_tiles(lds, DM, 512, ValGate{p.in[8], p.in[9], p.in[6]}, (bf16_t*)(ws + WS_WGIN), 0, 3072);
    xpose_tiles(lds, DM, 512, ValGate{p.in[8] + DM * 16, p.in[9] + 16 * 512, p.in[6]}, (bf16_t*)(ws + WS_WGIN), 0, 3584);
    xpose_tiles(lds, DM, DM, ValPlain{p.in[12], DM}, (bf16_t*)(ws + WS_WGOUT), 0, 0);
    xpose_tiles(lds, DM, 1536, ValGain{p.in[13], 1536, p.in[6] + DM}, (bf16_t*)(ws + WS_WAIN), 0, 0);
    xpose_tiles(lds, DM, DM, ValPlain{p.in[16], DM}, (bf16_t*)(ws + WS_WAOUT), 0, 0);
}

__device__ __forceinline__ int gla_row(int b, int c, int to) { return c == 0 ? (to >= 48 ? b * 16 + (to - 48) : -1) : R0 + b * SEQ + (c - 1) * 64 + to; }
__device__ __forceinline__ bf16x8 ld8(ldsp base, int off) { return *(const LAS bf16x8*)(base + off); }

__device__ __forceinline__ void phase_gla_seq(const Params& p, ldsp lds) {
    constexpr int PBF = 528, PQ = 272, PT = 144;
    constexpr int OFF_BF = 0, OFF_QD = 33792, OFF_KI = OFF_QD + 17408, OFF_KET = OFF_KI + 17408, OFF_VT = OFF_KET + 18432, OFF_AM = OFF_VT + 18432,
                  OFF_ST = OFF_AM + 9216, OFF_PART = OFF_ST + 34816, OFF_DEC = OFF_PART + 2048;
    static_assert(OFF_DEC + 512 <= LDS_BYTES, "gla lds");
    unsigned char* ws = p.ws;
    const bf16_t* qb = (const bf16_t*)((unsigned char*)p.out + O_GQ); const bf16_t* kb = (const bf16_t*)(ws + U_GK); const bf16_t* vb = (const bf16_t*)(ws + U_GV);
    const float* gfp = (const float*)((unsigned char*)p.out + O_GF); const float* gbp = (const float*)(ws + U_GB);
    const int tid = get_tid(), lane = tid & 63, wid = __builtin_amdgcn_readfirstlane(tid >> 6), fr = lane & 15, fq = lane >> 4;
    const int dcol = tid & 127, qtr = tid >> 7;
    const int trow = tid >> 3, seg = tid & 7;
    for (int it = blockIdx.x; it < 256; it += gridDim.x) {
        const int item = (gridDim.x == 256) ? ((it & 7) * 32 + (it >> 3)) : it;
        const int vp = item & 1, dir = (item >> 1) & 1, hd = (item >> 2) & 3, b = item >> 4;
        bf16_t* obuf = (bf16_t*)(ws + WS_H) + (size_t)dir * MROWS * 1024;
        const float* gsrc = dir ? gbp : gfp;
        const unsigned colo = (unsigned)(qtr * 16) * 2048u + (unsigned)dcol * 4u, rowo = (unsigned)trow * 1024u + (unsigned)seg * 32u, rowv = (unsigned)trow * 2048u + (unsigned)seg * 32u;
        float gcol[16]; u32x4 rq0, rq1, rk0, rk1, rv0, rv1;
        f32x4 accS[8];
#define GLA_LOAD_SLOW(c_) do { \
        _Pragma("unroll") for (int i = 0; i < 16; ++i) { const int r_ = gla_row(b, (c_), qtr * 16 + i); \
            gcol[i] = r_ >= 0 ? gsrc[(size_t)r_ * 512 + hd * 128 + dcol] : 0.f; } \
        { const int r_ = gla_row(b, (c_), trow); const u32x4 z_ = {0u, 0u, 0u, 0u}; \
          if (r_ >= 0) { const bf16_t* qp_ = qb + (size_t)r_ * 512 + hd * 128 + seg * 16; const bf16_t* kp_ = kb + (size_t)r_ * 512 + hd * 128 + seg * 16; const bf16_t* vp_ = vb + (size_t)r_ * 1024 + hd * 256 + vp * 128 + seg * 16; \
              rq0 = *(const u32x4*)qp_; rq1 = *(const u32x4*)(qp_ + 8); rk0 = *(const u32x4*)kp_; rk1 = *(const u32x4*)(kp_ + 8); rv0 = *(const u32x4*)vp_; rv1 = *(const u32x4*)(vp_ + 8); } \
          else { rq0 = z_; rq1 = z_; rk0 = z_; rk1 = z_; rv0 = z_; rv1 = z_; } } } while (0)
#define GLA_LOAD_FAST(c_) do { const size_t rb_ = (size_t)R0 + (size_t)b * SEQ + (size_t)((c_) - 1) * 64; \
        unsigned colo_ = colo, rowo_ = rowo; asm volatile("" : "+v"(colo_), "+v"(rowo_));     \
        { const char* gB_ = (const char*)(gsrc + rb_ * 512 + hd * 128); \
          _Pragma("unroll") for (int i = 0; i < 16; ++i) gcol[i] = *(const float*)(gB_ + (colo_ + (unsigned)i * 2048u)); } \
        { const char* qB_ = (const char*)(qb + rb_ * 512 + hd * 128); const char* kB_ = (const char*)(kb + rb_ * 512 + hd * 128); const char* vB_ = (const char*)(vb + rb_ * 1024 + hd * 256 + vp * 128); \
          rq0 = *(const u32x4*)(qB_ + rowo_); rq1 = *(const u32x4*)(qB_ + rowo_ + 16u); rk0 = *(const u32x4*)(kB_ + rowo_); rk1 = *(const u32x4*)(kB_ + rowo_ + 16u); \
          rv0 = *(const u32x4*)(vB_ + rowv); rv1 = *(const u32x4*)(vB_ + rowv + 16u); } } while (0)
#define GLA_LOAD(c_) do { if ((c_) != 0) GLA_LOAD_FAST(c_); else GLA_LOAD_SLOW(c_); } while (0)
        GLA_LOAD(dir ? 64 : 0);
#pragma unroll
        for (int i = 0; i < 8; ++i) accS[i] = (f32x4){0.f, 0.f, 0.f, 0.f};
        for (int i = tid; i < 34816 / 4; i += 512) *(LAS unsigned*)(lds + OFF_ST + i * 4) = 0u;
        for (int ci = 0; ci < 65; ++ci) {
            const int c = dir ? 64 - ci : ci;
            float bl[16]; float run = 0.f;
            if (dir == 0) {
#pragma unroll
                for (int i = 0; i < 16; ++i) { run += gcol[i]; bl[i] = run; }
            } else {
#pragma unroll
                for (int i = 15; i >= 0; --i) { run += gcol[i]; bl[i] = run; }
            }
            *(LAS float*)(lds + OFF_PART + (qtr * 128 + dcol) * 4) = run;
            { const unsigned vw[8] = {rv0.x, rv0.y, rv0.z, rv0.w, rv1.x, rv1.y, rv1.z, rv1.w};
#pragma unroll
              for (int i = 0; i < 8; ++i) { const int vv = seg * 16 + 2 * i; const int vts = (((trow >> 3) ^ ((vv >> 3) & 7)) << 4) + (trow & 7) * 2;
                  *(LAS bf16_t*)(lds + OFF_VT + vv * PT + vts) = (bf16_t)(vw[i] & 0xffffu); *(LAS bf16_t*)(lds + OFF_VT + (vv + 1) * PT + vts) = (bf16_t)(vw[i] >> 16); } }
            __syncthreads();
            float offp = 0.f, tot = 0.f;
#pragma unroll
            for (int q2 = 0; q2 < 4; ++q2) { const float pv = *(LAS float*)(lds + OFF_PART + (q2 * 128 + dcol) * 4); tot += pv; if (dir ? (q2 > qtr) : (q2 < qtr)) offp += pv; }
#pragma unroll
            for (int i = 0; i < 16; ++i) *(LAS float*)(lds + OFF_BF + (qtr * 16 + i) * PBF + dcol * 4) = bl[i] + offp;
            if (qtr == 0) *(LAS float*)(lds + OFF_DEC + dcol * 4) = fast_exp(tot);
            __syncthreads();
            { const unsigned qw[8] = {rq0.x, rq0.y, rq0.z, rq0.w, rq1.x, rq1.y, rq1.z, rq1.w}, kw[8] = {rk0.x, rk0.y, rk0.z, rk0.w, rk1.x, rk1.y, rk1.z, rk1.w};
              unsigned qo[8], ko[8]; const int kts = (((trow >> 3) ^ seg) << 4) + (trow & 7) * 2;
#pragma unroll
              for (int i = 0; i < 4; ++i) { const f32x4 bv = *(const LAS f32x4*)(lds + OFF_BF + trow * PBF + (seg * 16 + i * 4) * 4); const f32x4 dc = *(const LAS f32x4*)(lds + OFF_DEC + (seg * 16 + i * 4) * 4);
#pragma unroll
                  for (int j = 0; j < 2; ++j) { const float e0 = fast_exp(bv[2 * j]), e1 = fast_exp(bv[2 * j + 1]); const unsigned qq = qw[i * 2 + j], kk = kw[i * 2 + j];
                      const float k0 = bflo(kk) * __builtin_amdgcn_rcpf(e0), k1 = bfhi(kk) * __builtin_amdgcn_rcpf(e1);
                      qo[i * 2 + j] = cvt_pk_bf16(bflo(qq) * e0, bfhi(qq) * e1); ko[i * 2 + j] = cvt_pk_bf16(k0, k1);
                      const unsigned kew = cvt_pk_bf16(k0 * dc[2 * j], k1 * dc[2 * j + 1]); const int d = seg * 16 + i * 4 + 2 * j;
                      *(LAS bf16_t*)(lds + OFF_KET + d * PT + kts) = (bf16_t)(kew & 0xffffu); *(LAS bf16_t*)(lds + OFF_KET + (d + 1) * PT + kts) = (bf16_t)(kew >> 16); } }
              *(LAS u32x4*)(lds + OFF_QD + trow * PQ + seg * 32) = (u32x4){qo[0], qo[1], qo[2], qo[3]}; *(LAS u32x4*)(lds + OFF_QD + trow * PQ + seg * 32 + 16) = (u32x4){qo[4], qo[5], qo[6], qo[7]};
              *(LAS u32x4*)(lds + OFF_KI + trow * PQ + seg * 32) = (u32x4){ko[0], ko[1], ko[2], ko[3]}; *(LAS u32x4*)(lds + OFF_KI + trow * PQ + seg * 32 + 16) = (u32x4){ko[4], ko[5], ko[6], ko[7]}; }
            if (ci + 1 < 65) { const int c2 = dir ? 63 - ci : ci + 1; GLA_LOAD(c2); }
            __syncthreads();
#pragma unroll
            for (int xx = 0; xx < 2; ++xx) { const int x = 2 * wid + xx, si = x >> 2, ti = x & 3; f32x4 a4 = {0.f, 0.f, 0.f, 0.f};
                if (dir ? (si >= ti) : (si <= ti)) {
#pragma unroll
                    for (int kk = 0; kk < 4; ++kk) a4 = __builtin_amdgcn_mfma_f32_16x16x32_bf16(ld8(lds, OFF_KI + (si * 16 + fr) * PQ + kk * 64 + fq * 16), ld8(lds, OFF_QD + (ti * 16 + fr) * PQ + kk * 64 + fq * 16), a4, 0, 0, 0);
#pragma unroll
                    for (int i = 0; i < 4; ++i) { const int sd = si * 16 + 4 * fq + i - (ti * 16 + fr); if (dir ? (sd < 0) : (sd > 0)) a4[i] = 0.f; }
                }
                u32x2 w; w.x = cvt_pk_bf16(a4[0], a4[1]); w.y = cvt_pk_bf16(a4[2], a4[3]);
                *(LAS u32x2*)(lds + OFF_AM + (ti * 16 + fr) * PT + (si * 16 + 4 * fq) * 2) = w; }
            __syncthreads();
            { const int vsw = (2 * wid + (fr >> 3)) & 7; bf16x8 fv[2], fs[4];
#pragma unroll
              for (int kk = 0; kk < 2; ++kk) fv[kk] = ld8(lds, OFF_VT + (wid * 16 + fr) * PT + (((kk * 4 + fq) ^ vsw) << 4));
#pragma unroll
              for (int kk = 0; kk < 4; ++kk) fs[kk] = ld8(lds, OFF_ST + (wid * 16 + fr) * PQ + kk * 64 + fq * 16);
#pragma unroll
              for (int ti = 0; ti < 4; ++ti) { f32x4 a4 = {0.f, 0.f, 0.f, 0.f};
#pragma unroll
                  for (int kk = 0; kk < 2; ++kk) a4 = __builtin_amdgcn_mfma_f32_16x16x32_bf16(fv[kk], ld8(lds, OFF_AM + (ti * 16 + fr) * PT + kk * 64 + fq * 16), a4, 0, 0, 0);
#pragma unroll
                  for (int kk = 0; kk < 4; ++kk) a4 = __builtin_amdgcn_mfma_f32_16x16x32_bf16(fs[kk], ld8(lds, OFF_QD + (ti * 16 + fr) * PQ + kk * 64 + fq * 16), a4, 0, 0, 0);
                  const int r = gla_row(b, c, ti * 16 + fr);
                  if (r >= 0) { u32x2 w; w.x = cvt_pk_bf16(a4[0], a4[1]); w.y = cvt_pk_bf16(a4[2], a4[3]); *(u32x2*)(obuf + (size_t)r * 1024 + hd * 256 + vp * 128 + wid * 16 + 4 * fq) = w; } } }
            __syncthreads();
            { const f32x4 dc = *(const LAS f32x4*)(lds + OFF_DEC + (16 * wid + 4 * fq) * 4); bf16x8 fk[2];
#pragma unroll
              for (int kk = 0; kk < 2; ++kk) fk[kk] = ld8(lds, OFF_KET + (16 * wid + fr) * PT + (((kk * 4 + fq) ^ (wid & 7)) << 4));
#pragma unroll
              for (int vbk = 0; vbk < 8; ++vbk) { accS[vbk] = accS[vbk] * dc; const int vsw = (2 * vbk + (fr >> 3)) & 7;
#pragma unroll
                  for (int kk = 0; kk < 2; ++kk) accS[vbk] = __builtin_amdgcn_mfma_f32_16x16x32_bf16(fk[kk], ld8(lds, OFF_VT + (vbk * 16 + fr) * PT + (((kk * 4 + fq) ^ vsw) << 4)), accS[vbk], 0, 0, 0);
                  u32x2 w; w.x = cvt_pk_bf16(accS[vbk][0], accS[vbk][1]); w.y = cvt_pk_bf16(accS[vbk][2], accS[vbk][3]);
                  *(LAS u32x2*)(lds + OFF_ST + (vbk * 16 + fr) * PQ + (16 * wid + 4 * fq) * 2) = w; } }
            __syncthreads();
        }
#undef GLA_LOAD
#undef GLA_LOAD_FAST
#undef GLA_LOAD_SLOW
    }
}

__device__ __forceinline__ void phase_gla_post(const Params& p) {
    unsigned char* ws = p.ws; const bf16_t* o = (const bf16_t*)(ws + WS_H); const bf16_t* ob = o + (size_t)MROWS * 1024; const bf16_t* r = (const bf16_t*)(ws + U_GR); bf16_t* og = (bf16_t*)(ws + U_GV);
    const float* hn = p.in[11]; const int tid = get_tid(), lane = tid & 63, wid = tid >> 6;
    float g[16];
#pragma unroll
    for (int i = 0; i < 16; ++i) g[i] = hn[(lane & 15) * 16 + i];
    for (int row = blockIdx.x * 8 + wid; row < MROWS; row += gridDim.x * 8) {
        const size_t off = (size_t)row * 1024 + lane * 16;
        const u32x4 o0 = *(const u32x4*)(o + off), o1 = *(const u32x4*)(o + off + 8), p0 = *(const u32x4*)(ob + off), p1 = *(const u32x4*)(ob + off + 8), r0 = *(const u32x4*)(r + off), r1 = *(const u32x4*)(r + off + 8);
        const unsigned ow[8] = {o0.x, o0.y, o0.z, o0.w, o1.x, o1.y, o1.z, o1.w}, pw[8] = {p0.x, p0.y, p0.z, p0.w, p1.x, p1.y, p1.z, p1.w}, rw[8] = {r0.x, r0.y, r0.z, r0.w, r1.x, r1.y, r1.z, r1.w};
        float x[16]; float ss = 0.f;
#pragma unroll
        for (int i = 0; i < 8; ++i) { x[2 * i] = bflo(ow[i]) + bflo(pw[i]); x[2 * i + 1] = bfhi(ow[i]) + bfhi(pw[i]); ss += x[2 * i] * x[2 * i] + x[2 * i + 1] * x[2 * i + 1]; }
        ss += __shfl_xor(ss, 1); ss += __shfl_xor(ss, 2); ss += __shfl_xor(ss, 4); ss += __shfl_xor(ss, 8);
        const float rs = rsqrtf(ss * (1.f / 256.f) + EPS); unsigned w[8];
#pragma unroll
        for (int i = 0; i < 8; ++i) w[i] = cvt_pk_bf16(x[2 * i] * rs * g[2 * i] * silu_f(bflo(rw[i])), x[2 * i + 1] * rs * g[2 * i + 1] * silu_f(bfhi(rw[i])));
        *(u32x4*)(og + off) = (u32x4){w[0], w[1], w[2], w[3]}; *(u32x4*)(og + off + 8) = (u32x4){w[4], w[5], w[6], w[7]};
    }
}

__device__ __forceinline__ void attn_prep_head(bf16_t* base, int pos, bool real, int ax, int ic, const float* gn) {
    const int d0 = ax * 64 + ic * 8;
    const u32x4 wa = *(const u32x4*)(base + d0), wb = *(const u32x4*)(base + d0 + 32);
    const unsigned aw[4] = {wa.x, wa.y, wa.z, wa.w}, bw[4] = {wb.x, wb.y, wb.z, wb.w};
    float xa[8], xb[8]; float ss = 0.f;
#pragma unroll
    for (int j = 0; j < 4; ++j) { xa[2 * j] = bflo(aw[j]); xa[2 * j + 1] = bfhi(aw[j]); xb[2 * j] = bflo(bw[j]); xb[2 * j + 1] = bfhi(bw[j]); }
#pragma unroll
    for (int j = 0; j < 8; ++j) ss += xa[j] * xa[j] + xb[j] * xb[j];
    ss += __shfl_xor(ss, 1); ss += __shfl_xor(ss, 2); ss += __shfl_xor(ss, 4);
    const float rs = rsqrtf(ss * (1.f / 128.f) + EPS);
    const float t = real ? (float)(ax ? (pos & 63) : (pos >> 6)) : 0.f;
    const f32x4 ga0 = *(const f32x4*)(gn + d0), ga1 = *(const f32x4*)(gn + d0 + 4), gb0 = *(const f32x4*)(gn + d0 + 32), gb1 = *(const f32x4*)(gn + d0 + 36);
    float oa[8], ob[8];
#pragma unroll
    for (int j = 0; j < 8; ++j) { const float invf = __builtin_amdgcn_exp2f(-(float)(ic * 8 + j) * (2.0f / 64.0f) * 13.287712379549449f);
        float rev = t * invf * 0.15915494309189535f; rev -= floorf(rev);
        const float sn = __builtin_amdgcn_sinf(rev), cs = __builtin_amdgcn_cosf(rev);
        const float ya = xa[j] * rs * (j < 4 ? ga0[j & 3] : ga1[j & 3]), yb = xb[j] * rs * (j < 4 ? gb0[j & 3] : gb1[j & 3]);
        oa[j] = ya * cs - yb * sn; ob[j] = yb * cs + ya * sn; }
    *(u32x4*)(base + d0) = (u32x4){cvt_pk_bf16(oa[0], oa[1]), cvt_pk_bf16(oa[2], oa[3]), cvt_pk_bf16(oa[4], oa[5]), cvt_pk_bf16(oa[6], oa[7])};
    *(u32x4*)(base + d0 + 32) = (u32x4){cvt_pk_bf16(ob[0], ob[1]), cvt_pk_bf16(ob[2], ob[3]), cvt_pk_bf16(ob[4], ob[5]), cvt_pk_bf16(ob[6], ob[7])};
}
__device__ __forceinline__ void phase_attn_prep(const Params& p) {
    unsigned char* ws = p.ws; bf16_t* k = (bf16_t*)(ws + U_AK);
    const float* kn = p.in[15]; const int tid = get_tid(), lane = tid & 63, wid = tid >> 6;
    const int sub = lane & 7, ax = sub >> 2, ic = sub & 3, hl = lane >> 3;
    for (int r4 = blockIdx.x * 8 + wid; r4 < MROWS / 4; r4 += gridDim.x * 8) { const int row = r4 * 4 + (hl >> 1);
        attn_prep_head(k + (size_t)row * 256 + (hl & 1) * 128, (row - R0) & 4095, row >= R0, ax, ic, kn); }
}

__device__ __forceinline__ void phase_final(const Params& p) {
    unsigned char* ws = p.ws; const bf16_t* hb = (const bf16_t*)(ws + WS_HB); const float* ssq = (const float*)(ws + WS_SSQ) + 6 * (size_t)MROWS * 16; const float* gn = p.in[21];
    const int tid = get_tid(), lane = tid & 63, wid = tid >> 6;
    f32x4 g[4];
#pragma unroll
    for (int i = 0; i < 4; ++i) g[i] = *(const f32x4*)(gn + i * 256 + lane * 4);
    float pofs = 0.f;
    if (TPROBE_MASK) pofs = sqrtf(*(const float*)(ws + WS_NEED) * 1e-8f);
    for (int rq = blockIdx.x * 8 + wid; rq < (MROWS - R0) / 4; rq += gridDim.x * 8) {
        u32x2 w[4][4]; float sr[4];
#pragma unroll
        for (int k = 0; k < 4; ++k) { const int row = R0 + rq * 4 + k;
#pragma unroll
            for (int i = 0; i < 4; ++i) w[k][i] = *(const u32x2*)(hb + (size_t)row * DM + i * 256 + lane * 4);
            sr[k] = row_rstd(ssq, row); }
#pragma unroll
        for (int k = 0; k < 4; ++k) { const int row = R0 + rq * 4 + k;
#pragma unroll
            for (int i = 0; i < 4; ++i) { const f32x4 v = {bflo(w[k][i].x), bfhi(w[k][i].x), bflo(w[k][i].y), bfhi(w[k][i].y)};
                __builtin_nontemporal_store(v * sr[k] * g[i] + pofs, (f32x4*)(p.out + (size_t)(row - R0) * DM + i * 256 + lane * 4)); } }
    }
}

namespace att {
constexpr int D = 128, KVBLK = 64, LDQ = 1024, LDK = 256, LDO = 1024;
constexpr float SCALE = 0.088388347648318440f, THR = 8.f;
constexpr size_t SHM_V = KVBLK * D * 2, SHM_K = KVBLK * D * 2, SHM_ATTN = 2 * SHM_V + 2 * SHM_K + 8 * 64 * 4;
#define KSWZ(row, colB) ((row) * 256 + ((colB) ^ (((row) & 7) << 4)))
#define SBAR() __builtin_amdgcn_sched_barrier(0)
__device__ __forceinline__ int crow(int r, int hi) { return (r & 3) + 8 * (r >> 2) + 4 * hi; }
__device__ __forceinline__ void partialSM(f32x16& p0, f32x16& p1, float& m_reg, float& mn, float& alpha) {
  constexpr float C = SCALE * 1.4426950408889634f;
  float pmax = p0[0]; for (int r = 1; r < 16; ++r) pmax = fmaxf(pmax, p0[r]); for (int r = 0; r < 16; ++r) pmax = fmaxf(pmax, p1[r]);
  { auto rr = __builtin_amdgcn_permlane32_swap(__float_as_uint(pmax), __float_as_uint(pmax), false, false);
    pmax = fmaxf(__uint_as_float(rr[0]), __uint_as_float(rr[1])); }
  if (__builtin_expect(__all(pmax - m_reg <= THR / SCALE), 1)) { mn = m_reg; alpha = 1.f; }
  else { mn = fmaxf(m_reg, pmax); alpha = __builtin_amdgcn_exp2f((m_reg - mn) * C); m_reg = mn; }
  float mnC = -mn * C;
  for (int r = 0; r < 16; ++r) p0[r] = fmaf(p0[r], C, mnC); for (int r = 0; r < 16; ++r) p1[r] = fmaf(p1[r], C, mnC);
  for (int r = 0; r < 16; ++r) p0[r] = __builtin_amdgcn_exp2f(p0[r]);
}
__device__ __forceinline__ void finishSM(f32x16& p0, f32x16& p1, float alpha, float& l_reg, bf16x8& pa0, bf16x8& pa1, bf16x8& pa2, bf16x8& pa3) {
  for (int r = 0; r < 16; ++r) p1[r] = __builtin_amdgcn_exp2f(p1[r]);
  float ps = 0; for (int r = 0; r < 16; ++r) ps += p0[r]; for (int r = 0; r < 16; ++r) ps += p1[r];
  { auto rr = __builtin_amdgcn_permlane32_swap(__float_as_uint(ps), __float_as_uint(ps), false, false);
    ps = __uint_as_float(rr[0]) + __uint_as_float(rr[1]); }
  l_reg = l_reg * alpha + ps;
#define PK4(P, BASE, OUT) do { unsigned a0 = cvt_pk_bf16(P[BASE + 0], P[BASE + 1]), a1 = cvt_pk_bf16(P[BASE + 2], P[BASE + 3]);   \
    unsigned b0 = cvt_pk_bf16(P[BASE + 4], P[BASE + 5]), b1 = cvt_pk_bf16(P[BASE + 6], P[BASE + 7]);                              \
    auto r0 = __builtin_amdgcn_permlane32_swap(a0, b0, false, false); auto r1 = __builtin_amdgcn_permlane32_swap(a1, b1, false, false); \
    u32x4 w = {r0[0], r1[0], r0[1], r1[1]}; OUT = *reinterpret_cast<bf16x8*>(&w); } while (0)
  PK4(p0, 0, pa0); PK4(p0, 8, pa1); PK4(p1, 0, pa2); PK4(p1, 8, pa3);
#undef PK4
}
__device__ __forceinline__ void qkt(f32x16& p0, f32x16& p1, const char* Ks, const bf16x8* qr, int r32, int hi) {
  p0 = f32x16{}; p1 = f32x16{};
  for (int d0 = 0; d0 < 8; ++d0) { int cb = (d0 * 16 + hi * 8) * 2;
    bf16x8 b0 = *reinterpret_cast<const bf16x8*>(Ks + KSWZ(r32, cb));
    bf16x8 b1 = *reinterpret_cast<const bf16x8*>(Ks + KSWZ(32 + r32, cb));
    p0 = __builtin_amdgcn_mfma_f32_32x32x16_bf16(b0, qr[d0], p0, 0, 0, 0);
    p1 = __builtin_amdgcn_mfma_f32_32x32x16_bf16(b1, qr[d0], p1, 0, 0, 0); }
}
__device__ __forceinline__ int v_st(int k, int c) { const int kk = (k & ~0xC) | ((k & 4) << 1) | ((k & 8) >> 1); return ((kk >> 3) * 4 + (c >> 5)) * 512 + ((kk & 7) * 32 + (c & 31)) * 2; }
__device__ __forceinline__ int v_rd_base(int lane) { return ((lane & 3) << 3) | (((lane >> 2) & 3) << 6) | (((lane >> 4) & 1) << 5) | (((lane >> 5) & 1) << 8); }
constexpr int v_rd_off(int d0, int ks, int half) { return d0 * 512 + ks * 4096 + half * 2048; }
template <int OFF> __device__ __forceinline__ s16x4 tr_read(int vb) {
  s16x4 r; asm volatile("ds_read_b64_tr_b16 %0, %1 offset:%2" : "=&v"(r) : "v"(vb), "i"(OFF) : "memory"); return r;
}
template <int D0> __device__ __forceinline__ void pv_one(f32x16& od, int vb, bf16x8 pa0, bf16x8 pa1, bf16x8 pa2, bf16x8 pa3) {
  const s16x4 l0 = tr_read<v_rd_off(D0, 0, 0)>(vb), h0 = tr_read<v_rd_off(D0, 0, 1)>(vb), l1 = tr_read<v_rd_off(D0, 1, 0)>(vb), h1 = tr_read<v_rd_off(D0, 1, 1)>(vb);
  const s16x4 l2 = tr_read<v_rd_off(D0, 2, 0)>(vb), h2 = tr_read<v_rd_off(D0, 2, 1)>(vb), l3 = tr_read<v_rd_off(D0, 3, 0)>(vb), h3 = tr_read<v_rd_off(D0, 3, 1)>(vb);
  asm volatile("s_waitcnt lgkmcnt(0)" ::: "memory"); SBAR();
#define PK(L, H) (bf16x8){L[0], L[1], L[2], L[3], H[0], H[1], H[2], H[3]}
  od = __builtin_amdgcn_mfma_f32_32x32x16_bf16(pa0, PK(l0, h0), od, 0, 0, 0);
  od = __builtin_amdgcn_mfma_f32_32x32x16_bf16(pa1, PK(l1, h1), od, 0, 0, 0);
  od = __builtin_amdgcn_mfma_f32_32x32x16_bf16(pa2, PK(l2, h2), od, 0, 0, 0);
  od = __builtin_amdgcn_mfma_f32_32x32x16_bf16(pa3, PK(l3, h3), od, 0, 0, 0);
#undef PK
}
__device__ __forceinline__ void pv_d0(f32x16* o, int vb, bf16x8 pa0, bf16x8 pa1, bf16x8 pa2, bf16x8 pa3) {
  pv_one<0>(o[0], vb, pa0, pa1, pa2, pa3); pv_one<1>(o[1], vb, pa0, pa1, pa2, pa3); pv_one<2>(o[2], vb, pa0, pa1, pa2, pa3); pv_one<3>(o[3], vb, pa0, pa1, pa2, pa3);
}
__device__ __forceinline__ void attn_body(const bf16_t* Qb, const bf16_t* K0, const bf16_t* V0, const bf16_t* K1, const bf16_t* V1, bf16_t* Ob, char* lds, const float* qn, int qpos0) {
  constexpr int NT = 65;
  const int tid = get_tid(), wid = tid >> 6, lane = tid & 63, r32 = lane & 31, hi = lane >> 5;
  char* V_lds = lds; char* K_lds = lds + 2 * SHM_V;
  float* wsf = (float*)(lds + 2 * SHM_V + 2 * SHM_K) + wid * 64; float* li_l = wsf; float* al_l = wsf + 32;
  float m_reg = -1e30f, l_reg = 0; f32x16 o[4] = {}; bf16x8 qr[8];
  const bf16_t* Qw = Qb + (long)(wid * 32 + r32) * LDQ + hi * 8;
#pragma unroll
  for (int d0 = 0; d0 < 8; ++d0) qr[d0] = *reinterpret_cast<const bf16x8*>(Qw + d0 * 16);
  const int sr = tid >> 4, sc = (tid & 15) * 8, vst0 = v_st(sr, sc), vst1 = v_st(32 + sr, sc);
  const int vb0 = (int)(uintptr_t)V_lds + v_rd_base(lane);
  struct { bf16x8 vs0, vs1, ks0, ks1; } sr_[2];
#define TKP(T) ((T) == 0 ? K0 : K1 + (long)((T) - 1) * 64 * LDK)
#define TVP(T) ((T) == 0 ? V0 : V1 + (long)((T) - 1) * 64 * LDK)
#define SLOAD(i, T) do { const bf16_t* kp_ = TKP(T); const bf16_t* vp_ = TVP(T); \
    sr_[i].vs0 = *reinterpret_cast<const bf16x8*>(&vp_[(long)(sr) * LDK + sc]); sr_[i].vs1 = *reinterpret_cast<const bf16x8*>(&vp_[(long)(32 + sr) * LDK + sc]); \
    sr_[i].ks0 = *reinterpret_cast<const bf16x8*>(&kp_[(long)(sr) * LDK + sc]); sr_[i].ks1 = *reinterpret_cast<const bf16x8*>(&kp_[(long)(32 + sr) * LDK + sc]); } while (0)
#define SWRITE(b, i) do { *(bf16x8*)(V_lds + (b) * SHM_V + vst0) = sr_[i].vs0;          \
    *(bf16x8*)(V_lds + (b) * SHM_V + vst1) = sr_[i].vs1; int kc = sc * 2;               \
    *(bf16x8*)(K_lds + (b) * SHM_K + KSWZ(sr, kc)) = sr_[i].ks0;                       \
    *(bf16x8*)(K_lds + (b) * SHM_K + KSWZ(32 + sr, kc)) = sr_[i].ks1; } while (0)
#define SWAIT() asm volatile("s_waitcnt vmcnt(4)" ::: "memory")
#define RESC(a) do { if (__any((a) < 1.f)) { if (hi == 0) al_l[r32] = (a); asm volatile("s_waitcnt lgkmcnt(0)" ::: "memory"); \
    for (int d = 0; d < 4; ++d) for (int r = 0; r < 16; ++r) o[d][r] *= al_l[crow(r, hi)]; } } while (0)
  f32x16 pA0, pA1, pB0, pB1; float mnA, mnB, alA, alB; bf16x8 pa0, pa1, pa2, pa3;
  constexpr int SE = 0, SO = 1;
  SLOAD(SE, 0);
  { float ss = 0.f;
#pragma unroll
    for (int d0 = 0; d0 < 8; ++d0)
#pragma unroll
      for (int j = 0; j < 8; ++j) { const float x = bf2f((bf16_t)qr[d0][j]); ss += x * x; }
    ss += __shfl_xor(ss, 32);
    const float rs = rsqrtf(ss * (1.f / 128.f) + EPS);
    const int pos = (qpos0 + wid * 32 + r32) & 4095;
#pragma unroll
    for (int ax = 0; ax < 2; ++ax) { const float t = (float)(ax ? (pos & 63) : (pos >> 6));
#pragma unroll
      for (int bl = 0; bl < 2; ++bl) { const int da = ax * 4 + bl, db = da + 2; unsigned wa[4], wb[4];
        const f32x4 ga0 = *(const f32x4*)(qn + da * 16 + hi * 8), ga1 = *(const f32x4*)(qn + da * 16 + hi * 8 + 4), gb0 = *(const f32x4*)(qn + db * 16 + hi * 8), gb1 = *(const f32x4*)(qn + db * 16 + hi * 8 + 4);
#pragma unroll
        for (int jp = 0; jp < 4; ++jp) { float oa[2], ob[2];
#pragma unroll
          for (int jj = 0; jj < 2; ++jj) { const int j = jp * 2 + jj;
            const float invf = __builtin_amdgcn_exp2f(-(float)(bl * 16 + j) * (2.0f / 64.0f) * 13.287712379549449f) * __builtin_amdgcn_exp2f(-(float)hi * (16.0f / 64.0f) * 13.287712379549449f);
            float rev = t * invf * 0.15915494309189535f; rev -= floorf(rev);
            const float sn = __builtin_amdgcn_sinf(rev), cs = __builtin_amdgcn_cosf(rev);
            const float ya = bf2f((bf16_t)qr[da][j]) * rs * (j < 4 ? ga0[j & 3] : ga1[j & 3]), yb = bf2f((bf16_t)qr[db][j]) * rs * (j < 4 ? gb0[j & 3] : gb1[j & 3]);
            oa[jj] = ya * cs - yb * sn; ob[jj] = yb * cs + ya * sn; }
          wa[jp] = cvt_pk_bf16(oa[0], oa[1]); wb[jp] = cvt_pk_bf16(ob[0], ob[1]); }
        { u32x4 w = {wa[0], wa[1], wa[2], wa[3]}; qr[da] = *reinterpret_cast<bf16x8*>(&w); }
        { u32x4 w = {wb[0], wb[1], wb[2], wb[3]}; qr[db] = *reinterpret_cast<bf16x8*>(&w); } } }
  }
  asm volatile("s_waitcnt vmcnt(0)" ::: "memory"); SWRITE(0, SE); __syncthreads();
  qkt(pA0, pA1, K_lds, qr, r32, hi);
#pragma unroll
  for (int r = 8; r < 16; ++r) pA0[r] = -1e30f;
#pragma unroll
  for (int r = 0; r < 16; ++r) pA1[r] = -1e30f;
  partialSM(pA0, pA1, m_reg, mnA, alA);
  SLOAD(SO, 1); SLOAD(SE, 2);
  SWAIT(); SWRITE(1, SO); __syncthreads();
  for (int j = 1; j + 1 < NT; j += 2) {
    SBAR(); qkt(pB0, pB1, K_lds + SHM_K, qr, r32, hi);
    finishSM(pA0, pA1, alA, l_reg, pa0, pa1, pa2, pa3); SBAR();
    SLOAD(SO, (j + 2 < NT) ? j + 2 : NT - 1); SBAR();
    pv_d0(o, vb0, pa0, pa1, pa2, pa3); partialSM(pB0, pB1, m_reg, mnB, alB);
    __syncthreads(); SWAIT(); SWRITE(0, SE);
    RESC(alB); __syncthreads();
    SBAR(); qkt(pA0, pA1, K_lds, qr, r32, hi);
    finishSM(pB0, pB1, alB, l_reg, pa0, pa1, pa2, pa3); SBAR();
    SLOAD(SE, (j + 3 < NT) ? j + 3 : NT - 1); SBAR();
    pv_d0(o, vb0 + (int)SHM_V, pa0, pa1, pa2, pa3); partialSM(pA0, pA1, m_reg, mnA, alA);
    __syncthreads(); SWAIT(); SWRITE(1, SO);
    RESC(alA); __syncthreads();
  }
  finishSM(pA0, pA1, alA, l_reg, pa0, pa1, pa2, pa3); SBAR();
  pv_d0(o, vb0, pa0, pa1, pa2, pa3);
  if (hi == 0) li_l[r32] = l_reg; asm volatile("s_waitcnt lgkmcnt(0)" ::: "memory");
  float rli[16];
#pragma unroll
  for (int r = 0; r < 16; ++r) rli[r] = __builtin_amdgcn_rcpf(li_l[crow(r, hi)]);
  bf16_t* Ow = Ob + (long)(wid * 32) * LDO;
#pragma unroll
  for (int r = 0; r < 16; ++r) { int orow = crow(r, hi);
    for (int d0 = 0; d0 < 4; ++d0) { const float v = o[d0][r] * rli[r]; Ow[(long)orow * LDO + d0 * 32 + r32] = (bf16_t)(cvt_pk_bf16(v, v) & 0xffffu); } }
#undef SLOAD
#undef SWRITE
#undef SWAIT
#undef RESC
#undef TKP
#undef TVP
}
}

__device__ __forceinline__ void phase_attn(const Params& p, char* lds) {
    unsigned char* ws = p.ws; const bf16_t* q = (const bf16_t*)(ws + U_AQ); const bf16_t* k = (const bf16_t*)(ws + U_AK); const bf16_t* v = (const bf16_t*)(ws + U_AV); bf16_t* ao = (bf16_t*)(ws + U_AO);
    const bool xmap = (gridDim.x == 256);
    for (int it = blockIdx.x, rnd = 0; it < 2048; it += gridDim.x, ++rnd) {
        int item = it;
        if (xmap) { const int x = blockIdx.x & 7, j = blockIdx.x >> 3, pair = x * 4 + (rnd >> 1), i64 = (rnd & 1) * 32 + j; item = (pair >> 1) * 128 + ((pair & 1) * 4 + (i64 >> 4)) * 16 + (i64 & 15); }
        const int qb = item & 15, hh = (item >> 4) & 7, b = item >> 7, kvh = hh >> 2;
        const size_t qrow = (size_t)R0 + (size_t)b * SEQ + qb * 256;
        att::attn_body(q + qrow * 1024 + hh * 128, k + (size_t)(b * 16) * 256 + kvh * 128, v + (size_t)(b * 16) * 256 + kvh * 128,
                       k + ((size_t)R0 + (size_t)b * SEQ) * 256 + kvh * 128, v + ((size_t)R0 + (size_t)b * SEQ) * 256 + kvh * 128,
                       ao + qrow * 1024 + hh * 128, lds, p.in[14], qb * 256);
        __syncthreads();
    }
}

#define XB_TMO      128
#define XB_XCNT(j)  (256  + 64 * (j))
#define XB_XSUB(j)  (1280 + 64 * (j))
#define XB_XGEN(j)  (2304 + 64 * (j))
#define XB_TOP      3328
#define XB_TOPGEN   3392
#define XCD_BAR_WORDS 3456
#define XB_SPIN_CAP (1u << 18)
__device__ __forceinline__ unsigned xb_ld(unsigned* p)              { return __hip_atomic_load(p, __ATOMIC_RELAXED, __HIP_MEMORY_SCOPE_AGENT); }
__device__ __forceinline__ unsigned xb_add(unsigned* p, unsigned v) { return __hip_atomic_fetch_add(p, v, __ATOMIC_RELAXED, __HIP_MEMORY_SCOPE_AGENT); }
__device__ __forceinline__ unsigned xb_xcc_id() { return (unsigned)__builtin_amdgcn_s_getreg((3 << 11) | 20) & 0xFu; }
#define XB_SPIN(cond, bar) do { unsigned _sp = 0; while (cond) { __builtin_amdgcn_s_sleep(1); \
    if ((++_sp & 255u) == 0u) { if (xb_ld(&(bar)[XB_TMO])) break; if (_sp > XB_SPIN_CAP) { atomicAdd(&(bar)[XB_TMO], 1u); break; } } } } while (0)
struct XcdBarrier { unsigned* bar; unsigned x; volatile LAS unsigned* st; };
__device__ __forceinline__ XcdBarrier xcd_barrier_post(unsigned* bar, volatile LAS unsigned* st) {
    XcdBarrier b; b.bar = bar; b.x = xb_xcc_id(); b.st = st;
    if (threadIdx.x == 0) (void)xb_add(&bar[XB_XCNT(b.x)], 1u);
    return b;
}
__device__ __forceinline__ void xcd_barrier_complete(unsigned* bar, unsigned x, unsigned& nloc, unsigned& nx) {
    const unsigned G = gridDim.x * gridDim.y * gridDim.z;
    unsigned sum, cnt, mine, sp = 0u;
    for (;;) {
        sum = 0u; cnt = 0u; mine = 0u;
#pragma unroll
        for (unsigned j = 0; j < 16; ++j) { const unsigned c = xb_ld(&bar[XB_XCNT(j)]); sum += c; cnt += (c > 0u) ? 1u : 0u; mine = (j == x) ? c : mine; }
        if (sum == G) break;
        __builtin_amdgcn_s_sleep(1);
        if ((++sp & 255u) == 0u) { if (xb_ld(&bar[XB_TMO])) break; if (sp > XB_SPIN_CAP) { atomicAdd(&bar[XB_TMO], 1u); break; } }
    }
    nloc = mine > 0u ? mine : 1u; nx = cnt > 0u ? cnt : 1u;
}
__device__ __forceinline__ void xcd_barrier(const XcdBarrier& b) {
    asm volatile("s_waitcnt vmcnt(0)" ::: "memory");
    __syncthreads();
    if (threadIdx.x == 0) {
        unsigned* bar = b.bar;
        __builtin_amdgcn_s_waitcnt(0);
        unsigned nloc = b.st[0], nx = b.st[1];
        if (nloc == 0u) { xcd_barrier_complete(bar, b.x, nloc, nx); b.st[0] = nloc; b.st[1] = nx; }
        const unsigned old = xb_add(&bar[XB_XSUB(b.x)], 1u);
        const unsigned gen = old / nloc;
        if (old + 1u == (gen + 1u) * nloc) {
            __builtin_amdgcn_fence(__ATOMIC_RELEASE, "agent");
            asm volatile("s_waitcnt vmcnt(0)" ::: "memory");
            const unsigned og = xb_add(&bar[XB_TOP], 1u);
            const unsigned tg = og / nx;
            if (og + 1u == (tg + 1u) * nx) xb_add(&bar[XB_TOPGEN], 1u);
            else XB_SPIN(xb_ld(&bar[XB_TOPGEN]) == tg, bar);
            __builtin_amdgcn_fence(__ATOMIC_ACQUIRE, "agent");
            xb_add(&bar[XB_XGEN(b.x)], 1u);
            asm volatile("s_waitcnt vmcnt(0)" ::: "memory");
        } else {
            XB_SPIN(xb_ld(&bar[XB_XGEN(b.x)]) == gen, bar);
            __builtin_amdgcn_fence(__ATOMIC_ACQUIRE, "agent");
            asm volatile("s_waitcnt vmcnt(0)" ::: "memory");
        }
    }
    __syncthreads();
}

__global__ void __launch_bounds__(512, 1) mega_fwd(Params p) {
    extern __shared__ __attribute__((aligned(16))) unsigned char shm[];
    ldsp lds = (ldsp)shm;
    unsigned char* ws = p.ws;
    bf16_t* hb = (bf16_t*)(ws + WS_HB); float* ssq = (float*)(ws + WS_SSQ);
    const int G = gridDim.x, c = blockIdx.x;
    if (threadIdx.x < 4) ((volatile LAS unsigned*)(lds + LDS_BYTES))[threadIdx.x] = 0u;
    if (blockIdx.x == 0 && p.hi - p.lo > 1) for (int i = threadIdx.x; i < XCD_BAR_WORDS; i += 512) ((unsigned*)(p.ws + WS_BAR))[i] = 0u;
    __syncthreads();
    unsigned long long tp0 = 0; float tpsum = 0.f;
    for (int ph = p.lo; ph < p.hi; ++ph) {
        if (TPROBE_MASK && blockIdx.x == 0 && threadIdx.x == 0) tp0 = __builtin_amdgcn_s_memrealtime();
        int kind, f = 0, nin = 0, nout = 0;
        switch (ph) {
            case 0: kind = 0; break;
            case 1: kind = 1; f = 0; nin = 0; break;
            case 2: kind = 2; f = 0; nout = (DIAG == 2) ? 6 : 1; break;
            case 3: kind = 3; nin = 1; break;
            case 4: kind = 4; break;
            case 5: kind = 5; break;
            case 6: kind = 2; f = 4; nout = (DIAG == 3) ? 6 : 2; break;
            case 7: kind = 1; f = 1; nin = 2; break;
            case 8: kind = 2; f = 1; nout = 3; break;
            case 9: kind = 1; f = 2; nin = 3; break;
            case 10: kind = 2; f = 2; nout = 4; break;
            case 11: kind = 6; nin = 4; break;
            case 12: kind = 7; break;
            case 13: kind = 8; break;
            case 14: kind = 2; f = 5; nout = 5; break;
            case 15: kind = 1; f = 3; nin = 5; break;
            case 16: kind = 2; f = 3; nout = 6; break;
            default: kind = 9; break;
        }
        if (!((PHMASK >> ph) & 1)) kind = 99;
        const int pmoff = (ph >= 14) ? 1 : 0; const int Mrows = MROWS - pmoff * 256;
        if (kind == 0) { if (KMASK & 1) phase_prep(p, lds); }
        else if (kind == 1 && (KMASK & 2)) {
            pg8::Gemm g{hb + (size_t)pmoff * 256 * DM, (const bf16_t*)(ws + WS_WGU + f * SZ_WGU), Mrows, 2 * FF, DM, 0}; pg8::StaticOrder S; S.init(Mrows, 2 * FF, G, c);
            EpiSwiGLU E{(bf16_t*)(ws + U_ACT), ssq + (size_t)nin * MROWS * 16, pmoff, lds};
            rstd_table_build(lds, S, E.ssq, pmoff);
            pg8::gemm_phase(lds, g, S, E);
        } else if (kind == 2 && (KMASK & 4)) {
            pg8::Gemm g; float alpha; const float* x32 = nullptr;
            if (f < 4) { g = pg8::Gemm{(const bf16_t*)(ws + U_ACT) + (size_t)pmoff * 256 * FF, (const bf16_t*)(ws + WS_WD + f * SZ_WD), Mrows, DM, FF, 1}; alpha = 0.5f; if (ph == 2) x32 = p.in[0] - (size_t)R0 * DM; }
            else if (f == 4) { g = pg8::Gemm{(const bf16_t*)(ws + U_GV), (const bf16_t*)(ws + WS_WGOUT), MROWS, DM, DM, 0}; alpha = 1.f; }
            else { g = pg8::Gemm{(const bf16_t*)(ws + U_AO) + (size_t)pmoff * 256 * DM, (const bf16_t*)(ws + WS_WAOUT), Mrows, DM, DM, 0}; alpha = 1.f; }
            pg8::StaticOrder S; S.init(Mrows, DM, G, c);
            EpiResid E{x32, hb, ssq + (size_t)nout * MROWS * 16, alpha, pmoff};
            pg8::gemm_phase(lds, g, S, E);
        } else if (kind == 3 && (KMASK & 8)) {
            pg8::Gemm g{hb, (const bf16_t*)(ws + WS_WGIN), MROWS, 4096, DM, 0}; pg8::StaticOrder S; S.init(MROWS, 4096, G, c);
            EpiGlaIn E{(bf16_t*)((unsigned char*)p.out + O_GQ), (bf16_t*)(ws + U_GK), (bf16_t*)(ws + U_GV), (bf16_t*)(ws + U_GR), (float*)((unsigned char*)p.out + O_GF), (float*)(ws + U_GB),
                       ssq + (size_t)nin * MROWS * 16, p.in[10], lds};
            for (int i = get_tid(); i < 1024; i += 512) *(LAS float*)(lds + GB_OFF + i * 4) = p.in[10][i];
            rstd_table_build(lds, S, E.ssq, 0);
            pg8::gemm_phase(lds, g, S, E);
        } else if (kind == 4) { if (KMASK & 16) phase_gla_seq(p, lds); }
        else if (kind == 5) { if (KMASK & 32) phase_gla_post(p); }
        else if (kind == 6 && (KMASK & 64)) {
            pg8::Gemm g{hb, (const bf16_t*)(ws + WS_WAIN), MROWS, 1536, DM, 0}; pg8::StaticOrder S; S.init(MROWS, 1536, G, c);
            EpiAttnIn E{(bf16_t*)(ws + U_AQ), (bf16_t*)(ws + U_AK), (bf16_t*)(ws + U_AV), ssq + (size_t)nin * MROWS * 16, lds};
            rstd_table_build(lds, S, E.ssq, 0);
            pg8::gemm_phase(lds, g, S, E);
        } else if (kind == 7) { if (KMASK & 128) phase_attn_prep(p); }
        else if (kind == 8) { if (KMASK & 256) phase_attn(p, (char*)shm); }
        else if (kind == 9 && (KMASK & 512)) phase_final(p);
        if (ph + 1 < p.hi) {
            if (ph == p.lo) { cg::this_grid().sync(); (void)xcd_barrier_post((unsigned*)(p.ws + WS_BAR), (volatile LAS unsigned*)(lds + LDS_BYTES)); }
            else { XcdBarrier xb; xb.bar = (unsigned*)(p.ws + WS_BAR); xb.x = xb_xcc_id(); xb.st = (volatile LAS unsigned*)(lds + LDS_BYTES); xcd_barrier(xb); } }
        if (TPROBE_MASK) { if (blockIdx.x == 0 && threadIdx.x == 0) { const unsigned long long tp1 = __builtin_amdgcn_s_memrealtime(); if ((TPROBE_MASK >> ph) & 1) tpsum += (float)(tp1 - tp0) * 0.01f;
                if (ph == 16) __hip_atomic_store((float*)(ws + WS_NEED), tpsum, __ATOMIC_RELAXED, __HIP_MEMORY_SCOPE_AGENT); }
            if (ph == 16) cg::this_grid().sync(); }
    }
}

extern "C" void kernel_launch(void* const* d_in, const int* in_sizes, int n_in, void* d_out, int out_size, void* d_ws, size_t ws_size, hipStream_t stream) {
    static int grid = 0;
    if (grid == 0) {
        if (n_in != 22 || out_size != NB * SEQ * DM || ws_size < WS_END) { fprintf(stderr, "kernel_launch: unexpected shapes n_in %d out %d ws %zu (need %zu)\n", n_in, out_size, ws_size, (size_t)WS_END); grid = -1; return; }
        if (hipFuncSetAttribute((const void*)mega_fwd, hipFuncAttributeMaxDynamicSharedMemorySize, LDS_TOTAL) != hipSuccess) { fprintf(stderr, "kernel_launch: hipFuncSetAttribute failed\n"); grid = -1; return; }
        int dev = 0, cus = 0, per_cu = 0;
        hipGetDevice(&dev); hipDeviceGetAttribute(&cus, hipDeviceAttributeMultiprocessorCount, dev);
        hipOccupancyMaxActiveBlocksPerMultiprocessor(&per_cu, (const void*)mega_fwd, 512, LDS_TOTAL);
        if (per_cu < 1) { fprintf(stderr, "kernel_launch: occupancy query says %d blocks/CU\n", per_cu); per_cu = 1; }
        (void)hipGetLastError();
        grid = cus * per_cu;
    }
    if (grid < 0) return;
    Params p{};
    for (int i = 0; i < 22; ++i) p.in[i] = (const float*)d_in[i];
    p.out = (float*)d_out; p.ws = (unsigned char*)d_ws;
#if ONE_LAUNCH
    p.lo = 0; p.hi = NPHASE;
    void* args[] = {&p};
    hipError_t e = hipLaunchCooperativeKernel((const void*)mega_fwd, dim3(grid), dim3(512), args, LDS_TOTAL, stream);
    if (e != hipSuccess) fprintf(stderr, "cooperative launch failed: %s (grid %d)\n", hipGetErrorString(e), grid);
#else
    for (int ph = 0; ph < NPHASE; ++ph) { p.lo = ph; p.hi = ph + 1; hipLaunchKernelGGL(mega_fwd, dim3(grid), dim3(512), LDS_TOTAL, stream, p); }
#endif
}
```

```cpp
#include <hip/hip_runtime.h>
#include <hip/hip_cooperative_groups.h>
#include <cstdio>
namespace cg = cooperative_groups;

#ifndef TPROBE_MASK
#define TPROBE_MASK 0
#endif
#ifndef NOADD
#define NOADD 0
#endif
#ifndef FWDONLY
#define FWDONLY 0
#endif
#ifndef DIAG
#define DIAG 0
#endif
#ifndef PHMASK
#define PHMASK 0x3ffff
#endif
#ifndef KMASK
#define KMASK 1023
#endif
#ifndef ONE_LAUNCH
#define ONE_LAUNCH 1
#endif

#define LAS __attribute__((address_space(3)))
typedef unsigned short bf16_t;
typedef short bf16x8 __attribute__((ext_vector_type(8)));
typedef short s16x4 __attribute__((ext_vector_type(4)));
typedef float f32x4 __attribute__((ext_vector_type(4)));
typedef float f32x8 __attribute__((ext_vector_type(8)));
typedef float f32x16 __attribute__((ext_vector_type(16)));
typedef unsigned u32x4 __attribute__((ext_vector_type(4)));
typedef unsigned u32x2 __attribute__((ext_vector_type(2)));
typedef LAS unsigned char* ldsp;

constexpr int DM = 1024, FF = 2816, NB = 16, SEQ = 4096, NMETA = 16;
constexpr int MROWS = NB * NMETA + NB * SEQ;
constexpr int R0 = NB * NMETA;
constexpr float EPS = 1e-6f;
constexpr int LDS_BYTES = 152064;
constexpr int LDS_TOTAL = LDS_BYTES + 16;
constexpr int NPHASE = 18;

constexpr size_t SZ_H = (size_t)MROWS * DM * 4, SZ_HB = (size_t)MROWS * DM * 2, SZ_SSQ1 = (size_t)MROWS * 16 * 4;
constexpr size_t WS_H = 0, WS_HB = WS_H + SZ_H, WS_SSQ = WS_HB + SZ_HB, WS_W = WS_SSQ + 7 * SZ_SSQ1;
constexpr size_t SZ_WGU = (size_t)2 * FF * DM * 2, SZ_WD = (size_t)DM * FF * 2;
constexpr size_t WS_WGU = WS_W, WS_WD = WS_WGU + 4 * SZ_WGU, WS_WGIN = WS_WD + 4 * SZ_WD, WS_WGOUT = WS_WGIN + (size_t)4096 * DM * 2,
                 WS_WAIN = WS_WGOUT + (size_t)DM * DM * 2, WS_WAOUT = WS_WAIN + (size_t)1536 * DM * 2, WS_U = WS_WAOUT + (size_t)DM * DM * 2;
constexpr size_t U_ACT = WS_U;
constexpr size_t U_GB = WS_U, U_GK = U_GB + (size_t)MROWS * 512 * 4, U_GV = U_GK + (size_t)MROWS * 512 * 2, U_GR = U_GV + SZ_HB, U_GEND = U_GR + SZ_HB;
constexpr size_t U_AQ = WS_U, U_AK = U_AQ + SZ_HB, U_AV = U_AK + (size_t)MROWS * 256 * 2, U_AO = U_AV + (size_t)MROWS * 256 * 2, U_AEND = U_AO + SZ_HB;
constexpr size_t WS_NEED = (U_GEND > U_AEND ? U_GEND : U_AEND);
constexpr size_t WS_BAR = WS_NEED + 256, WS_END = WS_BAR + 16384;
constexpr size_t O_GF = 0, O_GQ = (size_t)MROWS * 512 * 4;

struct Params { const float* in[22]; float* out; unsigned char* ws; int lo, hi; };

typedef __bf16 bf16x2_t __attribute__((ext_vector_type(2)));
typedef float f32x2_t __attribute__((ext_vector_type(2)));
__device__ __forceinline__ unsigned cvt_pk_bf16(float lo, float hi) { const f32x2_t f = {lo, hi}; const bf16x2_t b = __builtin_convertvector(f, bf16x2_t); return __builtin_bit_cast(unsigned, b); }
__device__ __forceinline__ int get_tid() { int t = threadIdx.x; asm volatile("" : "+v"(t)); return t; }
__device__ __forceinline__ float bf2f(bf16_t v) { return __uint_as_float(((unsigned)v) << 16); }
__device__ __forceinline__ float bflo(unsigned w) { return __uint_as_float(w << 16); }
__device__ __forceinline__ float bfhi(unsigned w) { return __uint_as_float(w & 0xffff0000u); }
__device__ __forceinline__ float row_rstd(const float* ssq, int row) { const f32x4* p4 = (const f32x4*)(ssq + (size_t)row * 16); const f32x4 a = p4[0], b = p4[1], c = p4[2], d = p4[3];
    const f32x4 t = (a + b) + (c + d); return rsqrtf(((t[0] + t[1]) + (t[2] + t[3])) * (1.f / 1024.f) + EPS); }
__device__ __forceinline__ float fast_exp(float x) { return __builtin_amdgcn_exp2f(x * 1.4426950408889634f); }
__device__ __forceinline__ float silu_f(float x) { return x * __builtin_amdgcn_rcpf(1.f + __builtin_amdgcn_exp2f(-1.4426950408889634f * x)); }

namespace pg8 {
constexpr int BM = 256, BK = 64, HALF = 128, HTB = HALF * BK * 2, STAGE_BYTES = 8 * HTB, NXCD = 8, WGM = 8;
__host__ __device__ __forceinline__ int lds_byte(int r, int c) { const int st = (r >> 4) * 2 + (c >> 5), rr = r & 15, cc = c & 31, ob = rr * 64 + cc * 2; return st * 1024 + (ob ^ (((ob >> 9) & 1) << 5)); }
__host__ __device__ __forceinline__ void stage_rc(int b, int& R, int& C) { const int st = b / 1024, sb = b % 1024, swz = sb ^ (((sb >> 9) & 1) << 5); R = (st >> 1) * 16 + swz / 64; C = (st & 1) * 32 + (swz % 64) / 2; }
__host__ __device__ __forceinline__ int perm32(int rho) { const int n = rho >> 4, i = rho & 15; return 8 * (i >> 2) + 4 * n + (i & 3); }
struct Unit { int pm, pn; };
struct Gemm { const bf16_t* A; const bf16_t* Bt; int M, N, K; int atiled; };
struct StaticOrder {
    int nM, nN, nwg, G, c;
    __device__ void init(int M, int N, int G_, int c_) { nM = M / BM; nN = N / BM; nwg = nM * nN; G = G_; c = c_; }
    __device__ bool next(int i, Unit& u) const {
        const long L = (long)i * G + c; if (L >= nwg) return false;
        int wgid = (int)L; { const int q = nwg / NXCD, r = nwg % NXCD, xcd = wgid % NXCD, off = wgid / NXCD; wgid = (xcd < r ? xcd * (q + 1) : r * (q + 1) + (xcd - r) * q) + off; }
        const int nig = WGM * nN, gid = wgid / nig, fm = gid * WGM, gsz = (nM - fm) < WGM ? (nM - fm) : WGM;
        u.pm = fm + ((wgid % nig) % gsz); u.pn = (wgid % nig) / gsz; return true;
    }
};
template <class Epi>
__device__ __forceinline__ void gemm_phase(ldsp lds, const Gemm g, const StaticOrder& S, const Epi& E) {
    const int tid = get_tid(), wid = __builtin_amdgcn_readfirstlane(tid >> 6), lane = tid & 63, wr = wid >> 2, wc = wid & 3, fr = lane & 15, fq = lane >> 4;
    const int K = g.K, nt = K / BK;
    unsigned voffA[2], voffB[2];
#pragma unroll
    for (int i = 0; i < 2; ++i) { int R, C; stage_rc(tid * 16 + i * 8192, R, C); const int Rb = Epi::PERM ? ((R & ~31) + perm32(R & 31)) : R;
        voffA[i] = (unsigned)(R * (g.atiled ? BK : K) + C) * 2u; voffB[i] = (unsigned)(Rb * K + C) * 2u; }
    const size_t kstep = (size_t)(BK * 2);
    const size_t hstep = (size_t)HALF * K * 2;
    const size_t tstep = 2 * hstep;
    const size_t kstepA = g.atiled ? (size_t)BM * BK * 2 : kstep, hstepA = g.atiled ? (size_t)HALF * BK * 2 : hstep;
    const unsigned ldsw = (unsigned)wid * 1024u;
    const int aoff = lds_byte(wr * 64 + fr, fq * 8), boff = lds_byte(wc * 32 + fr, fq * 8);
#define PG8_SA(b, h) (((b) * 2 + (h)) * HTB)
#define PG8_SB(b, h) ((4 + (b) * 2 + (h)) * HTB)
#define PG8_STAGE(bufoff, gbase, voff) do { _Pragma("unroll") for (int _i = 0; _i < 2; ++_i) \
        __builtin_amdgcn_global_load_lds((const unsigned*)((const char*)(gbase) + (voff)[_i]), (LAS unsigned*)(lds + (bufoff) + ldsw + _i * 8192), 16, 0, 0); } while (0)
#define PG8_LDA(dst, b, h) do { _Pragma("unroll") for (int m = 0; m < 4; ++m) _Pragma("unroll") for (int k = 0; k < 2; ++k) dst[m][k] = *(const LAS bf16x8*)(lds + PG8_SA(b, h) + aoff + m * 2048 + k * 1024); } while (0)
#define PG8_LDB(dst, b, h) do { _Pragma("unroll") for (int n = 0; n < 2; ++n) _Pragma("unroll") for (int k = 0; k < 2; ++k) dst[n][k] = *(const LAS bf16x8*)(lds + PG8_SB(b, h) + boff + n * 2048 + k * 1024); } while (0)
#define PG8_MMA(ai, bj, At, Bt) do { __builtin_amdgcn_s_setprio(1); _Pragma("unroll") for (int m = 0; m < 4; ++m) _Pragma("unroll") for (int n = 0; n < 2; ++n) _Pragma("unroll") for (int k = 0; k < 2; ++k) \
        acc[ai][bj][m][n] = __builtin_amdgcn_mfma_f32_16x16x32_bf16(Bt[n][k], At[m][k], acc[ai][bj][m][n], 0, 0, 0); __builtin_amdgcn_s_setprio(0); } while (0)
#define PG8_WAIT_V(n) asm volatile("s_waitcnt vmcnt(" #n ")" ::: "memory")
#define PG8_WAIT_L(n) asm volatile("s_waitcnt lgkmcnt(" #n ")" ::: "memory")
#define PG8_BAR __builtin_amdgcn_s_barrier()
#define PG8_SCHED __builtin_amdgcn_sched_barrier(0)
    Unit cur, nxt; int ui = 0;
    if (!S.next(0, cur)) return;
    f32x4 acc[2][2][4][2];
#pragma unroll
    for (int a = 0; a < 2; ++a)
#pragma unroll
        for (int b = 0; b < 2; ++b)
#pragma unroll
            for (int m = 0; m < 4; ++m)
#pragma unroll
                for (int n = 0; n < 2; ++n) acc[a][b][m][n] = (f32x4){0.f, 0.f, 0.f, 0.f};
    bf16x8 At[4][2], B0[2][2], B1[2][2];
    const char* cA = (const char*)g.A + (size_t)cur.pm * tstep; const char* cB = (const char*)g.Bt + (size_t)cur.pn * tstep;
    PG8_STAGE(PG8_SB(0, 0), cB, voffB); PG8_STAGE(PG8_SA(0, 0), cA, voffA); PG8_STAGE(PG8_SB(0, 1), cB + hstep, voffB); PG8_STAGE(PG8_SA(0, 1), cA + hstepA, voffA);
    if (wr == 1) PG8_BAR;
    PG8_WAIT_V(4); PG8_BAR;
    PG8_STAGE(PG8_SB(1, 0), cB + kstep, voffB); PG8_STAGE(PG8_SA(1, 0), cA + kstepA, voffA); PG8_STAGE(PG8_SB(1, 1), cB + hstep + kstep, voffB);
    PG8_WAIT_V(6); PG8_BAR;
    for (;;) {
        const bool has_next = S.next(ui + 1, nxt);
        const char* nA = has_next ? (const char*)g.A + (size_t)nxt.pm * tstep : cA; const char* nB = has_next ? (const char*)g.Bt + (size_t)nxt.pn * tstep : cB;
        for (int t = 0; t < nt; t += 2) {
            const bool last = (t == nt - 2);
            const char* a1 = cA + (size_t)(t + 1) * kstepA;
            const char* a2 = last ? nA : cA + (size_t)(t + 2) * kstepA; const char* b2 = last ? nB : cB + (size_t)(t + 2) * kstep;
            const char* a3 = a2 + kstepA; const char* b3 = b2 + kstep;
            PG8_LDB(B0, 0, 0); PG8_SCHED; PG8_LDA(At, 0, 0); PG8_STAGE(PG8_SA(1, 1), a1 + hstepA, voffA);
            PG8_WAIT_L(8); PG8_BAR; PG8_WAIT_L(0); PG8_MMA(0, 0, At, B0); PG8_BAR; PG8_SCHED;
            PG8_LDB(B1, 0, 1); PG8_STAGE(PG8_SB(0, 0), b2, voffB);
            PG8_BAR; PG8_WAIT_L(0); PG8_MMA(0, 1, At, B1); PG8_BAR;
            PG8_LDA(At, 0, 1); PG8_STAGE(PG8_SA(0, 0), a2, voffA);
            PG8_BAR; PG8_WAIT_L(0); PG8_MMA(1, 0, At, B0); PG8_BAR; PG8_SCHED;
            PG8_STAGE(PG8_SB(0, 1), b2 + hstep, voffB);
            PG8_WAIT_V(6); PG8_BAR; PG8_MMA(1, 1, At, B1); PG8_BAR;
            PG8_LDB(B0, 1, 0); PG8_SCHED; PG8_LDA(At, 1, 0); PG8_STAGE(PG8_SA(0, 1), a2 + hstepA, voffA);
            PG8_WAIT_L(8); PG8_BAR; PG8_WAIT_L(0); PG8_MMA(0, 0, At, B0); PG8_BAR; PG8_SCHED;
            PG8_LDB(B1, 1, 1); PG8_STAGE(PG8_SB(1, 0), b3, voffB);
            PG8_BAR; PG8_WAIT_L(0); PG8_MMA(0, 1, At, B1); PG8_BAR;
            PG8_LDA(At, 1, 1); PG8_STAGE(PG8_SA(1, 0), a3, voffA);
            PG8_BAR; PG8_WAIT_L(0); PG8_MMA(1, 0, At, B0); PG8_BAR; PG8_SCHED;
            PG8_STAGE(PG8_SB(1, 1), b3 + hstep, voffB);
            PG8_WAIT_V(6); PG8_BAR; PG8_MMA(1, 1, At, B1); PG8_BAR;
        }
        E(acc, cur, wr, wc, fr, fq);
        if (!has_next) break;
#pragma unroll
        for (int a = 0; a < 2; ++a)
#pragma unroll
            for (int b = 0; b < 2; ++b)
#pragma unroll
                for (int m = 0; m < 4; ++m)
#pragma unroll
                    for (int n = 0; n < 2; ++n) acc[a][b][m][n] = (f32x4){0.f, 0.f, 0.f, 0.f};
        cur = nxt; cA = nA; cB = nB; ++ui;
    }
    PG8_WAIT_V(0);
    if (wr == 0) PG8_BAR;
    PG8_BAR;
#undef PG8_SA
#undef PG8_SB
#undef PG8_STAGE
#undef PG8_LDA
#undef PG8_LDB
#undef PG8_MMA
#undef PG8_WAIT_V
#undef PG8_WAIT_L
#undef PG8_BAR
#undef PG8_SCHED
}
}

typedef f32x4 AccT[2][2][4][2];

constexpr int RS_OFF = 131072, RS_SLOTS = 8, RS_TAG = RS_OFF + RS_SLOTS * 256 * 4, GB_OFF = RS_TAG + 64;
static_assert(GB_OFF + 4096 <= LDS_BYTES, "rstd table + gate bias");
__device__ __forceinline__ void rstd_table_build(ldsp lds, const pg8::StaticOrder& S, const float* ssq, int pmoff) {
    const int tid = get_tid(); int nslot = 0, last = -1; pg8::Unit u;
    for (int i = 0; S.next(i, u); ++i) if (u.pm != last) { last = u.pm; if (nslot < RS_SLOTS && tid == 0) *(LAS int*)(lds + RS_TAG + nslot * 4) = u.pm; ++nslot; }
    if (tid < RS_SLOTS && tid >= nslot) *(LAS int*)(lds + RS_TAG + tid * 4) = -1;
    __syncthreads();
    const int row = tid & 255, half = tid >> 8; f32x4 t[4][4];
#pragma unroll
    for (int kk = 0; kk < 4; ++kk) { const int pm = *(const LAS int*)(lds + RS_TAG + (2 * kk + half) * 4); const int pmc = pm < 0 ? 0 : pm + pmoff;
        const f32x4* p4 = (const f32x4*)(ssq + ((size_t)pmc * 256 + row) * 16); t[kk][0] = p4[0]; t[kk][1] = p4[1]; t[kk][2] = p4[2]; t[kk][3] = p4[3]; }
#pragma unroll
    for (int kk = 0; kk < 4; ++kk) { const f32x4 q = (t[kk][0] + t[kk][1]) + (t[kk][2] + t[kk][3]);
        *(LAS float*)(lds + RS_OFF + ((2 * kk + half) * 256 + row) * 4) = rsqrtf(((q[0] + q[1]) + (q[2] + q[3])) * (1.f / 1024.f) + EPS); }
    __syncthreads();
}
__device__ __forceinline__ void rstd_rows(ldsp lds, const float* ssq, int pm, int pmoff, int wr, int fr, float (&rs)[8]) {
    int slot = -1;
#pragma unroll
    for (int k = 0; k < RS_SLOTS; ++k) if (*(const LAS int*)(lds + RS_TAG + k * 4) == pm) slot = k;
    if (slot >= 0) {
#pragma unroll
        for (int ai = 0; ai < 2; ++ai)
#pragma unroll
            for (int m = 0; m < 4; ++m) rs[ai * 4 + m] = *(const LAS float*)(lds + RS_OFF + (slot * 256 + ai * 128 + wr * 64 + m * 16 + fr) * 4);
    } else {
#pragma unroll
        for (int ai = 0; ai < 2; ++ai)
#pragma unroll
            for (int m = 0; m < 4; ++m) rs[ai * 4 + m] = row_rstd(ssq, (pm + pmoff) * 256 + ai * 128 + wr * 64 + m * 16 + fr);
    }
}

struct EpiSwiGLU { static constexpr bool PERM = true;
    bf16_t* act; const float* ssq; int pmoff; ldsp lds;
    __device__ __forceinline__ void operator()(const AccT& acc, const pg8::Unit& u, int wr, int wc, int fr, int fq) const {
        const int row0 = (u.pm + pmoff) * 256 + wr * 64 + fr, col0 = u.pn * 128 + wc * 32 + 8 * fq;
        float rs[8]; rstd_rows(lds, ssq, u.pm, pmoff, wr, fr, rs);
#pragma unroll
        for (int ai = 0; ai < 2; ++ai)
#pragma unroll
            for (int m = 0; m < 4; ++m) { const int row = row0 + ai * 128 + m * 16; const float s = rs[ai * 4 + m];
                float a[8];
#pragma unroll
                for (int n = 0; n < 2; ++n)
#pragma unroll
                    for (int j = 0; j < 4; ++j) a[n * 4 + j] = silu_f(acc[ai][0][m][n][j] * s) * (acc[ai][1][m][n][j] * s);
                u32x4 w; w.x = cvt_pk_bf16(a[0], a[1]); w.y = cvt_pk_bf16(a[2], a[3]); w.z = cvt_pk_bf16(a[4], a[5]); w.w = cvt_pk_bf16(a[6], a[7]);
                *(u32x4*)(act + ((size_t)((row >> 8) * (FF / 64) + (col0 >> 6)) * 256 + (row & 255)) * 64 + (col0 & 63)) = w; }
    }
};
struct EpiResid { static constexpr bool PERM = true;
    const float* x32; bf16_t* hb; float* ssq; float alpha; int pmoff;
    __device__ __forceinline__ void operator()(const AccT& acc, const pg8::Unit& u, int wr, int wc, int fr, int fq) const {
        const int row0 = (u.pm + pmoff) * 256 + wr * 64 + fr, col0 = u.pn * 256 + wc * 32 + 8 * fq;
        const bool fromx = (x32 != nullptr) && (u.pm + pmoff != 0);
        if (fromx) {
#pragma unroll
            for (int ai = 0; ai < 2; ++ai)
#pragma unroll
                for (int mh = 0; mh < 2; ++mh) { f32x4 rf[2][2][2];
#pragma unroll
                    for (int mm = 0; mm < 2; ++mm)
#pragma unroll
                        for (int bj = 0; bj < 2; ++bj) { const float* xp = x32 + (size_t)(row0 + ai * 128 + (mh * 2 + mm) * 16) * DM + col0 + bj * 128; rf[mm][bj][0] = *(const f32x4*)xp; rf[mm][bj][1] = *(const f32x4*)(xp + 4); }
#pragma unroll
                    for (int mm = 0; mm < 2; ++mm) { const int m = mh * 2 + mm; const int row = row0 + ai * 128 + m * 16; const size_t off = (size_t)row * DM + col0; float ss = 0.f;
#pragma unroll
                        for (int bj = 0; bj < 2; ++bj) { float v[8];
#pragma unroll
                            for (int n = 0; n < 2; ++n)
#pragma unroll
                                for (int j = 0; j < 4; ++j) { v[n * 4 + j] = rf[mm][bj][n][j] + alpha * acc[ai][bj][m][n][j]; ss += v[n * 4 + j] * v[n * 4 + j]; }
                            u32x4 w; w.x = cvt_pk_bf16(v[0], v[1]); w.y = cvt_pk_bf16(v[2], v[3]); w.z = cvt_pk_bf16(v[4], v[5]); w.w = cvt_pk_bf16(v[6], v[7]);
                            *(u32x4*)(hb + off + bj * 128) = w; }
                        ss += __shfl_xor(ss, 16); ss += __shfl_xor(ss, 32);
                        if (fq == 0) ssq[(size_t)row * 16 + u.pn * 4 + wc] = ss; } }
        } else {
#pragma unroll
            for (int ai = 0; ai < 2; ++ai) { u32x4 rw[4][2];
#pragma unroll
                for (int m = 0; m < 4; ++m)
#pragma unroll
                    for (int bj = 0; bj < 2; ++bj) rw[m][bj] = *(const u32x4*)(hb + (size_t)(row0 + ai * 128 + m * 16) * DM + col0 + bj * 128);
#pragma unroll
                for (int m = 0; m < 4; ++m) { const int row = row0 + ai * 128 + m * 16; const size_t off = (size_t)row * DM + col0; float ss = 0.f;
#pragma unroll
                    for (int bj = 0; bj < 2; ++bj) { const u32x4 t = rw[m][bj]; const float r[8] = {bflo(t.x), bfhi(t.x), bflo(t.y), bfhi(t.y), bflo(t.z), bfhi(t.z), bflo(t.w), bfhi(t.w)}; float v[8];
#pragma unroll
                        for (int n = 0; n < 2; ++n)
#pragma unroll
                            for (int j = 0; j < 4; ++j) { v[n * 4 + j] = r[n * 4 + j] + alpha * acc[ai][bj][m][n][j]; ss += v[n * 4 + j] * v[n * 4 + j]; }
                        u32x4 w; w.x = cvt_pk_bf16(v[0], v[1]); w.y = cvt_pk_bf16(v[2], v[3]); w.z = cvt_pk_bf16(v[4], v[5]); w.w = cvt_pk_bf16(v[6], v[7]);
                        *(u32x4*)(hb + off + bj * 128) = w; }
                    ss += __shfl_xor(ss, 16); ss += __shfl_xor(ss, 32);
                    if (fq == 0) ssq[(size_t)row * 16 + u.pn * 4 + wc] = ss; } }
        }
    }
};
struct EpiGlaIn { static constexpr bool PERM = true;
    bf16_t *q, *k, *v, *r; float *gf, *gb; const float* ssq; const float* gbias; ldsp lds;
    __device__ __forceinline__ void operator()(const AccT& acc, const pg8::Unit& u, int wr, int wc, int fr, int fq) const {
        const int row0 = u.pm * 256 + wr * 64 + fr, cin0 = wc * 32 + 8 * fq, pn = u.pn;
        float rs[8]; rstd_rows(lds, ssq, u.pm, 0, wr, fr, rs);
#pragma unroll
        for (int ai = 0; ai < 2; ++ai)
#pragma unroll
            for (int m = 0; m < 4; ++m) { const int row = row0 + ai * 128 + m * 16; float s = rs[ai * 4 + m];
                if (pn < 2) s *= 0.08838834764831845f;
#pragma unroll
                for (int bj = 0; bj < 2; ++bj) { const int c = cin0 + 128 * bj; const f32x4 v0 = acc[ai][bj][m][0] * s, v1 = acc[ai][bj][m][1] * s;
                    if (pn < 12) {
                        bf16_t* dst;
                        if (pn < 2) dst = q + (size_t)row * 512 + pn * 256 + c; else if (pn < 4) dst = k + (size_t)row * 512 + (pn - 2) * 256 + c;
                        else if (pn < 8) dst = v + (size_t)row * 1024 + (pn - 4) * 256 + c; else dst = r + (size_t)row * 1024 + (pn - 8) * 256 + c;
                        u32x4 w; w.x = cvt_pk_bf16(v0[0], v0[1]); w.y = cvt_pk_bf16(v0[2], v0[3]); w.z = cvt_pk_bf16(v1[0], v1[1]); w.w = cvt_pk_bf16(v1[2], v1[3]);
                        *(u32x4*)dst = w;
                    } else {
                        const int dir = (pn - 12) >> 1, gc = ((pn - 12) & 1) * 256 + c;
                        const f32x4 b0 = *(const LAS f32x4*)(lds + GB_OFF + (dir * 512 + gc) * 4), b1 = *(const LAS f32x4*)(lds + GB_OFF + (dir * 512 + gc + 4) * 4); f32x4 o0, o1;
#pragma unroll
                        for (int j = 0; j < 4; ++j) { const float z0 = v0[j] + b0[j], z1 = v1[j] + b1[j];
                            o0[j] = (fminf(z0, 0.f) - __logf(1.f + __expf(-fabsf(z0)))) * 0.0625f; o1[j] = (fminf(z1, 0.f) - __logf(1.f + __expf(-fabsf(z1)))) * 0.0625f; }
                        float* dst = (dir ? gb : gf) + (size_t)row * 512 + gc; *(f32x4*)dst = o0; *(f32x4*)(dst + 4) = o1;
                    } } }
    }
};
struct EpiAttnIn { static constexpr bool PERM = true;
    bf16_t *q, *k, *v; const float* ssq; ldsp lds;
    __device__ __forceinline__ void operator()(const AccT& acc, const pg8::Unit& u, int wr, int wc, int fr, int fq) const {
        const int row0 = u.pm * 256 + wr * 64 + fr, cin0 = wc * 32 + 8 * fq, pn = u.pn;
        float rs[8]; rstd_rows(lds, ssq, u.pm, 0, wr, fr, rs);
#pragma unroll
        for (int ai = 0; ai < 2; ++ai)
#pragma unroll
            for (int m = 0; m < 4; ++m) { const int row = row0 + ai * 128 + m * 16; const float s = rs[ai * 4 + m];
#pragma unroll
                for (int bj = 0; bj < 2; ++bj) { const int c = cin0 + 128 * bj; const f32x4 v0 = acc[ai][bj][m][0] * s, v1 = acc[ai][bj][m][1] * s;
                    bf16_t* dst = (pn < 4) ? q + (size_t)row * 1024 + pn * 256 + c : (pn == 4 ? k + (size_t)row * 256 + c : v + (size_t)row * 256 + c);
                    u32x4 w; w.x = cvt_pk_bf16(v0[0], v0[1]); w.y = cvt_pk_bf16(v0[2], v0[3]); w.z = cvt_pk_bf16(v1[0], v1[1]); w.w = cvt_pk_bf16(v1[2], v1[3]);
                    *(u32x4*)dst = w; } }
    }
};

template <class F>
__device__ __forceinline__ void xpose_tiles(ldsp lds, int K, int N, F val, bf16_t* dst, int rmode, int rbase) {
    LAS float* T = (LAS float*)lds; const int tid = get_tid(), nkt = K / 64, nnt = N / 64;
    for (int t = blockIdx.x; t < nkt * nnt; t += gridDim.x) {
        const int kt = t % nkt, ntl = t / nkt, k0 = kt * 64, n0 = ntl * 64;
        { const int kr = tid >> 4, nc = (tid & 15) * 4; const f32x4 v0 = val(k0 + kr, n0 + nc), v1 = val(k0 + kr + 32, n0 + nc);
            T[kr * 65 + nc] = v0[0]; T[kr * 65 + nc + 1] = v0[1]; T[kr * 65 + nc + 2] = v0[2]; T[kr * 65 + nc + 3] = v0[3];
            T[(kr + 32) * 65 + nc] = v1[0]; T[(kr + 32) * 65 + nc + 1] = v1[1]; T[(kr + 32) * 65 + nc + 2] = v1[2]; T[(kr + 32) * 65 + nc + 3] = v1[3]; }
        __syncthreads();
        { const int n = tid >> 3, k8 = (tid & 7) * 8; float x[8];
#pragma unroll
            for (int j = 0; j < 8; ++j) x[j] = T[(k8 + j) * 65 + n];
            const int gn = n0 + n, dr = (rmode ? ((gn >> 7) * 256 + (gn & 127)) : gn) + rbase;
            u32x4 w; w.x = cvt_pk_bf16(x[0], x[1]); w.y = cvt_pk_bf16(x[2], x[3]); w.z = cvt_pk_bf16(x[4], x[5]); w.w = cvt_pk_bf16(x[6], x[7]);
            *(u32x4*)(dst + (size_t)dr * K + k0 + k8) = w; }
        __syncthreads();
    }
}
struct ValPlain { const float* src; int ld;
    __device__ __forceinline__ f32x4 operator()(int k, int n) const { return *(const f32x4*)(src + (size_t)k * ld + n); } };
struct ValGain { const float* src; int ld; const float* gain;
    __device__ __forceinline__ f32x4 operator()(int k, int n) const { const f32x4 v = *(const f32x4*)(src + (size_t)k * ld + n); return v * gain[k]; } };
struct ValGate { const float* w1; const float* w2; const float* gain;
    __device__ __forceinline__ f32x4 operator()(int k, int n) const { f32x4 a = {0.f, 0.f, 0.f, 0.f};
#pragma unroll
        for (int r = 0; r < 16; ++r) a += w1[k * 16 + r] * *(const f32x4*)(w2 + r * 512 + n);
        return a * gain[k]; } };

__device__ __forceinline__ void phase_prep(const Params& p, ldsp lds) {
    unsigned char* ws = p.ws; const int tid = get_tid(), lane = tid & 63, wid = tid >> 6;
    float* ssq = (float*)(ws + WS_SSQ); bf16_t* hb = (bf16_t*)(ws + WS_HB);
    for (int rp = blockIdx.x * 8 + wid; rp < MROWS / 2; rp += gridDim.x * 8) {
        f32x4 v[2][4];
#pragma unroll
        for (int k = 0; k < 2; ++k) { const int r = rp * 2 + k; const float* src = (r < R0) ? p.in[1] + (size_t)(r & 15) * DM : p.in[0] + (size_t)(r - R0) * DM;
#pragma unroll
            for (int i = 0; i < 4; ++i) v[k][i] = __builtin_nontemporal_load((const f32x4*)(src + i * 256 + lane * 4)); }
#pragma unroll
        for (int k = 0; k < 2; ++k) { const int r = rp * 2 + k; float ss = 0.f;
#pragma unroll
            for (int i = 0; i < 4; ++i) { const f32x4 x = v[k][i]; u32x2 w; w.x = cvt_pk_bf16(x[0], x[1]); w.y = cvt_pk_bf16(x[2], x[3]); *(u32x2*)(hb + (size_t)r * DM + i * 256 + lane * 4) = w;
                ss += (x[0] * x[0] + x[1] * x[1]) + (x[2] * x[2] + x[3] * x[3]); }
#pragma unroll
            for (int o = 32; o >= 1; o >>= 1) ss += __shfl_xor(ss, o);
            if (lane < 16) ssq[(size_t)r * 16 + lane] = lane == 0 ? ss : 0.f; }
    }
    for (int f = 0; f < 4; ++f) { const int li = f >> 1; const bool second = f & 1;
        const float* wg = p.in[second ? 18 : 3] + (size_t)li * DM * FF; const float* wu = p.in[second ? 19 : 4] + (size_t)li * DM * FF;
        const float* wd = p.in[second ? 20 : 5] + (size_t)li * FF * DM; const float* gn = p.in[second ? 17 : 2] + li * DM;
        bf16_t* dgu = (bf16_t*)(ws + WS_WGU + f * SZ_WGU); bf16_t* dd = (bf16_t*)(ws + WS_WD + f * SZ_WD);
        xpose_tiles(lds, DM, FF, ValGain{wg, FF, gn}, dgu, 1, 0);
        xpose_tiles(lds, DM, FF, ValGain{wu, FF, gn}, dgu, 1, 128);
        xpose_tiles(lds, FF, DM, ValPlain{wd, DM}, dd, 0, 0);
    }
    xpose_tiles(lds, DM, 3072, ValGain{p.in[7], 3072, p.in[6]}, (bf16_t*)(ws + WS_WGIN), 0, 0);
    xpose_tiles(lds, DM, 512, ValGate{p.in[8], p.in[9], p.in[6]}, (bf16_t*)(ws + WS_WGIN), 0, 3072);
    xpose_tiles(lds, DM, 512, ValGate{p.in[8] + DM * 16, p.in[9] + 16 * 512, p.in[6]}, (bf16_t*)(ws + WS_WGIN), 0, 3584);
    xpose_tiles(lds, DM, DM, ValPlain{p.in[12], DM}, (bf16_t*)(ws + WS_WGOUT), 0, 0);
    xpose_tiles(lds, DM, 1536, ValGain{p.in[13], 1536, p.in[6] + DM}, (bf16_t*)(ws + WS_WAIN), 0, 0);
    xpose_tiles(lds, DM, DM, ValPlain{p.in[16], DM}, (bf16_t*)(ws + WS_WAOUT), 0, 0);
}

__device__ __forceinline__ int gla_row(int b, int c, int to) { return c == 0 ? (to >= 48 ? b * 16 + (to - 48) : -1) : R0 + b * SEQ + (c - 1) * 64 + to; }
__device__ __forceinline__ bf16x8 ld8(ldsp base, int off) { return *(const LAS bf16x8*)(base + off); }

__device__ __forceinline__ void phase_gla_seq(const Params& p, ldsp lds) {
    constexpr int PBF = 528, PQ = 272, PT = 144;
    constexpr int OFF_BF = 0, OFF_QD = 33792, OFF_KI = OFF_QD + 17408, OFF_KET = OFF_KI + 17408, OFF_VT = OFF_KET + 18432, OFF_AM = OFF_VT + 18432,
                  OFF_ST = OFF_AM + 9216, OFF_PART = OFF_ST + 34816, OFF_DEC = OFF_PART + 2048;
    static_assert(OFF_DEC + 512 <= LDS_BYTES, "gla lds");
    unsigned char* ws = p.ws;
    const bf16_t* qb = (const bf16_t*)((unsigned char*)p.out + O_GQ); const bf16_t* kb = (const bf16_t*)(ws + U_GK); const bf16_t* vb = (const bf16_t*)(ws + U_GV);
    const float* gfp = (const float*)((unsigned char*)p.out + O_GF); const float* gbp = (const float*)(ws + U_GB);
    const int tid = get_tid(), lane = tid & 63, wid = __builtin_amdgcn_readfirstlane(tid >> 6), fr = lane & 15, fq = lane >> 4;
    const int dcol = tid & 127, qtr = tid >> 7;
    const int trow = tid >> 3, seg = tid & 7;
    for (int it = blockIdx.x; it < 256; it += gridDim.x) {
        const int item = (gridDim.x == 256) ? ((it & 7) * 32 + (it >> 3)) : it;
        const int vp = item & 1, dir = (item >> 1) & 1, hd = (item >> 2) & 3, b = item >> 4;
        bf16_t* obuf = (bf16_t*)(ws + WS_H) + (size_t)dir * MROWS * 1024;
        const float* gsrc = dir ? gbp : gfp;
        const unsigned colo = (unsigned)(qtr * 16) * 2048u + (unsigned)dcol * 4u, rowo = (unsigned)trow * 1024u + (unsigned)seg * 32u, rowv = (unsigned)trow * 2048u + (unsigned)seg * 32u;
        float gcol[16]; u32x4 rq0, rq1, rk0, rk1, rv0, rv1;
        f32x4 accS[8];
#define GLA_LOAD_SLOW(c_) do { \
        _Pragma("unroll") for (int i = 0; i < 16; ++i) { const int r_ = gla_row(b, (c_), qtr * 16 + i); \
            gcol[i] = r_ >= 0 ? gsrc[(size_t)r_ * 512 + hd * 128 + dcol] : 0.f; } \
        { const int r_ = gla_row(b, (c_), trow); const u32x4 z_ = {0u, 0u, 0u, 0u}; \
          if (r_ >= 0) { const bf16_t* qp_ = qb + (size_t)r_ * 512 + hd * 128 + seg * 16; const bf16_t* kp_ = kb + (size_t)r_ * 512 + hd * 128 + seg * 16; const bf16_t* vp_ = vb + (size_t)r_ * 1024 + hd * 256 + vp * 128 + seg * 16; \
              rq0 = *(const u32x4*)qp_; rq1 = *(const u32x4*)(qp_ + 8); rk0 = *(const u32x4*)kp_; rk1 = *(const u32x4*)(kp_ + 8); rv0 = *(const u32x4*)vp_; rv1 = *(const u32x4*)(vp_ + 8); } \
          else { rq0 = z_; rq1 = z_; rk0 = z_; rk1 = z_; rv0 = z_; rv1 = z_; } } } while (0)
#define GLA_LOAD_FAST(c_) do { const size_t rb_ = (size_t)R0 + (size_t)b * SEQ + (size_t)((c_) - 1) * 64; \
        unsigned colo_ = colo, rowo_ = rowo; asm volatile("" : "+v"(colo_), "+v"(rowo_));     \
        { const char* gB_ = (const char*)(gsrc + rb_ * 512 + hd * 128); \
          _Pragma("unroll") for (int i = 0; i < 16; ++i) gcol[i] = *(const float*)(gB_ + (colo_ + (unsigned)i * 2048u)); } \
        { const char* qB_ = (const char*)(qb + rb_ * 512 + hd * 128); const char* kB_ = (const char*)(kb + rb_ * 512 + hd * 128); const char* vB_ = (const char*)(vb + rb_ * 1024 + hd * 256 + vp * 128); \
          rq0 = *(const u32x4*)(qB_ + rowo_); rq1 = *(const u32x4*)(qB_ + rowo_ + 16u); rk0 = *(const u32x4*)(kB_ + rowo_); rk1 = *(const u32x4*)(kB_ + rowo_ + 16u); \
          rv0 = *(const u32x4*)(vB_ + rowv); rv1 = *(const u32x4*)(vB_ + rowv + 16u); } } while (0)
#define GLA_LOAD(c_) do { if ((c_) != 0) GLA_LOAD_FAST(c_); else GLA_LOAD_SLOW(c_); } while (0)
        GLA_LOAD(dir ? 64 : 0);
#pragma unroll
        for (int i = 0; i < 8; ++i) accS[i] = (f32x4){0.f, 0.f, 0.f, 0.f};
        for (int i = tid; i < 34816 / 4; i += 512) *(LAS unsigned*)(lds + OFF_ST + i * 4) = 0u;
        for (int ci = 0; ci < 65; ++ci) {
            const int c = dir ? 64 - ci : ci;
            float bl[16]; float run = 0.f;
            if (dir == 0) {
#pragma unroll
                for (int i = 0; i < 16; ++i) { run += gcol[i]; bl[i] = run; }
            } else {
#pragma unroll
                for (int i = 15; i >= 0; --i) { run += gcol[i]; bl[i] = run; }
            }
            *(LAS float*)(lds + OFF_PART + (qtr * 128 + dcol) * 4) = run;
            { const unsigned vw[8] = {rv0.x, rv0.y, rv0.z, rv0.w, rv1.x, rv1.y, rv1.z, rv1.w};
#pragma unroll
              for (int i = 0; i < 8; ++i) { const int vv = seg * 16 + 2 * i; const int vts = (((trow >> 3) ^ ((vv >> 3) & 7)) << 4) + (trow & 7) * 2;
                  *(LAS bf16_t*)(lds + OFF_VT + vv * PT + vts) = (bf16_t)(vw[i] & 0xffffu); *(LAS bf16_t*)(lds + OFF_VT + (vv + 1) * PT + vts) = (bf16_t)(vw[i] >> 16); } }
            __syncthreads();
            float offp = 0.f, tot = 0.f;
#pragma unroll
            for (int q2 = 0; q2 < 4; ++q2) { const float pv = *(LAS float*)(lds + OFF_PART + (q2 * 128 + dcol) * 4); tot += pv; if (dir ? (q2 > qtr) : (q2 < qtr)) offp += pv; }
#pragma unroll
            for (int i = 0; i < 16; ++i) *(LAS float*)(lds + OFF_BF + (qtr * 16 + i) * PBF + dcol * 4) = bl[i] + offp;
            if (qtr == 0) *(LAS float*)(lds + OFF_DEC + dcol * 4) = fast_exp(tot);
            __syncthreads();
            { const unsigned qw[8] = {rq0.x, rq0.y, rq0.z, rq0.w, rq1.x, rq1.y, rq1.z, rq1.w}, kw[8] = {rk0.x, rk0.y, rk0.z, rk0.w, rk1.x, rk1.y, rk1.z, rk1.w};
              unsigned qo[8], ko[8]; const int kts = (((trow >> 3) ^ seg) << 4) + (trow & 7) * 2;
#pragma unroll
              for (int i = 0; i < 4; ++i) { const f32x4 bv = *(const LAS f32x4*)(lds + OFF_BF + trow * PBF + (seg * 16 + i * 4) * 4); const f32x4 dc = *(const LAS f32x4*)(lds + OFF_DEC + (seg * 16 + i * 4) * 4);
#pragma unroll
                  for (int j = 0; j < 2; ++j) { const float e0 = fast_exp(bv[2 * j]), e1 = fast_exp(bv[2 * j + 1]); const unsigned qq = qw[i * 2 + j], kk = kw[i * 2 + j];
                      const float k0 = bflo(kk) * __builtin_amdgcn_rcpf(e0), k1 = bfhi(kk) * __builtin_amdgcn_rcpf(e1);
                      qo[i * 2 + j] = cvt_pk_bf16(bflo(qq) * e0, bfhi(qq) * e1); ko[i * 2 + j] = cvt_pk_bf16(k0, k1);
                      const unsigned kew = cvt_pk_bf16(k0 * dc[2 * j], k1 * dc[2 * j + 1]); const int d = seg * 16 + i * 4 + 2 * j;
                      *(LAS bf16_t*)(lds + OFF_KET + d * PT + kts) = (bf16_t)(kew & 0xffffu); *(LAS bf16_t*)(lds + OFF_KET + (d + 1) * PT + kts) = (bf16_t)(kew >> 16); } }
              *(LAS u32x4*)(lds + OFF_QD + trow * PQ + seg * 32) = (u32x4){qo[0], qo[1], qo[2], qo[3]}; *(LAS u32x4*)(lds + OFF_QD + trow * PQ + seg * 32 + 16) = (u32x4){qo[4], qo[5], qo[6], qo[7]};
              *(LAS u32x4*)(lds + OFF_KI + trow * PQ + seg * 32) = (u32x4){ko[0], ko[1], ko[2], ko[3]}; *(LAS u32x4*)(lds + OFF_KI + trow * PQ + seg * 32 + 16) = (u32x4){ko[4], ko[5], ko[6], ko[7]}; }
            if (ci + 1 < 65) { const int c2 = dir ? 63 - ci : ci + 1; GLA_LOAD(c2); }
            __syncthreads();
#pragma unroll
            for (int xx = 0; xx < 2; ++xx) { const int x = 2 * wid + xx, si = x >> 2, ti = x & 3; f32x4 a4 = {0.f, 0.f, 0.f, 0.f};
                if (dir ? (si >= ti) : (si <= ti)) {
#pragma unroll
                    for (int kk = 0; kk < 4; ++kk) a4 = __builtin_amdgcn_mfma_f32_16x16x32_bf16(ld8(lds, OFF_KI + (si * 16 + fr) * PQ + kk * 64 + fq * 16), ld8(lds, OFF_QD + (ti * 16 + fr) * PQ + kk * 64 + fq * 16), a4, 0, 0, 0);
#pragma unroll
                    for (int i = 0; i < 4; ++i) { const int sd = si * 16 + 4 * fq + i - (ti * 16 + fr); if (dir ? (sd < 0) : (sd > 0)) a4[i] = 0.f; }
                }
                u32x2 w; w.x = cvt_pk_bf16(a4[0], a4[1]); w.y = cvt_pk_bf16(a4[2], a4[3]);
                *(LAS u32x2*)(lds + OFF_AM + (ti * 16 + fr) * PT + (si * 16 + 4 * fq) * 2) = w; }
            __syncthreads();
            { const int vsw = (2 * wid + (fr >> 3)) & 7; bf16x8 fv[2], fs[4];
#pragma unroll
              for (int kk = 0; kk < 2; ++kk) fv[kk] = ld8(lds, OFF_VT + (wid * 16 + fr) * PT + (((kk * 4 + fq) ^ vsw) << 4));
#pragma unroll
              for (int kk = 0; kk < 4; ++kk) fs[kk] = ld8(lds, OFF_ST + (wid * 16 + fr) * PQ + kk * 64 + fq * 16);
#pragma unroll
              for (int ti = 0; ti < 4; ++ti) { f32x4 a4 = {0.f, 0.f, 0.f, 0.f};
#pragma unroll
                  for (int kk = 0; kk < 2; ++kk) a4 = __builtin_amdgcn_mfma_f32_16x16x32_bf16(fv[kk], ld8(lds, OFF_AM + (ti * 16 + fr) * PT + kk * 64 + fq * 16), a4, 0, 0, 0);
#pragma unroll
                  for (int kk = 0; kk < 4; ++kk) a4 = __builtin_amdgcn_mfma_f32_16x16x32_bf16(fs[kk], ld8(lds, OFF_QD + (ti * 16 + fr) * PQ + kk * 64 + fq * 16), a4, 0, 0, 0);
                  const int r = gla_row(b, c, ti * 16 + fr);
                  if (r >= 0) { u32x2 w; w.x = cvt_pk_bf16(a4[0], a4[1]); w.y = cvt_pk_bf16(a4[2], a4[3]); *(u32x2*)(obuf + (size_t)r * 1024 + hd * 256 + vp * 128 + wid * 16 + 4 * fq) = w; } } }
            __syncthreads();
            { const f32x4 dc = *(const LAS f32x4*)(lds + OFF_DEC + (16 * wid + 4 * fq) * 4); bf16x8 fk[2];
#pragma unroll
              for (int kk = 0; kk < 2; ++kk) fk[kk] = ld8(lds, OFF_KET + (16 * wid + fr) * PT + (((kk * 4 + fq) ^ (wid & 7)) << 4));
#pragma unroll
              for (int vbk = 0; vbk < 8; ++vbk) { accS[vbk] = accS[vbk] * dc; const int vsw = (2 * vbk + (fr >> 3)) & 7;
#pragma unroll
                  for (int kk = 0; kk < 2; ++kk) accS[vbk] = __builtin_amdgcn_mfma_f32_16x16x32_bf16(fk[kk], ld8(lds, OFF_VT + (vbk * 16 + fr) * PT + (((kk * 4 + fq) ^ vsw) << 4)), accS[vbk], 0, 0, 0);
                  u32x2 w; w.x = cvt_pk_bf16(accS[vbk][0], accS[vbk][1]); w.y = cvt_pk_bf16(accS[vbk][2], accS[vbk][3]);
                  *(LAS u32x2*)(lds + OFF_ST + (vbk * 16 + fr) * PQ + (16 * wid + 4 * fq) * 2) = w; } }
            __syncthreads();
        }
#undef GLA_LOAD
#undef GLA_LOAD_FAST
#undef GLA_LOAD_SLOW
    }
}

__device__ __forceinline__ void phase_gla_post(const Params& p) {
    unsigned char* ws = p.ws; const bf16_t* o = (const bf16_t*)(ws + WS_H); const bf16_t* ob = o + (size_t)MROWS * 1024; const bf16_t* r = (const bf16_t*)(ws + U_GR); bf16_t* og = (bf16_t*)(ws + U_GV);
    const float* hn = p.in[11]; const int tid = get_tid(), lane = tid & 63, wid = tid >> 6;
    float g[16];
#pragma unroll
    for (int i = 0; i < 16; ++i) g[i] = hn[(lane & 15) * 16 + i];
    for (int row = blockIdx.x * 8 + wid; row < MROWS; row += gridDim.x * 8) {
        const size_t off = (size_t)row * 1024 + lane * 16;
        const u32x4 o0 = *(const u32x4*)(o + off), o1 = *(const u32x4*)(o + off + 8), p0 = *(const u32x4*)(ob + off), p1 = *(const u32x4*)(ob + off + 8), r0 = *(const u32x4*)(r + off), r1 = *(const u32x4*)(r + off + 8);
        const unsigned ow[8] = {o0.x, o0.y, o0.z, o0.w, o1.x, o1.y, o1.z, o1.w}, pw[8] = {p0.x, p0.y, p0.z, p0.w, p1.x, p1.y, p1.z, p1.w}, rw[8] = {r0.x, r0.y, r0.z, r0.w, r1.x, r1.y, r1.z, r1.w};
        float x[16]; float ss = 0.f;
#pragma unroll
        for (int i = 0; i < 8; ++i) { x[2 * i] = bflo(ow[i]) + bflo(pw[i]); x[2 * i + 1] = bfhi(ow[i]) + bfhi(pw[i]); ss += x[2 * i] * x[2 * i] + x[2 * i + 1] * x[2 * i + 1]; }
        ss += __shfl_xor(ss, 1); ss += __shfl_xor(ss, 2); ss += __shfl_xor(ss, 4); ss += __shfl_xor(ss, 8);
        const float rs = rsqrtf(ss * (1.f / 256.f) + EPS); unsigned w[8];
#pragma unroll
        for (int i = 0; i < 8; ++i) w[i] = cvt_pk_bf16(x[2 * i] * rs * g[2 * i] * silu_f(bflo(rw[i])), x[2 * i + 1] * rs * g[2 * i + 1] * silu_f(bfhi(rw[i])));
        *(u32x4*)(og + off) = (u32x4){w[0], w[1], w[2], w[3]}; *(u32x4*)(og + off + 8) = (u32x4){w[4], w[5], w[6], w[7]};
    }
}

__device__ __forceinline__ void attn_prep_head(bf16_t* base, int pos, bool real, int ax, int ic, const float* gn) {
    const int d0 = ax * 64 + ic * 8;
    const u32x4 wa = *(const u32x4*)(base + d0), wb = *(const u32x4*)(base + d0 + 32);
    const unsigned aw[4] = {wa.x, wa.y, wa.z, wa.w}, bw[4] = {wb.x, wb.y, wb.z, wb.w};
    float xa[8], xb[8]; float ss = 0.f;
#pragma unroll
    for (int j = 0; j < 4; ++j) { xa[2 * j] = bflo(aw[j]); xa[2 * j + 1] = bfhi(aw[j]); xb[2 * j] = bflo(bw[j]); xb[2 * j + 1] = bfhi(bw[j]); }
#pragma unroll
    for (int j = 0; j < 8; ++j) ss += xa[j] * xa[j] + xb[j] * xb[j];
    ss += __shfl_xor(ss, 1); ss += __shfl_xor(ss, 2); ss += __shfl_xor(ss, 4);
    const float rs = rsqrtf(ss * (1.f / 128.f) + EPS);
    const float t = real ? (float)(ax ? (pos & 63) : (pos >> 6)) : 0.f;
    const f32x4 ga0 = *(const f32x4*)(gn + d0), ga1 = *(const f32x4*)(gn + d0 + 4), gb0 = *(const f32x4*)(gn + d0 + 32), gb1 = *(const f32x4*)(gn + d0 + 36);
    float oa[8], ob[8];
#pragma unroll
    for (int j = 0; j < 8; ++j) { const float invf = __builtin_amdgcn_exp2f(-(float)(ic * 8 + j) * (2.0f / 64.0f) * 13.287712379549449f);
        float rev = t * invf * 0.15915494309189535f; rev -= floorf(rev);
        const float sn = __builtin_amdgcn_sinf(rev), cs = __builtin_amdgcn_cosf(rev);
        const float ya = xa[j] * rs * (j < 4 ? ga0[j & 3] : ga1[j & 3]), yb = xb[j] * rs * (j < 4 ? gb0[j & 3] : gb1[j & 3]);
        oa[j] = ya * cs - yb * sn; ob[j] = yb * cs + ya * sn; }
    *(u32x4*)(base + d0) = (u32x4){cvt_pk_bf16(oa[0], oa[1]), cvt_pk_bf16(oa[2], oa[3]), cvt_pk_bf16(oa[4], oa[5]), cvt_pk_bf16(oa[6], oa[7])};
    *(u32x4*)(base + d0 + 32) = (u32x4){cvt_pk_bf16(ob[0], ob[1]), cvt_pk_bf16(ob[2], ob[3]), cvt_pk_bf16(ob[4], ob[5]), cvt_pk_bf16(ob[6], ob[7])};
}
__device__ __forceinline__ void phase_attn_prep(const Params& p) {
    unsigned char* ws = p.ws; bf16_t* k = (bf16_t*)(ws + U_AK);
    const float* kn = p.in[15]; const int tid = get_tid(), lane = tid & 63, wid = tid >> 6;
    const int sub = lane & 7, ax = sub >> 2, ic = sub & 3, hl = lane >> 3;
    for (int r4 = blockIdx.x * 8 + wid; r4 < MROWS / 4; r4 += gridDim.x * 8) { const int row = r4 * 4 + (hl >> 1);
        attn_prep_head(k + (size_t)row * 256 + (hl & 1) * 128, (row - R0) & 4095, row >= R0, ax, ic, kn); }
}

__device__ __forceinline__ void phase_final(const Params& p) {
    unsigned char* ws = p.ws; const bf16_t* hb = (const bf16_t*)(ws + WS_HB); const float* ssq = (const float*)(ws + WS_SSQ) + 6 * (size_t)MROWS * 16; const float* gn = p.in[21];
    const int tid = get_tid(), lane = tid & 63, wid = tid >> 6;
    f32x4 g[4];
#pragma unroll
    for (int i = 0; i < 4; ++i) g[i] = *(const f32x4*)(gn + i * 256 + lane * 4);
    float pofs = 0.f;
    if (TPROBE_MASK) pofs = sqrtf(*(const float*)(ws + WS_NEED) * 1e-8f);
    for (int rq = blockIdx.x * 8 + wid; rq < (MROWS - R0) / 4; rq += gridDim.x * 8) {
        u32x2 w[4][4]; float sr[4];
#pragma unroll
        for (int k = 0; k < 4; ++k) { const int row = R0 + rq * 4 + k;
#pragma unroll
            for (int i = 0; i < 4; ++i) w[k][i] = *(const u32x2*)(hb + (size_t)row * DM + i * 256 + lane * 4);
            sr[k] = row_rstd(ssq, row); }
#pragma unroll
        for (int k = 0; k < 4; ++k) { const int row = R0 + rq * 4 + k;
#pragma unroll
            for (int i = 0; i < 4; ++i) { const f32x4 v = {bflo(w[k][i].x), bfhi(w[k][i].x), bflo(w[k][i].y), bfhi(w[k][i].y)};
                __builtin_nontemporal_store(v * sr[k] * g[i] + pofs, (f32x4*)(p.out + (size_t)(row - R0) * DM + i * 256 + lane * 4)); } }
    }
}

namespace att {
constexpr int D = 128, KVBLK = 64, LDQ = 1024, LDK = 256, LDO = 1024;
constexpr float SCALE = 0.088388347648318440f, THR = 8.f;
constexpr size_t SHM_V = KVBLK * D * 2, SHM_K = KVBLK * D * 2, SHM_ATTN = 2 * SHM_V + 2 * SHM_K + 8 * 64 * 4;
#define KSWZ(row, colB) ((row) * 256 + ((colB) ^ (((row) & 7) << 4)))
#define SBAR() __builtin_amdgcn_sched_barrier(0)
__device__ __forceinline__ int crow(int r, int hi) { return (r & 3) + 8 * (r >> 2) + 4 * hi; }
__device__ __forceinline__ void partialSM(f32x16& p0, f32x16& p1, float& m_reg, float& mn, float& alpha) {
  constexpr float C = SCALE * 1.4426950408889634f;
  float pmax = p0[0]; for (int r = 1; r < 16; ++r) pmax = fmaxf(pmax, p0[r]); for (int r = 0; r < 16; ++r) pmax = fmaxf(pmax, p1[r]);
  { auto rr = __builtin_amdgcn_permlane32_swap(__float_as_uint(pmax), __float_as_uint(pmax), false, false);
    pmax = fmaxf(__uint_as_float(rr[0]), __uint_as_float(rr[1])); }
  if (__builtin_expect(__all(pmax - m_reg <= THR / SCALE), 1)) { mn = m_reg; alpha = 1.f; }
  else { mn = fmaxf(m_reg, pmax); alpha = __builtin_amdgcn_exp2f((m_reg - mn) * C); m_reg = mn; }
  float mnC = -mn * C;
  for (int r = 0; r < 16; ++r) p0[r] = fmaf(p0[r], C, mnC); for (int r = 0; r < 16; ++r) p1[r] = fmaf(p1[r], C, mnC);
  for (int r = 0; r < 16; ++r) p0[r] = __builtin_amdgcn_exp2f(p0[r]);
}
__device__ __forceinline__ void finishSM(f32x16& p0, f32x16& p1, float alpha, float& l_reg, bf16x8& pa0, bf16x8& pa1, bf16x8& pa2, bf16x8& pa3) {
  for (int r = 0; r < 16; ++r) p1[r] = __builtin_amdgcn_exp2f(p1[r]);
  float ps = 0; for (int r = 0; r < 16; ++r) ps += p0[r]; for (int r = 0; r < 16; ++r) ps += p1[r];
  { auto rr = __builtin_amdgcn_permlane32_swap(__float_as_uint(ps), __float_as_uint(ps), false, false);
    ps = __uint_as_float(rr[0]) + __uint_as_float(rr[1]); }
  l_reg = l_reg * alpha + ps;
#define PK4(P, BASE, OUT) do { unsigned a0 = cvt_pk_bf16(P[BASE + 0], P[BASE + 1]), a1 = cvt_pk_bf16(P[BASE + 2], P[BASE + 3]);   \
    unsigned b0 = cvt_pk_bf16(P[BASE + 4], P[BASE + 5]), b1 = cvt_pk_bf16(P[BASE + 6], P[BASE + 7]);                              \
    auto r0 = __builtin_amdgcn_permlane32_swap(a0, b0, false, false); auto r1 = __builtin_amdgcn_permlane32_swap(a1, b1, false, false); \
    u32x4 w = {r0[0], r1[0], r0[1], r1[1]}; OUT = *reinterpret_cast<bf16x8*>(&w); } while (0)
  PK4(p0, 0, pa0); PK4(p0, 8, pa1); PK4(p1, 0, pa2); PK4(p1, 8, pa3);
#undef PK4
}
__device__ __forceinline__ void qkt(f32x16& p0, f32x16& p1, const char* Ks, const bf16x8* qr, int r32, int hi) {
  p0 = f32x16{}; p1 = f32x16{};
  for (int d0 = 0; d0 < 8; ++d0) { int cb = (d0 * 16 + hi * 8) * 2;
    bf16x8 b0 = *reinterpret_cast<const bf16x8*>(Ks + KSWZ(r32, cb));
    bf16x8 b1 = *reinterpret_cast<const bf16x8*>(Ks + KSWZ(32 + r32, cb));
    p0 = __builtin_amdgcn_mfma_f32_32x32x16_bf16(b0, qr[d0], p0, 0, 0, 0);
    p1 = __builtin_amdgcn_mfma_f32_32x32x16_bf16(b1, qr[d0], p1, 0, 0, 0); }
}
__device__ __forceinline__ int v_st(int k, int c) { const int kk = (k & ~0xC) | ((k & 4) << 1) | ((k & 8) >> 1); return ((kk >> 3) * 4 + (c >> 5)) * 512 + ((kk & 7) * 32 + (c & 31)) * 2; }
__device__ __forceinline__ int v_rd_base(int lane) { return ((lane & 3) << 3) | (((lane >> 2) & 3) << 6) | (((lane >> 4) & 1) << 5) | (((lane >> 5) & 1) << 8); }
constexpr int v_rd_off(int d0, int ks, int half) { return d0 * 512 + ks * 4096 + half * 2048; }
template <int OFF> __device__ __forceinline__ s16x4 tr_read(int vb) {
  s16x4 r; asm volatile("ds_read_b64_tr_b16 %0, %1 offset:%2" : "=&v"(r) : "v"(vb), "i"(OFF) : "memory"); return r;
}
template <int D0> __device__ __forceinline__ void pv_one(f32x16& od, int vb, bf16x8 pa0, bf16x8 pa1, bf16x8 pa2, bf16x8 pa3) {
  const s16x4 l0 = tr_read<v_rd_off(D0, 0, 0)>(vb), h0 = tr_read<v_rd_off(D0, 0, 1)>(vb), l1 = tr_read<v_rd_off(D0, 1, 0)>(vb), h1 = tr_read<v_rd_off(D0, 1, 1)>(vb);
  const s16x4 l2 = tr_read<v_rd_off(D0, 2, 0)>(vb), h2 = tr_read<v_rd_off(D0, 2, 1)>(vb), l3 = tr_read<v_rd_off(D0, 3, 0)>(vb), h3 = tr_read<v_rd_off(D0, 3, 1)>(vb);
  asm volatile("s_waitcnt lgkmcnt(0)" ::: "memory"); SBAR();
#define PK(L, H) (bf16x8){L[0], L[1], L[2], L[3], H[0], H[1], H[2], H[3]}
  od = __builtin_amdgcn_mfma_f32_32x32x16_bf16(pa0, PK(l0, h0), od, 0, 0, 0);
  od = __builtin_amdgcn_mfma_f32_32x32x16_bf16(pa1, PK(l1, h1), od, 0, 0, 0);
  od = __builtin_amdgcn_mfma_f32_32x32x16_bf16(pa2, PK(l2, h2), od, 0, 0, 0);
  od = __builtin_amdgcn_mfma_f32_32x32x16_bf16(pa3, PK(l3, h3), od, 0, 0, 0);
#undef PK
}
__device__ __forceinline__ void pv_d0(f32x16* o, int vb, bf16x8 pa0, bf16x8 pa1, bf16x8 pa2, bf16x8 pa3) {
  pv_one<0>(o[0], vb, pa0, pa1, pa2, pa3); pv_one<1>(o[1], vb, pa0, pa1, pa2, pa3); pv_one<2>(o[2], vb, pa0, pa1, pa2, pa3); pv_one<3>(o[3], vb, pa0, pa1, pa2, pa3);
}
__device__ __forceinline__ void attn_body(const bf16_t* Qb, const bf16_t* K0, const bf16_t* V0, const bf16_t* K1, const bf16_t* V1, bf16_t* Ob, char* lds, const float* qn, int qpos0) {
  constexpr int NT = 65;
  const int tid = get_tid(), wid = tid >> 6, lane = tid & 63, r32 = lane & 31, hi = lane >> 5;
  char* V_lds = lds; char* K_lds = lds + 2 * SHM_V;
  float* wsf = (float*)(lds + 2 * SHM_V + 2 * SHM_K) + wid * 64; float* li_l = wsf; float* al_l = wsf + 32;
  float m_reg = -1e30f, l_reg = 0; f32x16 o[4] = {}; bf16x8 qr[8];
  const bf16_t* Qw = Qb + (long)(wid * 32 + r32) * LDQ + hi * 8;
#pragma unroll
  for (int d0 = 0; d0 < 8; ++d0) qr[d0] = *reinterpret_cast<const bf16x8*>(Qw + d0 * 16);
  const int sr = tid >> 4, sc = (tid & 15) * 8, vst0 = v_st(sr, sc), vst1 = v_st(32 + sr, sc);
  const int vb0 = (int)(uintptr_t)V_lds + v_rd_base(lane);
  struct { bf16x8 vs0, vs1, ks0, ks1; } sr_[2];
#define TKP(T) ((T) == 0 ? K0 : K1 + (long)((T) - 1) * 64 * LDK)
#define TVP(T) ((T) == 0 ? V0 : V1 + (long)((T) - 1) * 64 * LDK)
#define SLOAD(i, T) do { const bf16_t* kp_ = TKP(T); const bf16_t* vp_ = TVP(T); \
    sr_[i].vs0 = *reinterpret_cast<const bf16x8*>(&vp_[(long)(sr) * LDK + sc]); sr_[i].vs1 = *reinterpret_cast<const bf16x8*>(&vp_[(long)(32 + sr) * LDK + sc]); \
    sr_[i].ks0 = *reinterpret_cast<const bf16x8*>(&kp_[(long)(sr) * LDK + sc]); sr_[i].ks1 = *reinterpret_cast<const bf16x8*>(&kp_[(long)(32 + sr) * LDK + sc]); } while (0)
#define SWRITE(b, i) do { *(bf16x8*)(V_lds + (b) * SHM_V + vst0) = sr_[i].vs0;          \
    *(bf16x8*)(V_lds + (b) * SHM_V + vst1) = sr_[i].vs1; int kc = sc * 2;               \
    *(bf16x8*)(K_lds + (b) * SHM_K + KSWZ(sr, kc)) = sr_[i].ks0;                       \
    *(bf16x8*)(K_lds + (b) * SHM_K + KSWZ(32 + sr, kc)) = sr_[i].ks1; } while (0)
#define SWAIT() asm volatile("s_waitcnt vmcnt(4)" ::: "memory")
#define RESC(a) do { if (__any((a) < 1.f)) { if (hi == 0) al_l[r32] = (a); asm volatile("s_waitcnt lgkmcnt(0)" ::: "memory"); \
    for (int d = 0; d < 4; ++d) for (int r = 0; r < 16; ++r) o[d][r] *= al_l[crow(r, hi)]; } } while (0)
  f32x16 pA0, pA1, pB0, pB1; float mnA, mnB, alA, alB; bf16x8 pa0, pa1, pa2, pa3;
  constexpr int SE = 0, SO = 1;
  SLOAD(SE, 0);
  { float ss = 0.f;
#pragma unroll
    for (int d0 = 0; d0 < 8; ++d0)
#pragma unroll
      for (int j = 0; j < 8; ++j) { const float x = bf2f((bf16_t)qr[d0][j]); ss += x * x; }
    ss += __shfl_xor(ss, 32);
    const float rs = rsqrtf(ss * (1.f / 128.f) + EPS);
    const int pos = (qpos0 + wid * 32 + r32) & 4095;
#pragma unroll
    for (int ax = 0; ax < 2; ++ax) { const float t = (float)(ax ? (pos & 63) : (pos >> 6));
#pragma unroll
      for (int bl = 0; bl < 2; ++bl) { const int da = ax * 4 + bl, db = da + 2; unsigned wa[4], wb[4];
        const f32x4 ga0 = *(const f32x4*)(qn + da * 16 + hi * 8), ga1 = *(const f32x4*)(qn + da * 16 + hi * 8 + 4), gb0 = *(const f32x4*)(qn + db * 16 + hi * 8), gb1 = *(const f32x4*)(qn + db * 16 + hi * 8 + 4);
#pragma unroll
        for (int jp = 0; jp < 4; ++jp) { float oa[2], ob[2];
#pragma unroll
          for (int jj = 0; jj < 2; ++jj) { const int j = jp * 2 + jj;
            const float invf = __builtin_amdgcn_exp2f(-(float)(bl * 16 + j) * (2.0f / 64.0f) * 13.287712379549449f) * __builtin_amdgcn_exp2f(-(float)hi * (16.0f / 64.0f) * 13.287712379549449f);
            float rev = t * invf * 0.15915494309189535f; rev -= floorf(rev);
            const float sn = __builtin_amdgcn_sinf(rev), cs = __builtin_amdgcn_cosf(rev);
            const float ya = bf2f((bf16_t)qr[da][j]) * rs * (j < 4 ? ga0[j & 3] : ga1[j & 3]), yb = bf2f((bf16_t)qr[db][j]) * rs * (j < 4 ? gb0[j & 3] : gb1[j & 3]);
            oa[jj] = ya * cs - yb * sn; ob[jj] = yb * cs + ya * sn; }
          wa[jp] = cvt_pk_bf16(oa[0], oa[1]); wb[jp] = cvt_pk_bf16(ob[0], ob[1]); }
        { u32x4 w = {wa[0], wa[1], wa[2], wa[3]}; qr[da] = *reinterpret_cast<bf16x8*>(&w); }
        { u32x4 w = {wb[0], wb[1], wb[2], wb[3]}; qr[db] = *reinterpret_cast<bf16x8*>(&w); } } }
  }
  asm volatile("s_waitcnt vmcnt(0)" ::: "memory"); SWRITE(0, SE); __syncthreads();
  qkt(pA0, pA1, K_lds, qr, r32, hi);
#pragma unroll
  for (int r = 8; r < 16; ++r) pA0[r] = -1e30f;
#pragma unroll
  for (int r = 0; r < 16; ++r) pA1[r] = -1e30f;
  partialSM(pA0, pA1, m_reg, mnA, alA);
  SLOAD(SO, 1); SLOAD(SE, 2);
  SWAIT(); SWRITE(1, SO); __syncthreads();
  for (int j = 1; j + 1 < NT; j += 2) {
    SBAR(); qkt(pB0, pB1, K_lds + SHM_K, qr, r32, hi);
    finishSM(pA0, pA1, alA, l_reg, pa0, pa1, pa2, pa3); SBAR();
    SLOAD(SO, (j + 2 < NT) ? j + 2 : NT - 1); SBAR();
    pv_d0(o, vb0, pa0, pa1, pa2, pa3); partialSM(pB0, pB1, m_reg, mnB, alB);
    __syncthreads(); SWAIT(); SWRITE(0, SE);
    RESC(alB); __syncthreads();
    SBAR(); qkt(pA0, pA1, K_lds, qr, r32, hi);
    finishSM(pB0, pB1, alB, l_reg, pa0, pa1, pa2, pa3); SBAR();
    SLOAD(SE, (j + 3 < NT) ? j + 3 : NT - 1); SBAR();
    pv_d0(o, vb0 + (int)SHM_V, pa0, pa1, pa2, pa3); partialSM(pA0, pA1, m_reg, mnA, alA);
    __syncthreads(); SWAIT(); SWRITE(1, SO);
    RESC(alA); __syncthreads();
  }
  finishSM(pA0, pA1, alA, l_reg, pa0, pa1, pa2, pa3); SBAR();
  pv_d0(o, vb0, pa0, pa1, pa2, pa3);
  if (hi == 0) li_l[r32] = l_reg; asm volatile("s_waitcnt lgkmcnt(0)" ::: "memory");
  float rli[16];
#pragma unroll
  for (int r = 0; r < 16; ++r) rli[r] = __builtin_amdgcn_rcpf(li_l[crow(r, hi)]);
  bf16_t* Ow = Ob + (long)(wid * 32) * LDO;
#pragma unroll
  for (int r = 0; r < 16; ++r) { int orow = crow(r, hi);
    for (int d0 = 0; d0 < 4; ++d0) { const float v = o[d0][r] * rli[r]; Ow[(long)orow * LDO + d0 * 32 + r32] = (bf16_t)(cvt_pk_bf16(v, v) & 0xffffu); } }
#undef SLOAD
#undef SWRITE
#undef SWAIT
#undef RESC
#undef TKP
#undef TVP
}
}

__device__ __forceinline__ void phase_attn(const Params& p, char* lds) {
    unsigned char* ws = p.ws; const bf16_t* q = (const bf16_t*)(ws + U_AQ); const bf16_t* k = (const bf16_t*)(ws + U_AK); const bf16_t* v = (const bf16_t*)(ws + U_AV); bf16_t* ao = (bf16_t*)(ws + U_AO);
    const bool xmap = (gridDim.x == 256);
    for (int it = blockIdx.x, rnd = 0; it < 2048; it += gridDim.x, ++rnd) {
        int item = it;
        if (xmap) { const int x = blockIdx.x & 7, j = blockIdx.x >> 3, pair = x * 4 + (rnd >> 1), i64 = (rnd & 1) * 32 + j; item = (pair >> 1) * 128 + ((pair & 1) * 4 + (i64 >> 4)) * 16 + (i64 & 15); }
        const int qb = item & 15, hh = (item >> 4) & 7, b = item >> 7, kvh = hh >> 2;
        const size_t qrow = (size_t)R0 + (size_t)b * SEQ + qb * 256;
        att::attn_body(q + qrow * 1024 + hh * 128, k + (size_t)(b * 16) * 256 + kvh * 128, v + (size_t)(b * 16) * 256 + kvh * 128,
                       k + ((size_t)R0 + (size_t)b * SEQ) * 256 + kvh * 128, v + ((size_t)R0 + (size_t)b * SEQ) * 256 + kvh * 128,
                       ao + qrow * 1024 + hh * 128, lds, p.in[14], qb * 256);
        __syncthreads();
    }
}

#define XB_TMO      128
#define XB_XCNT(j)  (256  + 64 * (j))
#define XB_XSUB(j)  (1280 + 64 * (j))
#define XB_XGEN(j)  (2304 + 64 * (j))
#define XB_TOP      3328
#define XB_TOPGEN   3392
#define XCD_BAR_WORDS 3456
#define XB_SPIN_CAP (1u << 18)
__device__ __forceinline__ unsigned xb_ld(unsigned* p)              { return __hip_atomic_load(p, __ATOMIC_RELAXED, __HIP_MEMORY_SCOPE_AGENT); }
__device__ __forceinline__ unsigned xb_add(unsigned* p, unsigned v) { return __hip_atomic_fetch_add(p, v, __ATOMIC_RELAXED, __HIP_MEMORY_SCOPE_AGENT); }
__device__ __forceinline__ unsigned xb_xcc_id() { return (unsigned)__builtin_amdgcn_s_getreg((3 << 11) | 20) & 0xFu; }
#define XB_SPIN(cond, bar) do { unsigned _sp = 0; while (cond) { __builtin_amdgcn_s_sleep(1); \
    if ((++_sp & 255u) == 0u) { if (xb_ld(&(bar)[XB_TMO])) break; if (_sp > XB_SPIN_CAP) { atomicAdd(&(bar)[XB_TMO], 1u); break; } } } } while (0)
struct XcdBarrier { unsigned* bar; unsigned x; volatile LAS unsigned* st; };
__device__ __forceinline__ XcdBarrier xcd_barrier_post(unsigned* bar, volatile LAS unsigned* st) {
    XcdBarrier b; b.bar = bar; b.x = xb_xcc_id(); b.st = st;
    if (threadIdx.x == 0) (void)xb_add(&bar[XB_XCNT(b.x)], 1u);
    return b;
}
__device__ __forceinline__ void xcd_barrier_complete(unsigned* bar, unsigned x, unsigned& nloc, unsigned& nx) {
    const unsigned G = gridDim.x * gridDim.y * gridDim.z;
    unsigned sum, cnt, mine, sp = 0u;
    for (;;) {
        sum = 0u; cnt = 0u; mine = 0u;
#pragma unroll
        for (unsigned j = 0; j < 16; ++j) { const unsigned c = xb_ld(&bar[XB_XCNT(j)]); sum += c; cnt += (c > 0u) ? 1u : 0u; mine = (j == x) ? c : mine; }
        if (sum == G) break;
        __builtin_amdgcn_s_sleep(1);
        if ((++sp & 255u) == 0u) { if (xb_ld(&bar[XB_TMO])) break; if (sp > XB_SPIN_CAP) { atomicAdd(&bar[XB_TMO], 1u); break; } }
    }
    nloc = mine > 0u ? mine : 1u; nx = cnt > 0u ? cnt : 1u;
}
__device__ __forceinline__ void xcd_barrier(const XcdBarrier& b) {
    asm volatile("s_waitcnt vmcnt(0)" ::: "memory");
    __syncthreads();
    if (threadIdx.x == 0) {
        unsigned* bar = b.bar;
        __builtin_amdgcn_s_waitcnt(0);
        unsigned nloc = b.st[0], nx = b.st[1];
        if (nloc == 0u) { xcd_barrier_complete(bar, b.x, nloc, nx); b.st[0] = nloc; b.st[1] = nx; }
        const unsigned old = xb_add(&bar[XB_XSUB(b.x)], 1u);
        const unsigned gen = old / nloc;
        if (old + 1u == (gen + 1u) * nloc) {
            __builtin_amdgcn_fence(__ATOMIC_RELEASE, "agent");
            asm volatile("s_waitcnt vmcnt(0)" ::: "memory");
            const unsigned og = xb_add(&bar[XB_TOP], 1u);
            const unsigned tg = og / nx;
            if (og + 1u == (tg + 1u) * nx) xb_add(&bar[XB_TOPGEN], 1u);
            else XB_SPIN(xb_ld(&bar[XB_TOPGEN]) == tg, bar);
            __builtin_amdgcn_fence(__ATOMIC_ACQUIRE, "agent");
            xb_add(&bar[XB_XGEN(b.x)], 1u);
            asm volatile("s_waitcnt vmcnt(0)" ::: "memory");
        } else {
            XB_SPIN(xb_ld(&bar[XB_XGEN(b.x)]) == gen, bar);
            __builtin_amdgcn_fence(__ATOMIC_ACQUIRE, "agent");
            asm volatile("s_waitcnt vmcnt(0)" ::: "memory");
        }
    }
    __syncthreads();
}

__global__ void __launch_bounds__(512, 1) mega_fwd(Params p) {
    extern __shared__ __attribute__((aligned(16))) unsigned char shm[];
    ldsp lds = (ldsp)shm;
    unsigned char* ws = p.ws;
    bf16_t* hb = (bf16_t*)(ws + WS_HB); float* ssq = (float*)(ws + WS_SSQ);
    const int G = gridDim.x, c = blockIdx.x;
    if (threadIdx.x < 4) ((volatile LAS unsigned*)(lds + LDS_BYTES))[threadIdx.x] = 0u;
    if (blockIdx.x == 0 && p.hi - p.lo > 1) for (int i = threadIdx.x; i < XCD_BAR_WORDS; i += 512) ((unsigned*)(p.ws + WS_BAR))[i] = 0u;
    __syncthreads();
    unsigned long long tp0 = 0; float tpsum = 0.f;
    for (int ph = p.lo; ph < p.hi; ++ph) {
        if (TPROBE_MASK && blockIdx.x == 0 && threadIdx.x == 0) tp0 = __builtin_amdgcn_s_memrealtime();
        int kind, f = 0, nin = 0, nout = 0;
        switch (ph) {
            case 0: kind = 0; break;
            case 1: kind = 1; f = 0; nin = 0; break;
            case 2: kind = 2; f = 0; nout = (DIAG == 2) ? 6 : 1; break;
            case 3: kind = 3; nin = 1; break;
            case 4: kind = 4; break;
            case 5: kind = 5; break;
            case 6: kind = 2; f = 4; nout = (DIAG == 3) ? 6 : 2; break;
            case 7: kind = 1; f = 1; nin = 2; break;
            case 8: kind = 2; f = 1; nout = 3; break;
            case 9: kind = 1; f = 2; nin = 3; break;
            case 10: kind = 2; f = 2; nout = 4; break;
            case 11: kind = 6; nin = 4; break;
            case 12: kind = 7; break;
            case 13: kind = 8; break;
            case 14: kind = 2; f = 5; nout = 5; break;
            case 15: kind = 1; f = 3; nin = 5; break;
            case 16: kind = 2; f = 3; nout = 6; break;
            default: kind = 9; break;
        }
        if (!((PHMASK >> ph) & 1)) kind = 99;
        const int pmoff = (ph >= 14) ? 1 : 0; const int Mrows = MROWS - pmoff * 256;
        if (kind == 0) { if (KMASK & 1) phase_prep(p, lds); }
        else if (kind == 1 && (KMASK & 2)) {
            pg8::Gemm g{hb + (size_t)pmoff * 256 * DM, (const bf16_t*)(ws + WS_WGU + f * SZ_WGU), Mrows, 2 * FF, DM, 0}; pg8::StaticOrder S; S.init(Mrows, 2 * FF, G, c);
            EpiSwiGLU E{(bf16_t*)(ws + U_ACT), ssq + (size_t)nin * MROWS * 16, pmoff, lds};
            rstd_table_build(lds, S, E.ssq, pmoff);
            pg8::gemm_phase(lds, g, S, E);
        } else if (kind == 2 && (KMASK & 4)) {
            pg8::Gemm g; float alpha; const float* x32 = nullptr;
            if (f < 4) { g = pg8::Gemm{(const bf16_t*)(ws + U_ACT) + (size_t)pmoff * 256 * FF, (const bf16_t*)(ws + WS_WD + f * SZ_WD), Mrows, DM, FF, 1}; alpha = 0.5f; if (ph == 2) x32 = p.in[0] - (size_t)R0 * DM; }
            else if (f == 4) { g = pg8::Gemm{(const bf16_t*)(ws + U_GV), (const bf16_t*)(ws + WS_WGOUT), MROWS, DM, DM, 0}; alpha = 1.f; }
            else { g = pg8::Gemm{(const bf16_t*)(ws + U_AO) + (size_t)pmoff * 256 * DM, (const bf16_t*)(ws + WS_WAOUT), Mrows, DM, DM, 0}; alpha = 1.f; }
            pg8::StaticOrder S; S.init(Mrows, DM, G, c);
            EpiResid E{x32, hb, ssq + (size_t)nout * MROWS * 16, alpha, pmoff};
            pg8::gemm_phase(lds, g, S, E);
        } else if (kind == 3 && (KMASK & 8)) {
            pg8::Gemm g{hb, (const bf16_t*)(ws + WS_WGIN), MROWS, 4096, DM, 0}; pg8::StaticOrder S; S.init(MROWS, 4096, G, c);
            EpiGlaIn E{(bf16_t*)((unsigned char*)p.out + O_GQ), (bf16_t*)(ws + U_GK), (bf16_t*)(ws + U_GV), (bf16_t*)(ws + U_GR), (float*)((unsigned char*)p.out + O_GF), (float*)(ws + U_GB),
                       ssq + (size_t)nin * MROWS * 16, p.in[10], lds};
            for (int i = get_tid(); i < 1024; i += 512) *(LAS float*)(lds + GB_OFF + i * 4) = p.in[10][i];
            rstd_table_build(lds, S, E.ssq, 0);
            pg8::gemm_phase(lds, g, S, E);
        } else if (kind == 4) { if (KMASK & 16) phase_gla_seq(p, lds); }
        else if (kind == 5) { if (KMASK & 32) phase_gla_post(p); }
        else if (kind == 6 && (KMASK & 64)) {
            pg8::Gemm g{hb, (const bf16_t*)(ws + WS_WAIN), MROWS, 1536, DM, 0}; pg8::StaticOrder S; S.init(MROWS, 1536, G, c);
            EpiAttnIn E{(bf16_t*)(ws + U_AQ), (bf16_t*)(ws + U_AK), (bf16_t*)(ws + U_AV), ssq + (size_t)nin * MROWS * 16, lds};
            rstd_table_build(lds, S, E.ssq, 0);
            pg8::gemm_phase(lds, g, S, E);
        } else if (kind == 7) { if (KMASK & 128) phase_attn_prep(p); }
        else if (kind == 8) { if (KMASK & 256) phase_attn(p, (char*)shm); }
        else if (kind == 9 && (KMASK & 512)) phase_final(p);
        if (ph + 1 < p.hi) {
            if (ph == p.lo) { cg::this_grid().sync(); (void)xcd_barrier_post((unsigned*)(p.ws + WS_BAR), (volatile LAS unsigned*)(lds + LDS_BYTES)); }
            else { XcdBarrier xb; xb.bar = (unsigned*)(p.ws + WS_BAR); xb.x = xb_xcc_id(); xb.st = (volatile LAS unsigned*)(lds + LDS_BYTES); xcd_barrier(xb); } }
        if (TPROBE_MASK) { if (blockIdx.x == 0 && threadIdx.x == 0) { const unsigned long long tp1 = __builtin_amdgcn_s_memrealtime(); if ((TPROBE_MASK >> ph) & 1) tpsum += (float)(tp1 - tp0) * 0.01f;
                if (ph == 16) __hip_atomic_store((float*)(ws + WS_NEED), tpsum, __ATOMIC_RELAXED, __HIP_MEMORY_SCOPE_AGENT); }
            if (ph == 16) cg::this_grid().sync(); }
    }
}

extern "C" void kernel_launch(void* const* d_in, const int* in_sizes, int n_in, void* d_out, int out_size, void* d_ws, size_t ws_size, hipStream_t stream) {
    static int grid = 0;
    if (grid == 0) {
        if (n_in != 22 || out_size != NB * SEQ * DM || ws_size < WS_END) { fprintf(stderr, "kernel_launch: unexpected shapes n_in %d out %d ws %zu (need %zu)\n", n_in, out_size, ws_size, (size_t)WS_END); grid = -1; return; }
        if (hipFuncSetAttribute((const void*)mega_fwd, hipFuncAttributeMaxDynamicSharedMemorySize, LDS_TOTAL) != hipSuccess) { fprintf(stderr, "kernel_launch: hipFuncSetAttribute failed\n"); grid = -1; return; }
        int dev = 0, cus = 0, per_cu = 0;
        hipGetDevice(&dev); hipDeviceGetAttribute(&cus, hipDeviceAttributeMultiprocessorCount, dev);
        hipOccupancyMaxActiveBlocksPerMultiprocessor(&per_cu, (const void*)mega_fwd, 512, LDS_TOTAL);
        if (per_cu < 1) { fprintf(stderr, "kernel_launch: occupancy query says %d blocks/CU\n", per_cu); per_cu = 1; }
        (void)hipGetLastError();
        grid = cus * per_cu;
    }
    if (grid < 0) return;
    Params p{};
    for (int i = 0; i < 22; ++i) p.in[i] = (const float*)d_in[i];
    p.out = (float*)d_out; p.ws = (unsigned char*)d_ws;
#if ONE_LAUNCH
    p.lo = 0; p.hi = NPHASE;
    void* args[] = {&p};
    hipError_t e = hipLaunchCooperativeKernel((const void*)mega_fwd, dim3(grid), dim3(512), args, LDS_TOTAL, stream);
    if (e != hipSuccess) fprintf(stderr, "cooperative launch failed: %s (grid %d)\n", hipGetErrorString(e), grid);
#else
    for (int ph = 0; ph < NPHASE; ++ph) { p.lo = ph; p.hi = ph + 1; hipLaunchKernelGGL(mega_fwd, dim3(grid), dim3(512), LDS_TOTAL, stream, p); }
#endif
}
```
